# Optimizing an MI355X kernel written in HIP

```python
import jax, jax.numpy as jnp
from jax import lax
import numpy as np

D_MODEL = 1024
BATCH = 16
SEQ = 2048
DEPTH = 1
DEC_BATCH = 8
DEC_SEQ = 8192
PAST_LEN = 128

N_META = 16
GRID_W = 64
HEAD_DIM = 64
ATTN_WIDTH = D_MODEL // 2
N_Q_HEADS = ATTN_WIDTH // HEAD_DIM
N_KV_HEADS = N_Q_HEADS // 4
Q_PER_KV = N_Q_HEADS // N_KV_HEADS
KV_WIDTH = N_KV_HEADS * HEAD_DIM
FOURIER_WIDTH = D_MODEL // 2
N_FOURIER_GROUPS = 4
FOURIER_GROUP = FOURIER_WIDTH // N_FOURIER_GROUPS
D_FF = -(-(8 * D_MODEL) // (3 * 256)) * 256
IN_WIDTH = ATTN_WIDTH + 2 * KV_WIDTH + FOURIER_WIDTH + 2 * D_MODEL
ROPE_AXIS_DIM = HEAD_DIM // 2
ROPE_THETA = 10000.0
Q_BLOCK = 128
EPS = 1e-6

kernel_name = "hybrid_fnet_gqa_axial_rope_encoder"


def rms_norm(x, g):
    xf = x.astype(jnp.float32)
    y = xf * lax.rsqrt(jnp.mean(xf * xf, axis=-1, keepdims=True) + EPS) * g.astype(jnp.float32)
    return y.astype(x.dtype)


def grid_positions(n_tokens):
    rows = n_tokens // GRID_W
    meta_row = jnp.full((N_META,), -1.0, jnp.float32)
    meta_col = jnp.arange(N_META, dtype=jnp.float32)
    tok_row = jnp.repeat(jnp.arange(rows, dtype=jnp.float32), GRID_W)
    tok_col = jnp.tile(jnp.arange(GRID_W, dtype=jnp.float32), rows)
    return jnp.concatenate([meta_row, tok_row]), jnp.concatenate([meta_col, tok_col])


def rope_1d(x, ang):
    half = ROPE_AXIS_DIM // 2
    x1, x2 = x[..., :half], x[..., half:]
    c = jnp.cos(ang)[None, :, None, :]
    s = jnp.sin(ang)[None, :, None, :]
    return jnp.concatenate([x1 * c - x2 * s, x2 * c + x1 * s], axis=-1)


def axial_rope(x, row, col):
    inv_freq = 1.0 / (ROPE_THETA ** (jnp.arange(0, ROPE_AXIS_DIM, 2, dtype=jnp.float32) / ROPE_AXIS_DIM))
    ang_r = row[:, None] * inv_freq[None, :]
    ang_c = col[:, None] * inv_freq[None, :]
    xf = x.astype(jnp.float32)
    out = jnp.concatenate([rope_1d(xf[..., :ROPE_AXIS_DIM], ang_r),
                           rope_1d(xf[..., ROPE_AXIS_DIM:], ang_c)], axis=-1)
    return out.astype(x.dtype)


def head_rms_norm(x, g):
    xf = x.astype(jnp.float32)
    y = xf * lax.rsqrt(jnp.mean(xf * xf, axis=-1, keepdims=True) + EPS) * g.astype(jnp.float32)
    return y.astype(x.dtype)


def attention_block(qb, k, v):
    scale = HEAD_DIM ** -0.5
    s = jnp.einsum('bqhgd,bshd->bhgqs', qb, k).astype(jnp.float32) * scale
    p = jax.nn.softmax(s, axis=-1).astype(v.dtype)
    return jnp.einsum('bhgqs,bshd->bqhgd', p, v)


def bidirectional_gqa(q, k, v):
    b = q.shape[0]
    out_meta = attention_block(q[:, :N_META], k, v)
    q_real = q[:, N_META:]
    n = q_real.shape[1]
    nb = n // Q_BLOCK
    q_blocks = q_real.reshape(b, nb, Q_BLOCK, N_KV_HEADS, Q_PER_KV, HEAD_DIM).swapaxes(0, 1)
    out_blocks = lax.map(lambda qb: attention_block(qb, k, v), q_blocks)
    out_real = out_blocks.swapaxes(0, 1).reshape(b, n, N_KV_HEADS, Q_PER_KV, HEAD_DIM)
    out = jnp.concatenate([out_meta, out_real], axis=1)
    return out.reshape(b, out.shape[1], ATTN_WIDTH)


def fourier_mix(f):
    b, l, _ = f.shape
    fg = f.astype(jnp.float32).reshape(b, l, N_FOURIER_GROUPS, FOURIER_GROUP)
    y = jnp.real(jnp.fft.fftn(fg, axes=(1, 3), norm='ortho'))
    return y.reshape(b, l, FOURIER_WIDTH).astype(f.dtype)


def encoder_layer(x, row, col, norm_mix_g, w_in, q_norm_g, k_norm_g, w_attn_o, w_four_o, w_out,
                  norm_ffn_g, w_ffn_in, w_ffn_out):
    b, l, _ = x.shape
    h = rms_norm(x, norm_mix_g)
    z = h @ w_in
    o0 = ATTN_WIDTH
    o1 = o0 + KV_WIDTH
    o2 = o1 + KV_WIDTH
    o3 = o2 + FOURIER_WIDTH
    o4 = o3 + D_MODEL
    q = z[..., :o0].reshape(b, l, N_Q_HEADS, HEAD_DIM)
    k = z[..., o0:o1].reshape(b, l, N_KV_HEADS, HEAD_DIM)
    v = z[..., o1:o2].reshape(b, l, N_KV_HEADS, HEAD_DIM)
    f = z[..., o2:o3]
    g_attn = jax.nn.sigmoid(z[..., o3:o4])
    g_four = jax.nn.sigmoid(z[..., o4:])
    q = axial_rope(head_rms_norm(q, q_norm_g), row, col)
    k = axial_rope(head_rms_norm(k, k_norm_g), row, col)
    q = q.reshape(b, l, N_KV_HEADS, Q_PER_KV, HEAD_DIM)
    a = bidirectional_gqa(q, k, v) @ w_attn_o
    fo = fourier_mix(f) @ w_four_o
    merged = g_attn * a + g_four * fo
    x = x + merged @ w_out
    h2 = rms_norm(x, norm_ffn_g)
    u = h2 @ w_ffn_in
    gate, up = u[..., :D_FF], u[..., D_FF:]
    x = x + (jax.nn.silu(gate) * up) @ w_ffn_out
    return x


def encode(x, meta_tokens, norm_mix_g, w_in, q_norm_g, k_norm_g, w_attn_o, w_four_o, w_out,
           norm_ffn_g, w_ffn_in, w_ffn_out, final_norm_g):
    b, n, d = x.shape
    row, col = grid_positions(n)
    meta = jnp.broadcast_to(meta_tokens.astype(x.dtype)[None], (b, N_META, d))
    h = jnp.concatenate([meta, x], axis=1)
    for layer in range(DEPTH):
        h = encoder_layer(h, row, col, norm_mix_g[layer], w_in[layer], q_norm_g[layer], k_norm_g[layer],
                          w_attn_o[layer], w_four_o[layer], w_out[layer], norm_ffn_g[layer],
                          w_ffn_in[layer], w_ffn_out[layer])
    h = rms_norm(h, final_norm_g)
    return h[:, N_META:]


def setup_inputs(seed: int = 0) -> dict:
    key = jax.random.key(seed)
    ks = jax.random.split(key, 14)

    def w(k, shape, fan_in, extra=1.0):
        return jax.random.normal(k, shape, jnp.float32) * (fan_in ** -0.5) * extra

    def gain(k, shape):
        return 1.0 + 0.02 * jax.random.normal(k, shape, jnp.float32)

    return {
        "x_prompt": jax.random.normal(ks[0], (BATCH, SEQ, D_MODEL), jnp.float32),
        "x_sample": jax.random.normal(ks[1], (DEC_BATCH, DEC_SEQ, D_MODEL), jnp.float32),
        "meta_tokens": jax.random.normal(ks[2], (N_META, D_MODEL), jnp.float32),
        "norm_mix_g": gain(ks[3], (DEPTH, D_MODEL)),
        "w_in": w(ks[4], (DEPTH, D_MODEL, IN_WIDTH), D_MODEL),
        "q_norm_g": gain(ks[5], (DEPTH, HEAD_DIM)),
        "k_norm_g": gain(ks[6], (DEPTH, HEAD_DIM)),
        "w_attn_o": w(ks[7], (DEPTH, ATTN_WIDTH, D_MODEL), ATTN_WIDTH),
        "w_four_o": w(ks[8], (DEPTH, FOURIER_WIDTH, D_MODEL), FOURIER_WIDTH),
        "w_out": w(ks[9], (DEPTH, D_MODEL, D_MODEL), D_MODEL),
        "norm_ffn_g": gain(ks[10], (DEPTH, D_MODEL)),
        "w_ffn_in": w(ks[11], (DEPTH, D_MODEL, 2 * D_FF), D_MODEL),
        "w_ffn_out": w(ks[12], (DEPTH, D_FF, D_MODEL), D_FF),
        "final_norm_g": gain(ks[13], (D_MODEL,)),
    }


def reference(x_prompt, x_sample, meta_tokens, norm_mix_g, w_in, q_norm_g, k_norm_g, w_attn_o, w_four_o,
              w_out, norm_ffn_g, w_ffn_in, w_ffn_out, final_norm_g):
    y_prompt = encode(x_prompt, meta_tokens, norm_mix_g, w_in, q_norm_g, k_norm_g, w_attn_o, w_four_o,
                      w_out, norm_ffn_g, w_ffn_in, w_ffn_out, final_norm_g)
    y_sample = encode(x_sample, meta_tokens, norm_mix_g, w_in, q_norm_g, k_norm_g, w_attn_o, w_four_o,
                      w_out, norm_ffn_g, w_ffn_in, w_ffn_out, final_norm_g)
    return (y_prompt, y_sample)
```

```cpp
#include <hip/hip_runtime.h>
#include <hip/hip_cooperative_groups.h>
#include <cstdio>
#include <cstdint>
namespace cg = cooperative_groups;
#ifndef PHM
#define PHM 0x1ff
#endif
#ifndef PROBE
#define PROBE 0
#endif
#ifndef PG_ALIGN
#define PG_ALIGN true
#endif
#ifndef PG_SP2
#define PG_SP2 true
#endif
#ifndef CHECKS
#define CHECKS 0
#endif
namespace pg8 {
#define PG8_LAS __attribute__((address_space(3)))
typedef unsigned short bf16_t;
typedef short bf16x8 __attribute__((ext_vector_type(8)));
typedef float f32x4 __attribute__((ext_vector_type(4)));
typedef unsigned u32x4 __attribute__((ext_vector_type(4)));
constexpr int BM = 256, BK = 64, HALF = 128, HTB = HALF * BK * 2  , STAGE_BYTES = 8 * HTB, NXCD = 8, WGM = 8;

__host__ __device__ __forceinline__ int lds_byte(int r, int c) { const int st = (r >> 4) * 2 + (c >> 5), rr = r & 15, cc = c & 31, ob = rr * 64 + cc * 2; return st * 1024 + (ob ^ (((ob >> 9) & 1) << 5)); }
__host__ __device__ __forceinline__ void stage_rc(int b, int& R, int& C) { const int st = b / 1024, sb = b % 1024, swz = sb ^ (((sb >> 9) & 1) << 5); R = (st >> 1) * 16 + swz / 64; C = (st & 1) * 32 + (swz % 64) / 2; }
__host__ __device__ __forceinline__ int perm32(int rho) { const int n = rho >> 4, i = rho & 15; return 8 * (i >> 2) + 4 * n + (i & 3); }

struct Unit { int pm, pn; };
struct Gemm { const bf16_t* A; const bf16_t* Bt; int M, N, K; };

struct StaticOrder {
    int nM, nN, nwg, G, c;
    __host__ __device__ void init(int M, int N, int G_, int c_) { nM = M / BM; nN = N / BM; nwg = nM * nN; G = G_; c = c_; }
    __host__ __device__ bool next(int i, Unit& u) const {
        const long L = (long)i * G + c; if (L >= nwg) return false;
        int wgid = (int)L; { const int q = nwg / NXCD, r = nwg % NXCD, xcd = wgid % NXCD, off = wgid / NXCD; wgid = (xcd < r ? xcd * (q + 1) : r * (q + 1) + (xcd - r) * q) + off; }
        const int nig = WGM * nN, gid = wgid / nig, fm = gid * WGM, gsz = (nM - fm) < WGM ? (nM - fm) : WGM;
        u.pm = fm + ((wgid % nig) % gsz); u.pn = (wgid % nig) / gsz; return true;
    }
    __device__ __forceinline__ void a_ready(const Unit&) const {}
    __device__ __forceinline__ void done(const Unit&) const {}
};

typedef float f32x2c_t __attribute__((ext_vector_type(2))); typedef __bf16 bf16x2c_t __attribute__((ext_vector_type(2)));
__device__ __forceinline__ unsigned cvt_pk_bf16(float lo, float hi) { f32x2c_t v = {lo, hi}; bf16x2c_t b = __builtin_convertvector(v, bf16x2c_t); return __builtin_bit_cast(unsigned, b); }
typedef float f32x2 __attribute__((ext_vector_type(2)));
template <class Epi, class Sched, bool ALIGN_EPI = false, bool SP2 = false>
__device__ __forceinline__ void gemm_phase(PG8_LAS unsigned char* lds, const Gemm g, const Sched& S, const Epi& E) {
    int tid_ = threadIdx.x; asm volatile("" : "+v"(tid_));
    const int tid = tid_, wid = __builtin_amdgcn_readfirstlane(tid >> 6), lane = tid & 63, wr = wid >> 2, wc = wid & 3, fr = lane & 15, fq = lane >> 4;
    const int K = g.K, nt = K / BK;
    unsigned voffA[2], voffB[2];
#pragma unroll
    for (int i = 0; i < 2; ++i) { int R, C; stage_rc(tid * 16 + i * 8192, R, C); const int Rb = Epi::PERM ? ((R & ~31) + perm32(R & 31)) : R;
        voffA[i] = (unsigned)(R * K + C) * 2u; voffB[i] = (unsigned)(Epi::brow(Rb) * K + C) * 2u; }
    const size_t kstep = (size_t)(BK * 2);
    const size_t hstep = (size_t)HALF * K * 2;
    const size_t tstep = 2 * hstep;
    const unsigned ldsw = (unsigned)wid * 1024u;
    const int aoff = lds_byte(wr * 64 + fr, fq * 8), boff = lds_byte(wc * 32 + fr, fq * 8);
#define PG8_SA(b, h) (((b) * 2 + (h)) * HTB)
#define PG8_SB(b, h) ((4 + (b) * 2 + (h)) * HTB)
#define PG8_STAGE(bufoff, gbase, voff) do { _Pragma("unroll") for (int _i = 0; _i < 2; ++_i) \
        __builtin_amdgcn_global_load_lds((const unsigned*)((const char*)(gbase) + (voff)[_i]), (PG8_LAS unsigned*)(lds + (bufoff) + ldsw + _i * 8192), 16, 0, 0); } while (0)
#define PG8_LDA(dst, b, h) do { _Pragma("unroll") for (int m = 0; m < 4; ++m) _Pragma("unroll") for (int k = 0; k < 2; ++k) dst[m][k] = *(const PG8_LAS bf16x8*)(lds + PG8_SA(b, h) + aoff + m * 2048 + k * 1024); } while (0)
#define PG8_LDB(dst, b, h) do { _Pragma("unroll") for (int n = 0; n < 2; ++n) _Pragma("unroll") for (int k = 0; k < 2; ++k) dst[n][k] = *(const PG8_LAS bf16x8*)(lds + PG8_SB(b, h) + boff + n * 2048 + k * 1024); } while (0)
#define PG8_MMA(ai, bj, At, Bt) do { __builtin_amdgcn_s_setprio(1); _Pragma("unroll") for (int m = 0; m < 4; ++m) _Pragma("unroll") for (int n = 0; n < 2; ++n) _Pragma("unroll") for (int k = 0; k < 2; ++k) \
        acc[ai][bj][m][n] = __builtin_amdgcn_mfma_f32_16x16x32_bf16(Bt[n][k], At[m][k], acc[ai][bj][m][n], 0, 0, 0); __builtin_amdgcn_s_setprio(0); } while (0)
#define PG8_WAIT_V(n) asm volatile("s_waitcnt vmcnt(" #n ")" ::: "memory")
#define PG8_WAIT_L(n) asm volatile("s_waitcnt lgkmcnt(" #n ")" ::: "memory")
#define PG8_BAR __builtin_amdgcn_s_barrier()
#define PG8_SCHED __builtin_amdgcn_sched_barrier(0)
    Unit cur, nxt; int ui = 0;
    if (!S.next(0, cur)) return;
    f32x4 acc[2][2][4][2];
#pragma unroll
    for (int a = 0; a < 2; ++a)
#pragma unroll
        for (int b = 0; b < 2; ++b)
#pragma unroll
            for (int m = 0; m < 4; ++m)
#pragma unroll
                for (int n = 0; n < 2; ++n) acc[a][b][m][n] = (f32x4){0.f, 0.f, 0.f, 0.f};
    bf16x8 At[4][2], B0[2][2], B1[2][2];
    const char* cA = (const char*)g.A + (size_t)cur.pm * tstep; const char* cB = (const char*)g.Bt + (size_t)cur.pn * tstep;
    S.a_ready(cur);
    if constexpr (SP2) {
        PG8_STAGE(PG8_SB(0, 0), cB, voffB); PG8_STAGE(PG8_SB(0, 1), cB + hstep, voffB); PG8_STAGE(PG8_SA(0, 0), cA, voffA); PG8_STAGE(PG8_SA(0, 1), cA + hstep, voffA);
        if (wr == 1) PG8_BAR;
        PG8_WAIT_V(2); PG8_BAR;
        PG8_STAGE(PG8_SB(1, 0), cB + kstep, voffB); PG8_STAGE(PG8_SA(1, 0), cA + kstep, voffA); PG8_STAGE(PG8_SB(1, 1), cB + hstep + kstep, voffB);
        PG8_WAIT_V(6); PG8_BAR;
    } else {
        PG8_STAGE(PG8_SB(0, 0), cB, voffB); PG8_STAGE(PG8_SA(0, 0), cA, voffA); PG8_STAGE(PG8_SB(0, 1), cB + hstep, voffB); PG8_STAGE(PG8_SA(0, 1), cA + hstep, voffA);
        if (wr == 1) PG8_BAR;
        PG8_WAIT_V(4); PG8_BAR;
        PG8_STAGE(PG8_SB(1, 0), cB + kstep, voffB); PG8_STAGE(PG8_SA(1, 0), cA + kstep, voffA); PG8_STAGE(PG8_SB(1, 1), cB + hstep + kstep, voffB);
        PG8_WAIT_V(6); PG8_BAR;
    }
    for (;;) {
        const bool has_next = S.next(ui + 1, nxt);
        const char* nA = has_next ? (const char*)g.A + (size_t)nxt.pm * tstep : cA; const char* nB = has_next ? (const char*)g.Bt + (size_t)nxt.pn * tstep : cB;
        for (int t = 0; t < nt; t += 2) {
            const bool last = (t == nt - 2);
            const char* a1 = cA + (size_t)(t + 1) * kstep;
            const char* a2 = last ? nA : cA + (size_t)(t + 2) * kstep; const char* b2 = last ? nB : cB + (size_t)(t + 2) * kstep;
            const char* a3 = a2 + kstep; const char* b3 = b2 + kstep;
            if (last && has_next) S.a_ready(nxt);
            if constexpr (SP2) {
            PG8_LDB(B0, 0, 0); PG8_LDB(B1, 0, 1); PG8_SCHED; PG8_LDA(At, 0, 0); PG8_STAGE(PG8_SA(1, 1), a1 + hstep, voffA);
            PG8_WAIT_V(8); PG8_WAIT_L(0); PG8_BAR; PG8_MMA(0, 0, At, B0); PG8_MMA(0, 1, At, B1); PG8_BAR; PG8_SCHED;
            PG8_LDA(At, 0, 1); PG8_STAGE(PG8_SB(0, 0), b2, voffB); PG8_STAGE(PG8_SB(0, 1), b2 + hstep, voffB); PG8_STAGE(PG8_SA(0, 0), a2, voffA);
            PG8_WAIT_V(8); PG8_WAIT_L(0); PG8_BAR; PG8_MMA(1, 0, At, B0); PG8_MMA(1, 1, At, B1); PG8_BAR; PG8_SCHED;
            PG8_LDB(B0, 1, 0); PG8_LDB(B1, 1, 1); PG8_SCHED; PG8_LDA(At, 1, 0); PG8_STAGE(PG8_SA(0, 1), a2 + hstep, voffA);
            PG8_WAIT_V(8); PG8_WAIT_L(0); PG8_BAR; PG8_MMA(0, 0, At, B0); PG8_MMA(0, 1, At, B1); PG8_BAR; PG8_SCHED;
            PG8_LDA(At, 1, 1); PG8_STAGE(PG8_SB(1, 0), b3, voffB); PG8_STAGE(PG8_SB(1, 1), b3 + hstep, voffB); PG8_STAGE(PG8_SA(1, 0), a3, voffA);
            PG8_WAIT_V(8); PG8_WAIT_L(0); PG8_BAR; PG8_MMA(1, 0, At, B0); PG8_MMA(1, 1, At, B1); PG8_BAR; PG8_SCHED;
            } else {
            PG8_LDB(B0, 0, 0); PG8_SCHED; PG8_LDA(At, 0, 0); PG8_STAGE(PG8_SA(1, 1), a1 + hstep, voffA);
            PG8_WAIT_L(8); PG8_BAR; PG8_WAIT_L(0); PG8_MMA(0, 0, At, B0); PG8_BAR; PG8_SCHED;
            PG8_LDB(B1, 0, 1); PG8_STAGE(PG8_SB(0, 0), b2, voffB);
            PG8_BAR; PG8_WAIT_L(0); PG8_MMA(0, 1, At, B1); PG8_BAR;
            PG8_LDA(At, 0, 1); PG8_STAGE(PG8_SA(0, 0), a2, voffA);
            PG8_BAR; PG8_WAIT_L(0); PG8_MMA(1, 0, At, B0); PG8_BAR; PG8_SCHED;
            PG8_STAGE(PG8_SB(0, 1), b2 + hstep, voffB);
            PG8_WAIT_V(6); PG8_BAR; PG8_MMA(1, 1, At, B1); PG8_BAR;
            PG8_LDB(B0, 1, 0); PG8_SCHED; PG8_LDA(At, 1, 0); PG8_STAGE(PG8_SA(0, 1), a2 + hstep, voffA);
            PG8_WAIT_L(8); PG8_BAR; PG8_WAIT_L(0); PG8_MMA(0, 0, At, B0); PG8_BAR; PG8_SCHED;
            PG8_LDB(B1, 1, 1); PG8_STAGE(PG8_SB(1, 0), b3, voffB);
            PG8_BAR; PG8_WAIT_L(0); PG8_MMA(0, 1, At, B1); PG8_BAR;
            PG8_LDA(At, 1, 1); PG8_STAGE(PG8_SA(1, 0), a3, voffA);
            PG8_BAR; PG8_WAIT_L(0); PG8_MMA(1, 0, At, B0); PG8_BAR; PG8_SCHED;
            PG8_STAGE(PG8_SB(1, 1), b3 + hstep, voffB);
            PG8_WAIT_V(6); PG8_BAR; PG8_MMA(1, 1, At, B1); PG8_BAR;
            }
        }
        if constexpr (ALIGN_EPI) { if (wr == 0) PG8_BAR; }
        if constexpr (!Epi::AFTER_DRAIN) { E(acc, cur, wr, wc, fr, fq); S.done(cur); }
        if (!has_next) break;
#pragma unroll
        for (int a = 0; a < 2; ++a)
#pragma unroll
            for (int b = 0; b < 2; ++b)
#pragma unroll
                for (int m = 0; m < 4; ++m)
#pragma unroll
                    for (int n = 0; n < 2; ++n) acc[a][b][m][n] = (f32x4){0.f, 0.f, 0.f, 0.f};
        cur = nxt; cA = nA; cB = nB; ++ui;
        if constexpr (ALIGN_EPI) { if (wr == 1) PG8_BAR; }
    }
    PG8_WAIT_V(0);
    if constexpr (!ALIGN_EPI) { if (wr == 0) PG8_BAR; }
    PG8_BAR;
    if constexpr (Epi::AFTER_DRAIN) { E.fused(acc, cur, wr, wc, fr, fq, lds, wid, lane); S.done(cur); }
#undef PG8_SA
#undef PG8_SB
#undef PG8_STAGE
#undef PG8_LDA
#undef PG8_LDB
#undef PG8_MMA
#undef PG8_WAIT_V
#undef PG8_WAIT_L
#undef PG8_BAR
#undef PG8_SCHED
}
}
constexpr int NTOK = 98304;
constexpr int NMT = NTOK / 256;
constexpr int P_TOK = 32768;
constexpr int LP = 2064, LS = 8208;
constexpr int KPP = 2176, KPS = 8320;
constexpr int MTP = 5, MTS = 17;
constexpr size_t KV_S_OFF = (size_t)16 * 2 * KPP * 64;
constexpr float EPS = 1e-6f;
constexpr float QC2 = 0.125f * 1.4426950408889634f;

namespace pg8 {
__device__ __forceinline__ u32x4 pack8(f32x4 a, f32x4 b) { u32x4 w; w.x = cvt_pk_bf16(a[0], a[1]); w.y = cvt_pk_bf16(a[2], a[3]); w.z = cvt_pk_bf16(b[0], b[1]); w.w = cvt_pk_bf16(b[2], b[3]); return w; }
__device__ __forceinline__ void unpack8(u32x4 w, f32x4& a, f32x4& b) {
    a[0] = __uint_as_float(w.x << 16); a[1] = __uint_as_float(w.x & 0xffff0000u); a[2] = __uint_as_float(w.y << 16); a[3] = __uint_as_float(w.y & 0xffff0000u);
    b[0] = __uint_as_float(w.z << 16); b[1] = __uint_as_float(w.z & 0xffff0000u); b[2] = __uint_as_float(w.w << 16); b[3] = __uint_as_float(w.w & 0xffff0000u); }
__device__ __forceinline__ float sigm(float x) { return __builtin_amdgcn_rcpf(1.0f + __expf(-x)); }
__device__ __forceinline__ float dot4(f32x4 a) { return (a[0] * a[0] + a[1] * a[1]) + (a[2] * a[2] + a[3] * a[3]); }
__device__ __forceinline__ size_t kvoff(int seq, int kvh) { return seq < 16 ? (size_t)(seq * 2 + kvh) * KPP * 64 : KV_S_OFF + (size_t)((seq - 16) * 2 + kvh) * KPS * 64; }
__device__ __forceinline__ int seqlen(int seq) { return seq < 16 ? 2048 : 8192; }

struct EpiBase { static constexpr bool PERM = true, AFTER_DRAIN = false; static __host__ __device__ __forceinline__ int brow(int R) { return R; } };

struct G1Order {
    StaticOrder so; int nwg, G, c;
    __device__ void init(int G_, int c_) { so.init(NTOK, 2816, G_, c_); nwg = so.nwg; G = G_; c = c_; }
    __device__ bool next(int i, Unit& u) const { if (so.next(i, u)) return true; if ((long)i * G + c == (long)nwg + 72) { u.pm = NMT; u.pn = 2; return true; } return false; }
    __device__ __forceinline__ void a_ready(const Unit&) const {}
    __device__ __forceinline__ void done(const Unit&) const {}
};
struct DftOrder {
    int G, c, total, sample;
    __device__ bool next(int i, Unit& u) const {
        const long idx = (long)i * G + c; if (idx >= total) return false; const int id = (int)idx;
        if (sample) { if (id < 256) { const int x = id & 7, slot = id >> 3; u.pm = 2 * x + (slot >> 4); u.pn = slot & 15; } else { u.pm = 16; u.pn = id - 256; } }
        else { u.pm = id >> 5; u.pn = id & 31; }
        return true; }
    __device__ __forceinline__ void a_ready(const Unit&) const {}
    __device__ __forceinline__ void done(const Unit&) const {}
};

struct EpiG1 : EpiBase {
    bf16_t *Q, *KB, *VB, *GA; const float *rope, *gq, *gk;
    __device__ __forceinline__ void qk_row(const f32x4& a00, const f32x4& a01, const f32x4& a10, const f32x4& a11, const f32x4 (&gv)[2][2], int prow, int pcol, int fq, float osc, u32x4 (&w)[2]) const {
        float ss = (dot4(a00) + dot4(a01)) + (dot4(a10) + dot4(a11));
        ss += __shfl_xor(ss, 16); ss += __shfl_xor(ss, 32);
        const float rs = rsqrtf(ss * (1.0f / 64.0f) + EPS) ;
        { const int pp = prow + 1; const f32x4 c = *(const f32x4*)(rope + pp * 32 + 4 * fq), s = *(const f32x4*)(rope + pp * 32 + 16 + 4 * fq);
          const f32x4 x1 = a00 * rs * gv[0][0], x2 = a01 * rs * gv[0][1]; w[0] = pack8((x1 * c - x2 * s) * osc, (x2 * c + x1 * s) * osc); }
        { const int pp = pcol + 1; const f32x4 c = *(const f32x4*)(rope + pp * 32 + 4 * fq), s = *(const f32x4*)(rope + pp * 32 + 16 + 4 * fq);
          const f32x4 x1 = a10 * rs * gv[1][0], x2 = a11 * rs * gv[1][1]; w[1] = pack8((x1 * c - x2 * s) * osc, (x2 * c + x1 * s) * osc); }
    }
    __device__ __forceinline__ void operator()(const f32x4 (&acc)[2][2][4][2], const Unit& u, int wr, int wc, int fr, int fq) const {
        asm volatile("" : "+v"(fr), "+v"(fq));
        const int pm = u.pm, pn = u.pn;
        if (pm == NMT) {
            if (pn != 2 || wr != 0) return;
            u32x4 w[2]; bf16_t* base;
            if (wc < 2) { f32x4 gv[2][2];
#pragma unroll
                for (int bj = 0; bj < 2; ++bj)
#pragma unroll
                    for (int n = 0; n < 2; ++n) gv[bj][n] = *(const f32x4*)(gk + 32 * bj + 16 * n + 4 * fq);
                qk_row(acc[0][0][0][0], acc[0][0][0][1], acc[0][1][0][0], acc[0][1][0][1], gv, -1, fr, fq, 1.0f, w); base = KB; }
            else { w[0] = pack8(acc[0][0][0][0], acc[0][0][0][1]); w[1] = pack8(acc[0][1][0][0], acc[0][1][0][1]); base = VB; }
            const int kvh = wc & 1;
#pragma unroll 1
            for (int s = 0; s < 24; ++s) { bf16_t* d = base + kvoff(s, kvh) + (size_t)(seqlen(s) + fr) * 64 + 8 * fq; *(u32x4*)d = w[0]; *(u32x4*)(d + 32) = w[1]; }
            return;
        }
        if (pn >= 3) {
            const int col0 = (pn - 3) * 256 + wc * 32 + 8 * fq;
#pragma unroll
            for (int ai = 0; ai < 2; ++ai)
#pragma unroll
                for (int m = 0; m < 4; ++m) { bf16_t* rp = GA + (size_t)(pm * 256 + ai * 128 + wr * 64 + m * 16 + fr) * 2048 + col0;
#pragma unroll
                    for (int bj = 0; bj < 2; ++bj) { f32x4 v0 = acc[ai][bj][m][0], v1 = acc[ai][bj][m][1];
#pragma unroll
                        for (int j = 0; j < 4; ++j) { v0[j] = sigm(v0[j]); v1[j] = sigm(v1[j]); }
                        *(u32x4*)(rp + bj * 128) = pack8(v0, v1); } }
            return;
        }
        const int t0 = pm * 256; int seq, p0;
        if (t0 < P_TOK) { seq = t0 >> 11; p0 = t0 & 2047; } else { const int ts = t0 - P_TOK; seq = 16 + (ts >> 13); p0 = ts & 8191; }
        const bool isq = pn < 2;
        if (!isq && wc >= 2) {
            bf16_t* vb = VB + kvoff(seq, wc - 2) + (size_t)p0 * 64 + 8 * fq;
#pragma unroll
            for (int ai = 0; ai < 2; ++ai)
#pragma unroll
                for (int m = 0; m < 4; ++m) { const int rloc = ai * 128 + wr * 64 + m * 16 + fr;
#pragma unroll
                    for (int bj = 0; bj < 2; ++bj) *(u32x4*)(vb + (size_t)rloc * 64 + 32 * bj) = pack8(acc[ai][bj][m][0], acc[ai][bj][m][1]); }
            return;
        }
        const float* g = isq ? gq : gk; const float osc = isq ? QC2 : 1.0f;
        bf16_t* ob = isq ? Q + (size_t)t0 * 512 + (4 * pn + wc) * 64 + 8 * fq : KB + kvoff(seq, wc) + (size_t)p0 * 64 + 8 * fq; const int opitch = isq ? 512 : 64;
        f32x4 gv[2][2];
#pragma unroll
        for (int bj = 0; bj < 2; ++bj)
#pragma unroll
            for (int n = 0; n < 2; ++n) gv[bj][n] = *(const f32x4*)(g + 32 * bj + 16 * n + 4 * fq);
#pragma unroll
        for (int ai = 0; ai < 2; ++ai)
#pragma unroll
            for (int m = 0; m < 4; ++m) { const int rloc = ai * 128 + wr * 64 + m * 16 + fr; const int p = p0 + rloc;
                u32x4 w[2]; qk_row(acc[ai][0][m][0], acc[ai][0][m][1], acc[ai][1][m][0], acc[ai][1][m][1], gv, p >> 6, p & 63, fq, osc, w);
                bf16_t* d = ob + (size_t)rloc * opitch; *(u32x4*)d = w[0]; *(u32x4*)(d + 32) = w[1];
                asm volatile("" ::: "memory"); }
    }
};
struct EpiGT : EpiBase {
    bf16_t *GTp, *GTs;
    __device__ __forceinline__ bf16_t* dst(int seq, int ch) const { return seq < 16 ? GTp + ((size_t)seq * 512 + ch) * KPP : GTs + ((size_t)(seq - 16) * 512 + ch) * KPS; }
    __device__ __forceinline__ void operator()(const f32x4 (&acc)[2][2][4][2], const Unit& u, int wr, int wc, int fr, int fq) const {
        asm volatile("" : "+v"(fr), "+v"(fq));
        const bool meta = (u.pn == NMT);
        const int t0 = u.pn * 256; int seq, p0;
        if (t0 < P_TOK) { seq = t0 >> 11; p0 = t0 & 2047; } else { const int ts = t0 - P_TOK; seq = 16 + (ts >> 13); p0 = ts & 8191; }
#pragma unroll
        for (int ai = 0; ai < 2; ++ai)
#pragma unroll
            for (int m = 0; m < 4; ++m) { const int ch = u.pm * 256 + ai * 128 + wr * 64 + m * 16 + fr;
#pragma unroll
                for (int bj = 0; bj < 2; ++bj) { const u32x4 w = pack8(acc[ai][bj][m][0], acc[ai][bj][m][1]);
                    if (!meta) *(u32x4*)(dst(seq, ch) + 64 + p0 + bj * 128 + wc * 32 + 8 * fq) = w;
                    else if (bj == 0 && wc < 2) { for (int s = 0; s < 24; ++s) *(u32x4*)(dst(s, ch) + wc * 32 + 8 * fq) = w; } } }
    }
};
struct EpiDftP : EpiBase {
    static __host__ __device__ __forceinline__ int brow(int R) { return R <= 64 ? R : 128 - R; }
    float* dump; int nMt;
    __device__ __forceinline__ void operator()(const f32x4 (&acc)[2][2][4][2], const Unit& u, int wr, int wc, int fr, int fq) const {
        asm volatile("" : "+v"(fr), "+v"(fq));
        int tx_ = threadIdx.x; asm volatile("" : "+v"(tx_)); f32x4* d = (f32x4*)dump + (size_t)(u.pn * nMt + u.pm) * 32 * 512 + tx_;
#pragma unroll
        for (int ai = 0; ai < 2; ++ai)
#pragma unroll
            for (int bj = 0; bj < 2; ++bj)
#pragma unroll
                for (int m = 0; m < 4; ++m)
#pragma unroll
                    for (int n = 0; n < 2; ++n) d[(size_t)(((ai * 2 + bj) * 4 + m) * 2 + n) * 512] = acc[ai][bj][m][n];
    }
};
struct EpiDftQ : EpiBase {
    static __host__ __device__ __forceinline__ int brow(int R) { return (R == 0 || R == 64) ? 0 : (R < 64 ? 64 + R : 192 - R); }
    const float* dump; int nMt; bf16_t* F; int L, tokbase, nseq; float scale;
    __device__ __forceinline__ void operator()(const f32x4 (&acc)[2][2][4][2], const Unit& u, int wr, int wc, int fr, int fq) const {
        asm volatile("" : "+v"(fr), "+v"(fq));
        int tx_ = threadIdx.x; asm volatile("" : "+v"(tx_)); const f32x4* d = (const f32x4*)dump + (size_t)(u.pn * nMt + u.pm) * 32 * 512 + tx_;
        const int b = u.pn >> 1, pnl = u.pn & 1, tb = tokbase + b * nseq - 16, L2 = L >> 1;
        const float sg = (wc < 2) ? scale : -scale; const bool z0 = (fq == 0) && ((wc & 1) == 0);
#pragma unroll
        for (int ai = 0; ai < 2; ++ai)
#pragma unroll
            for (int m = 0; m < 4; ++m) { const int lp = u.pm * 256 + ai * 128 + wr * 64 + m * 16 + fr;
#pragma unroll
                for (int bj = 0; bj < 2; ++bj) {
                    const f32x4 P0 = d[(size_t)(((ai * 2 + bj) * 4 + m) * 2 + 0) * 512] * scale, P1 = d[(size_t)(((ai * 2 + bj) * 4 + m) * 2 + 1) * 512] * scale;
                    f32x4 q0 = acc[ai][bj][m][0] * sg, q1 = acc[ai][bj][m][1] * sg; if (z0) q0[0] = 0.f;
                    const int col = (pnl * 2 + bj) * 128 + wc * 32 + 8 * fq;
                    if (lp >= 16 && lp <= L2) *(u32x4*)(F + (size_t)(tb + lp) * 512 + col) = pack8(P0 - q0, P1 - q1);
                    if (lp >= 1 && lp < L2) *(u32x4*)(F + (size_t)(tb + L - lp) * 512 + col) = pack8(P0 + q0, P1 + q1); } }
    }
};
template <int SECOND> struct EpiMerge : EpiBase {
    const bf16_t* GA; bf16_t* MG;
    __device__ __forceinline__ void operator()(const f32x4 (&acc)[2][2][4][2], const Unit& u, int wr, int wc, int fr, int fq) const {
        asm volatile("" : "+v"(fr), "+v"(fq));
        const int col0 = u.pn * 256 + wc * 32 + 8 * fq;
#pragma unroll
        for (int ai = 0; ai < 2; ++ai)
#pragma unroll
            for (int m = 0; m < 4; ++m) { const size_t t = (size_t)(u.pm * 256 + ai * 128 + wr * 64 + m * 16 + fr);
#pragma unroll
                for (int bj = 0; bj < 2; ++bj) { const int c = col0 + bj * 128;
                    f32x4 g0, g1; unpack8(*(const u32x4*)(GA + t * 2048 + SECOND * 1024 + c), g0, g1);
                    f32x4 o0 = g0 * acc[ai][bj][m][0], o1 = g1 * acc[ai][bj][m][1];
                    if (SECOND) { f32x4 p0, p1; unpack8(*(const u32x4*)(MG + t * 1024 + c), p0, p1); o0 += p0; o1 += p1; }
                    *(u32x4*)(MG + t * 1024 + c) = pack8(o0, o1); } }
    }
};
struct EpiX1 : EpiBase {
    const float *xp, *xs; float* out; bf16_t* X1B; float* ss1;
    __device__ __forceinline__ void operator()(const f32x4 (&acc)[2][2][4][2], const Unit& u, int wr, int wc, int fr, int fq) const {
        asm volatile("" : "+v"(fr), "+v"(fq));
        const int col0 = u.pn * 256 + wc * 32 + 8 * fq;
#pragma unroll
        for (int ai = 0; ai < 2; ++ai)
#pragma unroll
            for (int m = 0; m < 4; ++m) { const int t = u.pm * 256 + ai * 128 + wr * 64 + m * 16 + fr;
                const float* xr = t < P_TOK ? xp + (size_t)t * 1024 : xs + (size_t)(t - P_TOK) * 1024; float part = 0.f;
#pragma unroll
                for (int bj = 0; bj < 2; ++bj) { const int c = col0 + bj * 128;
                    const f32x4 v0 = *(const f32x4*)(xr + c) + acc[ai][bj][m][0], v1 = *(const f32x4*)(xr + c + 4) + acc[ai][bj][m][1];
                    *(f32x4*)(out + (size_t)t * 1024 + c) = v0; *(f32x4*)(out + (size_t)t * 1024 + c + 4) = v1;
                    *(u32x4*)(X1B + (size_t)t * 1024 + c) = pack8(v0, v1); part += dot4(v0) + dot4(v1); }
                part += __shfl_xor(part, 16); part += __shfl_xor(part, 32);
                if (fq == 0) atomicAdd(ss1 + t, part); }
    }
};
struct EpiF1 : EpiBase {
    const float* ss1; bf16_t* U;
    __device__ __forceinline__ void operator()(const f32x4 (&acc)[2][2][4][2], const Unit& u, int wr, int wc, int fr, int fq) const {
        asm volatile("" : "+v"(fr), "+v"(fq));
        typedef unsigned u32x2 __attribute__((ext_vector_type(2)));
        const int col0 = u.pn * 128 + wc * 16 + 4 * fq;
#pragma unroll
        for (int ai = 0; ai < 2; ++ai)
#pragma unroll
            for (int m = 0; m < 4; ++m) { const int t = u.pm * 256 + ai * 128 + wr * 64 + m * 16 + fr;
                const float rs = rsqrtf(__hip_atomic_load(ss1 + t, __ATOMIC_RELAXED, __HIP_MEMORY_SCOPE_AGENT) * (1.0f / 1024.0f) + EPS);
#pragma unroll
                for (int bj = 0; bj < 2; ++bj) { const f32x4 gt = acc[ai][bj][m][0] * rs, up = acc[ai][bj][m][1] * rs; f32x4 o;
#pragma unroll
                    for (int j = 0; j < 4; ++j) o[j] = gt[j] * sigm(gt[j]) * up[j];
                    u32x2 w; w.x = cvt_pk_bf16(o[0], o[1]); w.y = cvt_pk_bf16(o[2], o[3]);
                    *(u32x2*)(U + (size_t)t * 2816 + col0 + bj * 64) = w; } }
    }
};
struct EpiF2 : EpiBase {
    float* out; float* ss2;
    __device__ __forceinline__ void operator()(const f32x4 (&acc)[2][2][4][2], const Unit& u, int wr, int wc, int fr, int fq) const {
        asm volatile("" : "+v"(fr), "+v"(fq));
        const int col0 = u.pn * 256 + wc * 32 + 8 * fq;
#pragma unroll
        for (int ai = 0; ai < 2; ++ai)
#pragma unroll
            for (int m = 0; m < 4; ++m) { const int t = u.pm * 256 + ai * 128 + wr * 64 + m * 16 + fr; float part = 0.f;
#pragma unroll
                for (int bj = 0; bj < 2; ++bj) { float* o = out + (size_t)t * 1024 + col0 + bj * 128;
                    const f32x4 v0 = *(const f32x4*)o + acc[ai][bj][m][0], v1 = *(const f32x4*)(o + 4) + acc[ai][bj][m][1];
                    *(f32x4*)o = v0; *(f32x4*)(o + 4) = v1; part += dot4(v0) + dot4(v1); }
                part += __shfl_xor(part, 16); part += __shfl_xor(part, 32);
                if (fq == 0) atomicAdd(ss2 + t, part); }
    }
};
}
#include <hip/hip_bf16.h>
#include <cmath>
namespace attn_body {
using bf16=__hip_bfloat16;
using bf16x8=__attribute__((ext_vector_type(8)))short;
using s16x4=__attribute__((ext_vector_type(4)))short;
using f32x16=__attribute__((ext_vector_type(16)))float;
using u32x4=__attribute__((ext_vector_type(4)))unsigned;
constexpr int D=64,QP=512,KP=64;
constexpr int NW=8,QBLK=32,QB=QBLK*NW,KVBLK=64;

__device__ __forceinline__ int crow(int r,int hi){return (r&3)+8*(r>>2)+4*hi;}
#define SBAR() __builtin_amdgcn_sched_barrier(0)
__device__ __forceinline__ void kmask(f32x16&p0,f32x16&p1,bool full){
  const float NEG=-INFINITY;
  #pragma unroll
  for(int r=0;r<16;++r){ if(full||r>=8)p0[r]=NEG; p1[r]=NEG; }
}

constexpr int NSLOT=3, SLOTB=8192;
constexpr int LDS_K=0, LDS_V=NSLOT*SLOTB, LDS_WS=2*NSLOT*SLOTB, LDS_OST=LDS_WS+NW*64*4, LDS_BYTES=LDS_OST+NW*4096;
constexpr float C2=0.125f*1.4426950408889634f;
__device__ __forceinline__ void glds16(const void*gsrc,unsigned lds_dst){unsigned keep;
  asm volatile("s_mov_b32 %0, m0\n\ts_mov_b32 m0, %2\n\ts_nop 0\n\tglobal_load_lds_dwordx4 %1, off\n\ts_mov_b32 m0, %0":"=&s"(keep):"v"(gsrc),"s"(lds_dst):"memory");}
__device__ __forceinline__ float max3f(float a,float b,float c){float r;asm("v_max3_f32 %0, %1, %2, %3":"=v"(r):"v"(a),"v"(b),"v"(c));return r;}
__device__ __forceinline__ float max2f(float a,float b){float r;asm("v_max_f32_e32 %0, %1, %2":"=v"(r):"v"(a),"v"(b));return r;}
__device__ __forceinline__ float fadd_s(float a,float b){float r;asm("v_add_f32_e32 %0, %1, %2":"=v"(r):"v"(a),"v"(b));return r;}
__device__ __forceinline__ float fsub_s(float a,float b){float r;asm("v_sub_f32_e32 %0, %1, %2":"=v"(r):"v"(a),"v"(b));return r;}
typedef float f32x2_t __attribute__((ext_vector_type(2))); typedef __bf16 bf16x2_t __attribute__((ext_vector_type(2)));
__device__ __forceinline__ unsigned cvtpk_s(float lo,float hi){f32x2_t v={lo,hi};bf16x2_t b=__builtin_convertvector(v,bf16x2_t);return __builtin_bit_cast(unsigned,b);}
#define WAIT_BAR(N) asm volatile("s_waitcnt vmcnt(" #N ") lgkmcnt(0)\n\ts_barrier":::"memory")

__device__ __forceinline__ void qkt(f32x16&p0,f32x16&p1,const char*Kslot,const bf16x8*qr,const f32x16&negm,int r32,int hi){
  const char*kb=Kslot+hi*1024+r32*16;
  #pragma unroll
  for(int d0=0;d0<4;++d0){
    const bf16x8 b0=*reinterpret_cast<const bf16x8*>(kb+d0*2048);
    const bf16x8 b1=*reinterpret_cast<const bf16x8*>(kb+d0*2048+512);
    if(d0==0){p0=__builtin_amdgcn_mfma_f32_32x32x16_bf16(b0,qr[0],negm,0,0,0);p1=__builtin_amdgcn_mfma_f32_32x32x16_bf16(b1,qr[0],negm,0,0,0);}
    else{p0=__builtin_amdgcn_mfma_f32_32x32x16_bf16(b0,qr[d0],p0,0,0,0);p1=__builtin_amdgcn_mfma_f32_32x32x16_bf16(b1,qr[d0],p1,0,0,0);}}
}
typedef __attribute__((address_space(3))) const char* lds_cptr;
typedef short v4i16_t __attribute__((ext_vector_type(4)));
__device__ __forceinline__ void kload8(bf16x8*kf,lds_cptr kp){
  kf[0]=*(const __attribute__((address_space(3))) bf16x8*)(kp);      kf[1]=*(const __attribute__((address_space(3))) bf16x8*)(kp+512);
  kf[2]=*(const __attribute__((address_space(3))) bf16x8*)(kp+2048); kf[3]=*(const __attribute__((address_space(3))) bf16x8*)(kp+2560);
  kf[4]=*(const __attribute__((address_space(3))) bf16x8*)(kp+4096); kf[5]=*(const __attribute__((address_space(3))) bf16x8*)(kp+4608);
  kf[6]=*(const __attribute__((address_space(3))) bf16x8*)(kp+6144); kf[7]=*(const __attribute__((address_space(3))) bf16x8*)(kp+6656);
}
__device__ __forceinline__ void kload2(bf16x8*kf,lds_cptr kp,int j){ kf[2*j]=*(const __attribute__((address_space(3))) bf16x8*)(kp+j*2048); kf[2*j+1]=*(const __attribute__((address_space(3))) bf16x8*)(kp+j*2048+512); }
__device__ __forceinline__ s16x4 vtr(lds_cptr p){ return __builtin_bit_cast(s16x4,__builtin_amdgcn_ds_read_tr16_b64_v4i16((__attribute__((address_space(3))) v4i16_t*)p)); }
__device__ __forceinline__ float rowmax(const f32x16&p0,const f32x16&p1){
  float a=max3f(p0[0],p0[1],p1[0]),b=max3f(p0[2],p0[3],p1[1]);a=max3f(a,p1[2],p1[3]);
  #pragma unroll
  for(int r=4;r<16;r+=4){a=max3f(a,p0[r],p0[r+1]);b=max3f(b,p0[r+2],p0[r+3]);a=max3f(a,p1[r],p1[r+1]);b=max3f(b,p1[r+2],p1[r+3]);}
  const float m=max2f(a,b);
  auto rr=__builtin_amdgcn_permlane32_swap(__float_as_uint(m),__float_as_uint(m),false,false);
  return max2f(__uint_as_float(rr[0]),__uint_as_float(rr[1]));
}
__device__ __forceinline__ void pv(f32x16*o,int vb,bf16x8 pa0,bf16x8 pa1,bf16x8 pa2,bf16x8 pa3){
  #pragma unroll
  for(int d0=0;d0<2;++d0){s16x4 lo[4],hi[4];
    #pragma unroll
    for(int ks=0;ks<4;++ks){
      asm volatile("ds_read_b64_tr_b16 %0,%1 offset:%c2":"=&v"(lo[ks]):"v"(vb),"i"(d0*4096+ks*1024):"memory");
      asm volatile("ds_read_b64_tr_b16 %0,%1 offset:%c2":"=&v"(hi[ks]):"v"(vb),"i"(d0*4096+ks*1024+512):"memory");}
    asm volatile("s_waitcnt lgkmcnt(0)":::"memory");SBAR();
    #define PK(k) (bf16x8){lo[k][0],lo[k][1],lo[k][2],lo[k][3],hi[k][0],hi[k][1],hi[k][2],hi[k][3]}
    o[d0]=__builtin_amdgcn_mfma_f32_32x32x16_bf16(pa0,PK(0),o[d0],0,0,0);
    o[d0]=__builtin_amdgcn_mfma_f32_32x32x16_bf16(pa1,PK(1),o[d0],0,0,0);
    o[d0]=__builtin_amdgcn_mfma_f32_32x32x16_bf16(pa2,PK(2),o[d0],0,0,0);
    o[d0]=__builtin_amdgcn_mfma_f32_32x32x16_bf16(pa3,PK(3),o[d0],0,0,0);
    #undef PK
  }
}

#ifndef ATTN_STORE16
#define ATTN_STORE16(p,v) (*(u32x4*)(p)=(v))
#endif
template<int THRL> __device__ __forceinline__ void attn_unit(const bf16*Qblk,const bf16*__restrict__ Kh,const bf16*__restrict__ Vh,bf16*Oblk,const int NT,char*shm){
  int tid_=threadIdx.x; asm volatile("":"+v"(tid_));
  const int tid=tid_,lane=tid&63,r32=lane&31,hi=lane>>5; const int wid=__builtin_amdgcn_readfirstlane(tid>>6);

  const bf16*Qw=Qblk+(long)(wid*QBLK)*QP;

  const unsigned lds0=(unsigned)(uintptr_t)shm;
  float*wsf=(float*)(shm+LDS_WS)+wid*64;
  const bf16*ksrc=Kh+(long)lane*KP+wid*8;
  const bf16*vsrc=Vh+(long)(16*(wid&3)+(lane>>2))*KP+(wid>>2)*32+(lane&3)*8;
  const unsigned kdst=lds0+LDS_K+wid*1024, vdst=lds0+LDS_V+wid*1024;
  #define DMA_K(t,slot) glds16(ksrc+(long)(t)*KVBLK*KP,(unsigned)__builtin_amdgcn_readfirstlane(kdst+(slot)))
  #define DMA_V(t,slot) glds16(vsrc+(long)(t)*KVBLK*KP,(unsigned)__builtin_amdgcn_readfirstlane(vdst+(slot)))
  const int vb0=(int)(lds0+LDS_V)+((lane>>4)&1)*32+(lane&3)*8+(4*hi+((lane&15)>>2))*64;
  const char*Kbase=shm+LDS_K; bf16x8 kf[8];
  const lds_cptr shm3=(lds_cptr)shm; const lds_cptr kp0=shm3+LDS_K+hi*1024+r32*16; const lds_cptr vp0=shm3+LDS_V+((lane>>4)&1)*32+(lane&3)*8+(4*hi+((lane&15)>>2))*64;
  DMA_K(0,0);DMA_V(0,0);DMA_K(1,SLOTB);
  bf16x8 qr[4];
  #pragma unroll
  for(int d0=0;d0<4;++d0)qr[d0]=*reinterpret_cast<const bf16x8*>(&Qw[(long)r32*QP+d0*16+hi*8]);
  float mhat=0.f,l_reg=0.f;f32x16 o[2];o[0]=f32x16{};o[1]=f32x16{};f32x16 negm=f32x16{};asm volatile("":"+v"(negm));
  const int qrel=wid*QBLK+r32;
  #define CMASK(P0,P1,t) do{}while(0)
  bool resc=false;
  #define START(P0,P1) do{ const float rm=rowmax(P0,P1); resc=false; \
    { const float dl=rm; mhat=fadd_s(mhat,dl); \
      _Pragma("unroll") for(int r=0;r<16;++r){P0[r]=fsub_s(P0[r],dl);P1[r]=fsub_s(P1[r],dl);} \
      _Pragma("unroll") for(int r=0;r<16;++r)negm[r]=-mhat; asm volatile("":"+v"(negm)); } \
    _Pragma("unroll") for(int r=0;r<16;++r)P0[r]=__builtin_amdgcn_exp2f(P0[r]); }while(0)
  #define RESC() do{ if(resc){ asm volatile("s_waitcnt lgkmcnt(0)":::"memory"); \
      _Pragma("unroll") for(int d_=0;d_<2;++d_) _Pragma("unroll") for(int r=0;r<16;++r)o[d_][r]*=wsf[crow(r,hi)]; } }while(0)
  f32x16 pA0,pA1,pB0,pB1;
  int sl_prev=0,sl_cur=0,sl_next=SLOTB;
  #define ROT() do{sl_prev=sl_cur;sl_cur=sl_next;sl_next=(sl_next==(NSLOT-1)*SLOTB)?0:sl_next+SLOTB;}while(0)
  DMA_K(2,2*SLOTB);
  WAIT_BAR(3);
  qkt(pA0,pA1,Kbase,qr,negm,r32,hi);asm volatile("s_nop 15\n\ts_nop 7":"+v"(pA0),"+v"(pA1));CMASK(pA0,pA1,0);
  START(pA0,pA1);
  _Pragma("unroll") for(int r=0;r<16;++r)pA1[r]=__builtin_amdgcn_exp2f(pA1[r]);
  WAIT_BAR(0);
  DMA_K(3,0);DMA_V(1,SLOTB);
  ROT();
  kload8(kf,kp0+sl_cur);
  WAIT_BAR(2);
  s16x4 vlo[8],vhi[8]; u32x4 pw0,pw1,pw2,pw3;
  #define PKW(P,B) cvtpk_s(P[B],P[B+1])
  #define PAF(k) __builtin_bit_cast(bf16x8,pw##k)
  #define VFR(i) (bf16x8){vlo[i][0],vlo[i][1],vlo[i][2],vlo[i][3],vhi[i][0],vhi[i][1],vhi[i][2],vhi[i][3]}
  #define PIN(x) asm volatile("":"+v"(x))
  #define MX3(a,b,c) __builtin_fmaxf(__builtin_fmaxf((a),(b)),(c))
  #define GAPA(MF,A0,A1,A2,A3,W0,W1,PW) do{ MF; sacc+=A0; sacc+=A1; sacc+=A2; sacc+=A3; PIN(sacc); W0; W1; PIN(PW); SBAR(); }while(0)
  #define EX(v) __builtin_amdgcn_exp2f(v)
  #define GAPB(MF,X,B) do{ MF; X[B]=EX(X[B]); X[B+1]=EX(X[B+1]); X[B+2]=EX(X[B+2]); X[B+3]=EX(X[B+3]); PIN(X); SBAR(); }while(0)
  #define VRD(i) do{ vlo[i]=vtr(vp_+(((i)>>2)*4096+((i)&3)*1024)); vhi[i]=vtr(vp_+(((i)>>2)*4096+((i)&3)*1024+512)); }while(0)
  #define KRD(G,j) do{ if(G){ kload2(kf,kp0+sl_next,j); SBAR(); } }while(0)
  #define STEP(C0,C1,P0,P1,t,GK,GV,GL) do{ SBAR(); \
    const lds_cptr vp_=vp0+sl_prev; \
    VRD(0); SBAR(); float sacc=(P0[0]+P0[1]); \
    GAPA(C0=__builtin_amdgcn_mfma_f32_32x32x16_bf16(kf[0],qr[0],negm,0,0,0), P0[2],P0[3],P0[4],P0[5],     pw0[0]=PKW(P0,0), pw0[1]=PKW(P0,2), pw0); \
    VRD(4); SBAR(); GAPA(C1=__builtin_amdgcn_mfma_f32_32x32x16_bf16(kf[1],qr[0],negm,0,0,0), P0[6],P0[7],P0[8],P0[9],     pw0[2]=PKW(P0,4), pw0[3]=PKW(P0,6), pw0); \
    VRD(1); SBAR(); GAPA(C0=__builtin_amdgcn_mfma_f32_32x32x16_bf16(kf[2],qr[1],C0,0,0,0),   P0[10],P0[11],P0[12],P0[13], pw1[0]=PKW(P0,8), pw1[1]=PKW(P0,10), pw1); \
    VRD(5); SBAR(); GAPA(C1=__builtin_amdgcn_mfma_f32_32x32x16_bf16(kf[3],qr[1],C1,0,0,0),   P0[14],P0[15],P1[0],P1[1],   pw1[2]=PKW(P0,12),pw1[3]=PKW(P0,14), pw1); \
    VRD(2); SBAR(); GAPA(C0=__builtin_amdgcn_mfma_f32_32x32x16_bf16(kf[4],qr[2],C0,0,0,0),   P1[2],P1[3],P1[4],P1[5],     pw2[0]=PKW(P1,0), pw2[1]=PKW(P1,2), pw2); \
    VRD(6); SBAR(); GAPA(C1=__builtin_amdgcn_mfma_f32_32x32x16_bf16(kf[5],qr[2],C1,0,0,0),   P1[6],P1[7],P1[8],P1[9],     pw2[2]=PKW(P1,4), pw2[3]=PKW(P1,6), pw2); \
    VRD(3); SBAR(); GAPA(C0=__builtin_amdgcn_mfma_f32_32x32x16_bf16(kf[6],qr[3],C0,0,0,0),   P1[10],P1[11],P1[12],P1[13], pw3[0]=PKW(P1,8), pw3[1]=PKW(P1,10), pw3); \
    VRD(7); SBAR(); GAPA(C1=__builtin_amdgcn_mfma_f32_32x32x16_bf16(kf[7],qr[3],C1,0,0,0),   P1[14],P1[15],0.f,0.f,       pw3[2]=PKW(P1,12),pw3[3]=PKW(P1,14), pw3); \
    l_reg+=sacc; \
    if(GK){DMA_K((t)+3,sl_cur);} if(GV){DMA_V((t)+1,sl_next);} \
    CMASK(C0,C1,t); \
    { float a=MX3(C0[0],C0[1],C1[0]),b=MX3(C0[2],C0[3],C1[1]); a=MX3(a,C1[2],C1[3]); \
      _Pragma("unroll") for(int r=4;r<16;r+=4){a=MX3(a,C0[r],C0[r+1]);b=MX3(b,C0[r+2],C0[r+3]);a=MX3(a,C1[r],C1[r+1]);b=MX3(b,C1[r+2],C1[r+3]);} \
      float rm=__builtin_fmaxf(a,b); { auto rr=__builtin_amdgcn_permlane32_swap(__float_as_uint(rm),__float_as_uint(rm),false,false); rm=__builtin_fmaxf(__uint_as_float(rr[0]),__uint_as_float(rr[1])); } \
      resc=false; \
      if(__builtin_expect(__any(rm>(float)THRL),0)){ const float dl=__builtin_fmaxf(rm,0.f); mhat+=dl; \
        _Pragma("unroll") for(int r=0;r<16;++r){C0[r]-=dl;C1[r]-=dl;} \
        _Pragma("unroll") for(int r=0;r<16;++r)negm[r]=-mhat; asm volatile("":"+v"(negm)); \
        const float f=__builtin_amdgcn_exp2f(-dl); l_reg*=f; if(hi==0)wsf[r32]=f; resc=true; } } \
    SBAR(); \
    GAPB(o[0]=__builtin_amdgcn_mfma_f32_32x32x16_bf16(PAF(0),VFR(0),o[0],0,0,0), C0,0); \
    GAPB(o[1]=__builtin_amdgcn_mfma_f32_32x32x16_bf16(PAF(0),VFR(4),o[1],0,0,0), C0,4); \
    KRD(GL,0); GAPB(o[0]=__builtin_amdgcn_mfma_f32_32x32x16_bf16(PAF(1),VFR(1),o[0],0,0,0), C0,8); \
    KRD(GL,1); GAPB(o[1]=__builtin_amdgcn_mfma_f32_32x32x16_bf16(PAF(1),VFR(5),o[1],0,0,0), C0,12); \
    KRD(GL,2); GAPB(o[0]=__builtin_amdgcn_mfma_f32_32x32x16_bf16(PAF(2),VFR(2),o[0],0,0,0), C1,0); \
    KRD(GL,3); GAPB(o[1]=__builtin_amdgcn_mfma_f32_32x32x16_bf16(PAF(2),VFR(6),o[1],0,0,0), C1,4); \
    GAPB(o[0]=__builtin_amdgcn_mfma_f32_32x32x16_bf16(PAF(3),VFR(3),o[0],0,0,0), C1,8); \
    GAPB(o[1]=__builtin_amdgcn_mfma_f32_32x32x16_bf16(PAF(3),VFR(7),o[1],0,0,0), C1,12); \
    }while(0)
  int t=1;
  #undef CMASK
  #define CMASK(P0,P1,t) do{}while(0)
  for(;t+5<NT;t+=2){
    STEP(pB0,pB1,pA0,pA1,t,true,true,true);     WAIT_BAR(2); RESC(); ROT();
    STEP(pA0,pA1,pB0,pB1,t+1,true,true,true);   WAIT_BAR(2); RESC(); ROT();
  }
  #undef CMASK
  #define CMASK(P0,P1,t) do{ if((t)>=NT-2) kmask(P0,P1,(t)==NT-1); }while(0)
  #define ENDW(tt) do{ if((tt)+3<NT){WAIT_BAR(2);} else if((tt)+2<NT){WAIT_BAR(1);} else {WAIT_BAR(0);} }while(0)
  for(;t+1<NT;t+=2){
    STEP(pB0,pB1,pA0,pA1,t,(t+3<NT),(t+1<NT),(t+1<NT));       ENDW(t);   RESC(); ROT();
    STEP(pA0,pA1,pB0,pB1,t+1,(t+4<NT),(t+2<NT),(t+2<NT));     ENDW(t+1); RESC(); ROT();
  }
  STEP(pB0,pB1,pA0,pA1,NT-1,false,false,false); RESC();
  { float sacc=pB0[0]+pB0[1]; _Pragma("unroll") for(int r=2;r<16;++r)sacc+=pB0[r]; _Pragma("unroll") for(int r=0;r<16;++r)sacc+=pB1[r]; l_reg+=sacc;
    pw0=(u32x4){PKW(pB0,0),PKW(pB0,2),PKW(pB0,4),PKW(pB0,6)};pw1=(u32x4){PKW(pB0,8),PKW(pB0,10),PKW(pB0,12),PKW(pB0,14)};pw2=(u32x4){PKW(pB1,0),PKW(pB1,2),PKW(pB1,4),PKW(pB1,6)};pw3=(u32x4){PKW(pB1,8),PKW(pB1,10),PKW(pB1,12),PKW(pB1,14)};
    SBAR(); pv(o,vb0+sl_cur,PAF(0),PAF(1),PAF(2),PAF(3)); }
  #undef PKW
  #undef PAF
  #undef VFR
  #undef PIN
  #undef MX3
  #undef GAPA
  #undef GAPB
  #undef EX
  #undef VRD
  #undef KRD
  #undef STEP
  #undef ENDW
  {auto rr=__builtin_amdgcn_permlane32_swap(__float_as_uint(l_reg),__float_as_uint(l_reg),false,false);l_reg=__uint_as_float(rr[0])+__uint_as_float(rr[1]);}
  if(hi==0)wsf[32+r32]=l_reg;asm volatile("s_waitcnt lgkmcnt(0)":::"memory");
  float rli[16];
  #pragma unroll
  for(int r=0;r<16;++r)rli[r]=__builtin_amdgcn_rcpf(wsf[32+crow(r,hi)]);
  bf16*Ow=Oblk+(long)(wid*QBLK)*QP;
  { bf16*stg=(bf16*)(shm+LDS_OST)+wid*2048;
    #pragma unroll
    for(int r=0;r<16;++r){const int orow=crow(r,hi);
      #pragma unroll
      for(int d0=0;d0<2;++d0)stg[orow*64+d0*32+r32]=__float2bfloat16(o[d0][r]*rli[r]);}
    asm volatile("s_waitcnt lgkmcnt(0)":::"memory");
    #pragma unroll
    for(int i=0;i<4;++i){const int row=i*8+(lane>>3),ch=lane&7; const u32x4 v=*(const u32x4*)(stg+row*64+ch*8); ATTN_STORE16(Ow+(long)row*QP+ch*8,v);} }
  asm volatile("s_waitcnt lgkmcnt(0)\n\ts_barrier":::"memory");
  #undef DMA_K
  #undef DMA_V
  #undef CMASK
  #undef START
  #undef RESC
  #undef ROT
}
#undef SBAR
#undef WAIT_BAR
}
#define GAS __attribute__((address_space(1)))
#define LAS __attribute__((address_space(3)))
typedef unsigned short bf16;
typedef unsigned v4u __attribute__((ext_vector_type(4)));
typedef float f32x4 __attribute__((ext_vector_type(4)));
constexpr size_t MiB = 1u << 20;
constexpr size_t WS_CTL = 0, CTL_BYTES = 4096;
constexpr size_t WS_ROPE = 1 * MiB, WS_SS1 = 2 * MiB, WS_SS2 = 3 * MiB;
constexpr size_t WS_WIN = 4 * MiB, WS_WG = 10 * MiB, WS_WA = 11 * MiB, WS_WF = 12 * MiB, WS_WO = 13 * MiB, WS_WFFN = 15 * MiB, WS_WDN = 26 * MiB;
constexpr size_t WS_GA = 32 * MiB, WS_X1B = 32 * MiB, WS_Q = 416 * MiB, WS_KB = 512 * MiB, WS_VB = 537 * MiB, WS_GTP = 562 * MiB, WS_GTS = 596 * MiB;
constexpr size_t WS_CS = 661 * MiB, WS_SS = 731 * MiB, WS_CP = 801 * MiB, WS_SP = 807 * MiB, WS_H = 813 * MiB, WS_F = 813 * MiB, WS_DS = 909 * MiB, WS_DP = 977 * MiB, WS_END = 1017 * MiB;
constexpr size_t WS_U = 224 * MiB, WS_MG = 512 * MiB;
static_assert(WS_GA + (size_t)NTOK * 2048 * 2 <= WS_Q && WS_Q + (size_t)NTOK * 512 * 2 <= WS_KB && WS_KB + (KV_S_OFF + (size_t)16 * KPS * 64) * 2 <= WS_VB && WS_VB + (KV_S_OFF + (size_t)16 * KPS * 64) * 2 <= WS_GTP, "ws map 1");
static_assert(WS_GTP + (size_t)16 * 512 * KPP * 2 <= WS_GTS && WS_GTS + (size_t)8 * 512 * KPS * 2 <= WS_CS && WS_CS + (size_t)MTS * 256 * KPS * 2 <= WS_SS && WS_SS + (size_t)MTS * 256 * KPS * 2 <= WS_CP, "ws map 2");
static_assert(WS_CP + (size_t)MTP * 256 * KPP * 2 <= WS_SP && WS_SP + (size_t)MTP * 256 * KPP * 2 <= WS_H && WS_H + (size_t)(NTOK + 256) * 1024 * 2 <= WS_END && WS_F + (size_t)NTOK * 512 * 2 <= WS_DS && WS_DS + (size_t)272 * 262144 <= WS_DP && WS_DP + (size_t)160 * 262144 <= WS_END, "ws map 3");
static_assert(WS_U + (size_t)NTOK * 2816 * 2 <= WS_END && WS_X1B + (size_t)NTOK * 1024 * 2 <= WS_U && WS_MG + (size_t)NTOK * 1024 * 2 <= WS_F && WS_WDN + (size_t)1024 * 2816 * 2 <= WS_GA && WS_WFFN + (size_t)5632 * 1024 * 2 <= WS_WDN && WS_WIN + (size_t)2816 * 1024 * 2 <= WS_WG, "ws map 4");
constexpr int LDS_BYTES = 147456, MISC_OFF = 131072 + 320;
constexpr int NATT = 3072;

__device__ __forceinline__ unsigned f2bf(float f) { unsigned u = __builtin_bit_cast(unsigned, f); return (u + 0x7fffu + ((u >> 16) & 1u)) >> 16; }
__device__ __forceinline__ unsigned pk2(float lo, float hi) { return f2bf(lo) | (f2bf(hi) << 16); }
__device__ __forceinline__ float wave_sum(float v) {
#pragma unroll
    for (int o = 1; o < 64; o <<= 1) v += __shfl_xor(v, o);
    return v; }

__device__ __forceinline__ int src_col(int mat, int n) {
    if (mat == 0) {
        if (n >= 768) return 1280 + (n - 768);
        const int ct = n & 255, bj = ct >> 7, wc = (ct >> 5) & 3, fq = (ct >> 3) & 3, nn = (ct >> 2) & 1, j = ct & 3;
        if (n < 512) return ((n >> 8) * 4 + wc) * 64 + 32 * bj + 16 * nn + 4 * fq + j;
        if (wc < 2) return 512 + wc * 64 + 32 * bj + 16 * nn + 4 * fq + j;
        return 640 + (wc - 2) * 64 + 32 * bj + 8 * fq + 4 * nn + j;
    }
    if (mat == 4) { const int pn = n >> 8, ct = n & 255, nn = (ct >> 2) & 1, j = ct & 3, q8 = ct >> 3; return (nn ? 2816 : 0) + 128 * pn + 4 * q8 + j; }
    return n;
}
__device__ __forceinline__ void tr_item(const float* W, int ldw, int K, int ND, bf16* WT, int mat, const float* ksc, LAS float* scr, int item, int lane) {
    const int nblk = ND / 32, kb = item / nblk, nb = item % nblk, k0 = 64 * kb, n0 = 32 * nb;
    const int sc = src_col(mat, n0 + (lane & 31));
#pragma unroll 8
    for (int i = 0; i < 32; ++i) { const int kk = 2 * i + (lane >> 5); float v = W[(size_t)(k0 + kk) * ldw + sc]; if (ksc) v *= ksc[k0 + kk]; scr[kk * 33 + (lane & 31)] = v; }
    asm volatile("s_waitcnt lgkmcnt(0)" ::: "memory");
    const int c = lane & 7;
#pragma unroll
    for (int j = 0; j < 4; ++j) { const int n = (lane >> 3) + 8 * j; const LAS float* s = scr + (8 * c) * 33 + n;
        v4u o; o.x = pk2(s[0 * 33], s[1 * 33]); o.y = pk2(s[2 * 33], s[3 * 33]); o.z = pk2(s[4 * 33], s[5 * 33]); o.w = pk2(s[6 * 33], s[7 * 33]);
        *(v4u*)(WT + (size_t)(n0 + n) * K + k0 + 8 * c) = o; }
    asm volatile("s_waitcnt lgkmcnt(0)" ::: "memory");
}
__device__ __forceinline__ void rms_row_bf16(const float* xrow, const float* g, bf16* orow, int lane) {
    const f32x4* xr = (const f32x4*)xrow + lane; const f32x4* gr = (const f32x4*)g + lane;
    f32x4 v[4]; float s = 0.f;
#pragma unroll
    for (int j = 0; j < 4; ++j) { v[j] = xr[64 * j]; s += (v[j].x * v[j].x + v[j].y * v[j].y) + (v[j].z * v[j].z + v[j].w * v[j].w); }
    const float rstd = rsqrtf(wave_sum(s) * (1.f / 1024.f) + EPS);
    unsigned long long* o8 = (unsigned long long*)orow + lane;
#pragma unroll
    for (int j = 0; j < 4; ++j) { const f32x4 gg = gr[64 * j]; o8[64 * j] = (unsigned long long)pk2(v[j].x * rstd * gg.x, v[j].y * rstd * gg.y) | ((unsigned long long)pk2(v[j].z * rstd * gg.z, v[j].w * rstd * gg.w) << 32); }
}
__device__ __forceinline__ void dft_fill(bf16* C, bf16* S, int rows, int KP_, int L, long gtid, long nthr) {
    const int per_row = KP_ / 8; const long items = (long)rows * per_row; const float inv = 2.0f / (float)L;
    for (long it = gtid; it < items; it += nthr) { const int r = (int)(it / per_row), k0 = (int)(it % per_row) * 8;
        const int l0 = k0 < 16 ? k0 : k0 - 48; const bool rv = (r >= 1 && r <= L / 2) && !(k0 >= 16 && k0 < 64);
        unsigned cw[4], sw[4]; int m = rv ? (int)(((long)r * l0) % L) : 0;
#pragma unroll
        for (int e = 0; e < 4; ++e) { float c0 = 0.f, s0 = 0.f, c1 = 0.f, s1 = 0.f;
            if (rv && l0 + 2 * e < L) sincospif((float)m * inv, &s0, &c0);
            m += r; if (m >= L) m -= L;
            if (rv && l0 + 2 * e + 1 < L) sincospif((float)m * inv, &s1, &c1);
            m += r; if (m >= L) m -= L;
            cw[e] = pk2(c0, c1); sw[e] = pk2(s0, s1); }
        *(v4u*)(C + (size_t)r * KP_ + k0) = (v4u){cw[0], cw[1], cw[2], cw[3]}; *(v4u*)(S + (size_t)r * KP_ + k0) = (v4u){sw[0], sw[1], sw[2], sw[3]}; }
}

__device__ __forceinline__ void my_bar(unsigned* cnt, unsigned target) {
    __syncthreads();
    if (threadIdx.x == 0) {
        __builtin_amdgcn_fence(__ATOMIC_RELEASE, "agent");
        __hip_atomic_fetch_add(cnt, 1u, __ATOMIC_RELAXED, __HIP_MEMORY_SCOPE_AGENT);
        while (__hip_atomic_load(cnt, __ATOMIC_RELAXED, __HIP_MEMORY_SCOPE_AGENT) < target) __builtin_amdgcn_s_sleep(2);
        __builtin_amdgcn_fence(__ATOMIC_ACQUIRE, "agent");
    }
    __syncthreads();
}
struct Args { const float* in[14]; float* out; unsigned char* ws; };

#if CHECKS
#define BF(v) (__uint_as_float(((unsigned)(v)) << 16))
__device__ __forceinline__ void chk(unsigned* ctl, int stage, float got, float ref, float rt) {
    const bool bad = !(fabsf(got - ref) <= rt * (1.0f + fabsf(ref)));
    const unsigned long long m = __ballot(bad);
    if ((threadIdx.x & 63) == 0 && m) atomicAdd(ctl + 200 + stage, (unsigned)__popcll(m));
}
__device__ __forceinline__ void tok_geom(int t, int& seq, int& p) { if (t < P_TOK) { seq = t >> 11; p = t & 2047; } else { seq = 16 + ((t - P_TOK) >> 13); p = (t - P_TOK) & 8191; } }
#define RUN_CHECKS(stage) do { run_checks((stage), bx * 8 + wave, lane); GRID_SYNC(); } while (0)
__device__ __forceinline__ void run_checks(int stage, int gw, int lane) {
    typedef __attribute__((address_space(4))) const Args CArgs;
    CArgs* ap_ = (CArgs*)__builtin_amdgcn_kernarg_segment_ptr(); unsigned char* ws = ap_->ws; unsigned* ctl = (unsigned*)(ws + WS_CTL);
    const int t = (int)(((long)gw * 48 + (gw >> 3)) % NTOK); int seq, p; tok_geom(t, seq, p);
    if (stage == 1) {
        const bf16* hrow = (const bf16*)(ws + WS_H) + (size_t)t * 1024; const float* w_in = ap_->in[4]; const int c = lane * 32 + (gw & 31);
        float z = 0.f; for (int k = 0; k < 1024; ++k) z += BF(hrow[k]) * w_in[(size_t)k * 3328 + 1280 + c];
        chk(ctl, 1, BF(((const bf16*)(ws + WS_GA))[(size_t)t * 2048 + c]), 1.f / (1.f + expf(-z)), 0.02f);
        { const float* xr = t < P_TOK ? ap_->in[0] + (size_t)t * 1024 : ap_->in[1] + (size_t)(t - P_TOK) * 1024; float s = 0.f; for (int k = lane; k < 1024; k += 64) s += xr[k] * xr[k];
          s = wave_sum(s); const float rs = rsqrtf(s * (1.f / 1024.f) + EPS); const int k = lane * 16 + (gw & 15); chk(ctl, 0, BF(hrow[k]), xr[k] * rs * ap_->in[3][k], 0.01f); }
    } else if (stage == 2) {
        const int L = seq < 16 ? LP : LS, lp = 16 + p, KP_ = seq < 16 ? KPP : KPS; const float scale = rsqrtf((float)L * 128.0f);
        const int c = lane * 8 + (gw & 7), g = c >> 7, cp = c & 127;
        const int rc = cp <= 64 ? cp : 128 - cp, rs_ = (cp == 0 || cp == 64) ? -1 : (cp < 64 ? 64 + cp : 192 - cp); const float sg = cp < 64 ? 1.f : -1.f;
        const bf16* gb = seq < 16 ? (const bf16*)(ws + WS_GTP) + ((size_t)seq * 512 + g * 128) * KPP : (const bf16*)(ws + WS_GTS) + ((size_t)(seq - 16) * 512 + g * 128) * KPS;
        float a = 0.f; int m = 0;
        for (int l = 0; l < L; ++l) { const int ph = l < 16 ? l : l + 48; float sn, cs; sincospif(2.0f * (float)m / (float)L, &sn, &cs);
            a += cs * BF(gb[(size_t)rc * KP_ + ph]); if (rs_ >= 0) a -= sg * sn * BF(gb[(size_t)rs_ * KP_ + ph]);
            m += lp; if (m >= L) m -= L; }
        chk(ctl, 2, BF(((const bf16*)(ws + WS_F))[(size_t)t * 512 + c]), a * scale, 0.04f);
    } else if (stage == 3) {
        const int c = lane * 16 + (gw & 15); float a = 0.f, f = 0.f;
        for (int k = 0; k < 512; ++k) { a += BF(((const bf16*)(ws + WS_Q))[(size_t)t * 512 + k]) * ap_->in[7][(size_t)k * 1024 + c]; f += BF(((const bf16*)(ws + WS_F))[(size_t)t * 512 + k]) * ap_->in[8][(size_t)k * 1024 + c]; }
        const bf16* ga = (const bf16*)(ws + WS_GA) + (size_t)t * 2048;
        chk(ctl, 3, BF(((const bf16*)(ws + WS_MG))[(size_t)t * 1024 + c]), BF(ga[c]) * a + BF(ga[1024 + c]) * f, 0.03f);
    } else if (stage == 4) {
        const float* xr = t < P_TOK ? ap_->in[0] + (size_t)t * 1024 : ap_->in[1] + (size_t)(t - P_TOK) * 1024; const float* o = ap_->out + (size_t)t * 1024;
        const int c = lane * 16 + (gw & 15); float a = 0.f; for (int k = 0; k < 1024; ++k) a += BF(((const bf16*)(ws + WS_MG))[(size_t)t * 1024 + k]) * ap_->in[9][(size_t)k * 1024 + c];
        chk(ctl, 4, o[c], xr[c] + a, 0.02f);
        chk(ctl, 4, BF(((const bf16*)(ws + WS_X1B))[(size_t)t * 1024 + c]), o[c], 0.01f);
        { float s = 0.f; for (int cc = lane; cc < 1024; cc += 64) s += o[cc] * o[cc]; s = wave_sum(s); chk(ctl, 4, ((const float*)(ws + WS_SS1))[t], s, 0.002f); }
    } else if (stage == 5) {
        const bf16* xb = (const bf16*)(ws + WS_X1B) + (size_t)t * 1024; const float rs = rsqrtf(((const float*)(ws + WS_SS1))[t] * (1.f / 1024.f) + EPS);
        const int j = lane * 44 + (gw % 44); float g = 0.f, u = 0.f;
        for (int k = 0; k < 1024; ++k) { const float xv = BF(xb[k]) * ap_->in[10][k]; g += xv * ap_->in[11][(size_t)k * 5632 + j]; u += xv * ap_->in[11][(size_t)k * 5632 + 2816 + j]; }
        g *= rs; u *= rs;
        chk(ctl, 5, BF(((const bf16*)(ws + WS_U))[(size_t)t * 2816 + j]), g / (1.f + expf(-g)) * u, 0.03f);
    } else if (stage == 6) {
        const int c = lane * 16 + (gw & 15); float a = 0.f; for (int k = 0; k < 2816; ++k) a += BF(((const bf16*)(ws + WS_U))[(size_t)t * 2816 + k]) * ap_->in[12][(size_t)k * 1024 + c];
        const float* o = ap_->out + (size_t)t * 1024;
        chk(ctl, 6, o[c], BF(((const bf16*)(ws + WS_X1B))[(size_t)t * 1024 + c]) + a, 0.03f);
        { float s = 0.f; for (int cc = lane; cc < 1024; cc += 64) s += o[cc] * o[cc]; s = wave_sum(s); chk(ctl, 6, ((const float*)(ws + WS_SS2))[t], s, 0.002f); }
    }
}
#else
#define RUN_CHECKS(stage) do {} while (0)
#endif

__global__ void __launch_bounds__(512, 2) enc_fwd(Args args) {
    extern __shared__ __attribute__((aligned(16))) unsigned char lds[];
    cg::grid_group grid = cg::this_grid();
    LAS unsigned char* L3 = (LAS unsigned char*)lds;
    volatile LAS unsigned* MISC = (volatile LAS unsigned*)(L3 + MISC_OFF);
    const int tid = threadIdx.x, lane = tid & 63, wave = __builtin_amdgcn_readfirstlane(tid >> 6);
    const int G = gridDim.x, bx = blockIdx.x; int nsync_ = 0;
    typedef __attribute__((address_space(4))) const Args CArgs;
#define LOAD_ARGS() CArgs* ap_ = (CArgs*)__builtin_amdgcn_kernarg_segment_ptr(); asm volatile("" : "+s"(ap_)); unsigned char* ws = ap_->ws; (void)ws
#define WSP(T, off) ((T*)(ws + (off)))
#define AIN(i) (ap_->in[i])
#define AOUT() (ap_->out)
#define GRID_SYNC() do { asm volatile("s_waitcnt vmcnt(0) lgkmcnt(0)" ::: "memory"); grid.sync(); ++nsync_; my_bar(WSPC(unsigned, WS_CTL) + 128, (unsigned)nsync_ * (unsigned)G); __builtin_amdgcn_fence(__ATOMIC_ACQUIRE, "agent"); asm volatile("s_waitcnt vmcnt(0)" ::: "memory"); } while (0)
#define WSPC(T, off) ((T*)(((CArgs*)__builtin_amdgcn_kernarg_segment_ptr())->ws + (off)))

#if (PHM>>0)&1
    { LOAD_ARGS();
        const int gw = bx * 8 + wave, NGW = G * 8; const long gtid = (long)bx * 512 + tid, nthr = (long)G * 512;
        LAS float* tab = (LAS float*)L3;
        if (tid < 128) { tab[tid] = cospif((float)tid * (1.0f / 64.0f)); }
        __syncthreads();
        LAS float* scr = (LAS float*)(L3 + 1024 + wave * 8704);
        constexpr int I0 = 16 * 88, I1 = 8 * 32, I2 = 8 * 32, I3 = 16 * 32, I4 = 16 * 176, I5 = 44 * 32;
        for (int it = gw; it < I0 + I1 + I2 + I3 + I4 + I5; it += NGW) { int r = it;
            if (r < I0) { tr_item(AIN(4), 3328, 1024, 2816, WSP(bf16, WS_WIN), 0, nullptr, scr, r, lane); continue; } r -= I0;
            if (r < I1) { tr_item(AIN(7), 1024, 512, 1024, WSP(bf16, WS_WA), 1, nullptr, scr, r, lane); continue; } r -= I1;
            if (r < I2) { tr_item(AIN(8), 1024, 512, 1024, WSP(bf16, WS_WF), 2, nullptr, scr, r, lane); continue; } r -= I2;
            if (r < I3) { tr_item(AIN(9), 1024, 1024, 1024, WSP(bf16, WS_WO), 3, nullptr, scr, r, lane); continue; } r -= I3;
            if (r < I4) { tr_item(AIN(11), 5632, 1024, 5632, WSP(bf16, WS_WFFN), 4, AIN(10), scr, r, lane); continue; } r -= I4;
            tr_item(AIN(12), 1024, 2816, 1024, WSP(bf16, WS_WDN), 5, nullptr, scr, r, lane); }
        for (long id = gtid; id < 512 * 128; id += nthr) { const int chunk = (int)id & 127, row = (int)id >> 7, s = row & 127, g = row >> 7, k = chunk * 8;
            const float* wr_ = AIN(4) + (size_t)k * 3328 + 768 + g * 128; float a[8];
#pragma unroll
            for (int j = 0; j < 8; ++j) a[j] = 0.f;
            const int sm = s <= 64 ? s : s - 64, sh = s <= 64 ? 0 : 96;
            for (int c = 0; c < 128; ++c) { const float tv = tab[(c * sm + sh) & 127];
#pragma unroll
                for (int j = 0; j < 8; ++j) a[j] += wr_[(size_t)j * 3328 + c] * tv; }
            *(v4u*)(WSP(bf16, WS_WG) + (size_t)row * 1024 + k) = (v4u){pk2(a[0], a[1]), pk2(a[2], a[3]), pk2(a[4], a[5]), pk2(a[6], a[7])}; }
        for (int m = gw; m < NTOK + 256; m += NGW) {
            bf16* orow = WSP(bf16, WS_H) + (size_t)m * 1024;
            if (m < P_TOK) rms_row_bf16(AIN(0) + (size_t)m * 1024, AIN(3), orow, lane);
            else if (m < NTOK) rms_row_bf16(AIN(1) + (size_t)(m - P_TOK) * 1024, AIN(3), orow, lane);
            else if (m < NTOK + 16) rms_row_bf16(AIN(2) + (size_t)(m - NTOK) * 1024, AIN(3), orow, lane);
            else { unsigned long long* o8 = (unsigned long long*)orow + lane;
#pragma unroll
                for (int j = 0; j < 4; ++j) o8[64 * j] = 0ull; } }
        dft_fill(WSP(bf16, WS_CS), WSP(bf16, WS_SS), MTS * 256, KPS, LS, gtid, nthr);
        dft_fill(WSP(bf16, WS_CP), WSP(bf16, WS_SP), MTP * 256, KPP, LP, gtid, nthr);
        for (long id = gtid; id < 130 * 16; id += nthr) { const int pp = (int)id >> 4, i = (int)id & 15;
            const double ang = (double)(pp - 1) * pow(10000.0, -(double)i / 16.0);
            WSP(float, WS_ROPE)[pp * 32 + i] = (float)cos(ang); WSP(float, WS_ROPE)[pp * 32 + 16 + i] = (float)sin(ang); }
        for (long id = gtid; id < NTOK; id += nthr) { WSP(float, WS_SS1)[id] = 0.f; WSP(float, WS_SS2)[id] = 0.f; }
        for (long id = gtid; id < 48L * 112 * 8; id += nthr) { const int g = (int)(id / 896), rem = (int)(id % 896), r = rem >> 3, ch = rem & 7;
            const int seq = g >> 1, kvh = g & 1; const size_t off = pg8::kvoff(seq, kvh) + (size_t)(pg8::seqlen(seq) + 16 + r) * 64 + ch * 8;
            *(v4u*)(WSP(bf16, WS_KB) + off) = (v4u){0u, 0u, 0u, 0u}; *(v4u*)(WSP(bf16, WS_VB) + off) = (v4u){0u, 0u, 0u, 0u}; }
        for (long id = gtid; id < 24L * 512 * 8; id += nthr) { const int row = (int)(id >> 3), ch = (int)(id & 7), seq = row >> 9, c = row & 511;
            bf16* d = seq < 16 ? WSP(bf16, WS_GTP) + ((size_t)seq * 512 + c) * KPP + 64 + 2048 : WSP(bf16, WS_GTS) + ((size_t)(seq - 16) * 512 + c) * KPS + 64 + 8192;
            *(v4u*)(d + ch * 8) = (v4u){0u, 0u, 0u, 0u}; }
        asm volatile("s_waitcnt vmcnt(0) lgkmcnt(0)" ::: "memory");
    }
#endif
    GRID_SYNC();
    RUN_CHECKS(0);

#if (PHM>>1)&1
    { LOAD_ARGS();
        pg8::Gemm g{WSP(bf16, WS_H), WSP(bf16, WS_WIN), NTOK + 256, 2816, 1024}; pg8::G1Order S; S.init(G, bx);
        pg8::EpiG1 E; E.Q = WSP(bf16, WS_Q); E.KB = WSP(bf16, WS_KB); E.VB = WSP(bf16, WS_VB); E.GA = WSP(bf16, WS_GA); E.rope = WSP(float, WS_ROPE); E.gq = AIN(5); E.gk = AIN(6);
        pg8::gemm_phase<pg8::EpiG1, pg8::G1Order, PG_ALIGN, PG_SP2>(L3, g, S, E);
    }
#endif
#if (PHM>>2)&1
    { LOAD_ARGS();
        pg8::Gemm g{WSP(bf16, WS_WG), WSP(bf16, WS_H), 512, NTOK + 256, 1024}; pg8::StaticOrder S; S.init(512, NTOK + 256, G, G - 1 - bx);
        pg8::EpiGT E; E.GTp = WSP(bf16, WS_GTP); E.GTs = WSP(bf16, WS_GTS);
        pg8::gemm_phase<pg8::EpiGT, pg8::StaticOrder, PG_ALIGN, PG_SP2>(L3, g, S, E);
    }
#endif
    GRID_SYNC();
    RUN_CHECKS(1);

#if (PHM>>3)&1
    for (int ps = 0; ps < 2; ++ps) { LOAD_ARGS();
        const int K = ps ? KPP : KPS, nMt = ps ? MTP : MTS, Lq = ps ? LP : LS;
        pg8::DftOrder S; S.G = G; S.c = ps ? (bx + G - 16) % G : bx; S.total = ps ? 160 : 272; S.sample = !ps;
        { pg8::Gemm g{ps ? WSP(bf16, WS_CP) : WSP(bf16, WS_CS), ps ? WSP(bf16, WS_GTP) : WSP(bf16, WS_GTS), nMt * 256, ps ? 16 * 512 : 8 * 512, K};
          pg8::EpiDftP E; E.dump = ps ? WSP(float, WS_DP) : WSP(float, WS_DS); E.nMt = nMt;
          pg8::gemm_phase<pg8::EpiDftP, pg8::DftOrder, PG_ALIGN, PG_SP2>(L3, g, S, E); }
        { pg8::Gemm g{ps ? WSP(bf16, WS_SP) : WSP(bf16, WS_SS), ps ? WSP(bf16, WS_GTP) : WSP(bf16, WS_GTS), nMt * 256, ps ? 16 * 512 : 8 * 512, K};
          pg8::EpiDftQ E; E.dump = ps ? WSP(float, WS_DP) : WSP(float, WS_DS); E.nMt = nMt; E.F = WSP(bf16, WS_F); E.L = Lq; E.tokbase = ps ? 0 : P_TOK; E.nseq = ps ? 2048 : 8192; E.scale = rsqrtf((float)Lq * 128.0f);
          pg8::gemm_phase<pg8::EpiDftQ, pg8::DftOrder, PG_ALIGN, PG_SP2>(L3, g, S, E); }
    }
#endif
#if (PHM>>4)&1
    for (;;) { LOAD_ARGS();
        if (tid == 0) MISC[0] = atomicAdd(WSP(unsigned, WS_CTL) + 64, 1u);
        __syncthreads();
        const int idx = (int)MISC[0];
        __syncthreads();
        if (idx >= NATT) break;
        int tok0, NT, hq; size_t kvo;
        if (idx < 2048) { const int gk = idx >> 7, r = idx & 127, b = gk >> 1, kvh = gk & 1; hq = kvh * 4 + (r >> 5); tok0 = P_TOK + b * 8192 + (r & 31) * 256; NT = 130; kvo = KV_S_OFF + (size_t)gk * KPS * 64; }
        else { const int j = idx - 2048, gk = j >> 5, r = j & 31, b = gk >> 1, kvh = gk & 1; hq = kvh * 4 + (r >> 3); tok0 = b * 2048 + (r & 7) * 256; NT = 34; kvo = (size_t)gk * KPP * 64; }
        attn_body::attn_unit<8>((const attn_body::bf16*)(WSP(bf16, WS_Q) + (size_t)tok0 * 512 + hq * 64), (const attn_body::bf16*)(WSP(bf16, WS_KB) + kvo), (const attn_body::bf16*)(WSP(bf16, WS_VB) + kvo), (attn_body::bf16*)(WSP(bf16, WS_Q) + (size_t)tok0 * 512 + hq * 64), NT, (char*)lds);
    }
#endif
    GRID_SYNC();
    RUN_CHECKS(2);

#if PROBE == 1
    {
        LOAD_ARGS();
        const long gtid = (long)bx * 512 + tid, nthr = (long)G * 512;
        for (long id = gtid; id < (long)NTOK * 128; id += nthr) { const long t = id >> 7; const int c = (int)(id & 127) * 8;
            const bf16* src = c < 512 ? WSP(bf16, WS_F) + t * 512 + c : WSP(bf16, WS_Q) + t * 512 + (c - 512);
            const v4u w = *(const v4u*)src; float* o = AOUT() + t * 1024 + c;
            o[0] = __uint_as_float(w.x << 16); o[1] = __uint_as_float(w.x & 0xffff0000u); o[2] = __uint_as_float(w.y << 16); o[3] = __uint_as_float(w.y & 0xffff0000u);
            o[4] = __uint_as_float(w.z << 16); o[5] = __uint_as_float(w.z & 0xffff0000u); o[6] = __uint_as_float(w.w << 16); o[7] = __uint_as_float(w.w & 0xffff0000u); }
        return;
    }
#endif
#if (PHM>>5)&1
    { LOAD_ARGS();
        pg8::StaticOrder S; S.init(NTOK, 1024, G, bx);
        { pg8::Gemm g{WSP(bf16, WS_Q), WSP(bf16, WS_WA), NTOK, 1024, 512}; pg8::EpiMerge<0> E; E.GA = WSP(bf16, WS_GA); E.MG = WSP(bf16, WS_MG);
          pg8::gemm_phase<pg8::EpiMerge<0>, pg8::StaticOrder, PG_ALIGN, PG_SP2>(L3, g, S, E); }
        { pg8::Gemm g{WSP(bf16, WS_F), WSP(bf16, WS_WF), NTOK, 1024, 512}; pg8::EpiMerge<1> E; E.GA = WSP(bf16, WS_GA); E.MG = WSP(bf16, WS_MG);
          pg8::gemm_phase<pg8::EpiMerge<1>, pg8::StaticOrder, PG_ALIGN, PG_SP2>(L3, g, S, E); }
    }
    GRID_SYNC();
    RUN_CHECKS(3);
#endif
#if PROBE == 4
    {
        LOAD_ARGS();
        const int gw = bx * 8 + wave, NGW = G * 8;
        for (int m = gw; m < NTOK; m += NGW) { const bf16* gr = WSP(bf16, WS_GA) + (size_t)m * 2048;
            const v4u a = *(const v4u*)(gr + lane * 8), b = *(const v4u*)(gr + 1024 + lane * 8);
            asm volatile("s_waitcnt vmcnt(0)" ::: "memory");
            float* o = AOUT() + (size_t)m * 1024 + lane * 8;
            o[0] = __uint_as_float(a.x << 16); o[1] = __uint_as_float(a.x & 0xffff0000u); o[2] = __uint_as_float(a.y << 16); o[3] = __uint_as_float(a.y & 0xffff0000u);
            o[4] = __uint_as_float(a.z << 16); o[5] = __uint_as_float(a.z & 0xffff0000u); o[6] = __uint_as_float(a.w << 16); o[7] = __uint_as_float(a.w & 0xffff0000u);
            o += 512;
            o[0] = __uint_as_float(b.x << 16); o[1] = __uint_as_float(b.x & 0xffff0000u); o[2] = __uint_as_float(b.y << 16); o[3] = __uint_as_float(b.y & 0xffff0000u);
            o[4] = __uint_as_float(b.z << 16); o[5] = __uint_as_float(b.z & 0xffff0000u); o[6] = __uint_as_float(b.w << 16); o[7] = __uint_as_float(b.w & 0xffff0000u); }
        return;
    }
#endif
#if PROBE == 3
    {
        LOAD_ARGS();
        const long gtid = (long)bx * 512 + tid, nthr = (long)G * 512;
        for (long id = gtid; id < (long)NTOK * 128; id += nthr) { const long t = id >> 7; const int c = (int)(id & 127) * 8;
            const v4u w = *(const v4u*)(WSP(bf16, WS_MG) + t * 1024 + c); float* o = AOUT() + t * 1024 + c;
            o[0] = __uint_as_float(w.x << 16); o[1] = __uint_as_float(w.x & 0xffff0000u); o[2] = __uint_as_float(w.y << 16); o[3] = __uint_as_float(w.y & 0xffff0000u);
            o[4] = __uint_as_float(w.z << 16); o[5] = __uint_as_float(w.z & 0xffff0000u); o[6] = __uint_as_float(w.w << 16); o[7] = __uint_as_float(w.w & 0xffff0000u); }
        return;
    }
#endif
#if (PHM>>6)&1
    { LOAD_ARGS();
        pg8::Gemm g{WSP(bf16, WS_MG), WSP(bf16, WS_WO), NTOK, 1024, 1024}; pg8::StaticOrder S; S.init(NTOK, 1024, G, bx);
        pg8::EpiX1 E; E.xp = AIN(0); E.xs = AIN(1); E.out = AOUT(); E.X1B = WSP(bf16, WS_X1B); E.ss1 = WSP(float, WS_SS1);
        pg8::gemm_phase<pg8::EpiX1, pg8::StaticOrder, PG_ALIGN, PG_SP2>(L3, g, S, E);
    }
#endif
    GRID_SYNC();
    RUN_CHECKS(4);
#if PROBE == 2
    return;
#endif
#if (PHM>>7)&1
    { LOAD_ARGS();
        pg8::Gemm g{WSP(bf16, WS_X1B), WSP(bf16, WS_WFFN), NTOK, 5632, 1024}; pg8::StaticOrder S; S.init(NTOK, 5632, G, bx);
        pg8::EpiF1 E; E.ss1 = WSP(float, WS_SS1); E.U = WSP(bf16, WS_U);
        pg8::gemm_phase<pg8::EpiF1, pg8::StaticOrder, PG_ALIGN, PG_SP2>(L3, g, S, E);
    }
#endif
    GRID_SYNC();
    RUN_CHECKS(5);
#if (PHM>>8)&1
    { LOAD_ARGS();
        pg8::Gemm g{WSP(bf16, WS_U), WSP(bf16, WS_WDN), NTOK, 1024, 2816}; pg8::StaticOrder S; S.init(NTOK, 1024, G, bx);
        pg8::EpiF2 E; E.out = AOUT(); E.ss2 = WSP(float, WS_SS2);
        pg8::gemm_phase<pg8::EpiF2, pg8::StaticOrder, PG_ALIGN, PG_SP2>(L3, g, S, E);
    }
#endif
    GRID_SYNC();
    RUN_CHECKS(6);
    { LOAD_ARGS();
        const int gw = bx * 8 + wave, NGW = G * 8; const f32x4* gf = (const f32x4*)AIN(13) + lane;
        for (int m = gw; m < NTOK; m += NGW) { f32x4* o = (f32x4*)(AOUT() + (size_t)m * 1024) + lane; const float rs = rsqrtf(__hip_atomic_load(WSP(float, WS_SS2) + m, __ATOMIC_RELAXED, __HIP_MEMORY_SCOPE_AGENT) * (1.f / 1024.f) + EPS);
#pragma unroll
            for (int j = 0; j < 4; ++j) o[64 * j] = o[64 * j] * rs * gf[64 * j]; }
    }
#if CHECKS
    { asm volatile("s_waitcnt vmcnt(0)" ::: "memory"); grid.sync(); LOAD_ARGS(); if (bx == 0 && tid == 0) { for (int st = 0; st < 7; ++st) { const unsigned v = __hip_atomic_load(WSP(unsigned, WS_CTL) + 200 + st, __ATOMIC_RELAXED, __HIP_MEMORY_SCOPE_AGENT);
        if (v) { AOUT()[0] = (float)st * 1e7f + 1e6f + 8e6f * (float)v / 131072.0f; break; } } } }
#endif
}

extern "C" void kernel_launch(void* const* d_in, const int* in_sizes, int n_in, void* d_out, int out_size, void* d_ws, size_t ws_size, hipStream_t stream) {
    static int grid = 0;
    if (grid == 0) {
        if (n_in != 14 || out_size != NTOK * 1024 || ws_size < WS_END) { fprintf(stderr, "kernel_launch: unexpected shapes: n_in %d out %d ws %zu (need %zu)\n", n_in, out_size, ws_size, (size_t)WS_END); grid = -1; return; }
        int dev = 0, cus = 0, per_cu = 0;
        hipGetDevice(&dev); hipDeviceGetAttribute(&cus, hipDeviceAttributeMultiprocessorCount, dev);
        if (hipFuncSetAttribute((const void*)enc_fwd, hipFuncAttributeMaxDynamicSharedMemorySize, LDS_BYTES) != hipSuccess) { fprintf(stderr, "kernel_launch: hipFuncSetAttribute failed\n"); grid = -1; return; }
        if (hipOccupancyMaxActiveBlocksPerMultiprocessor(&per_cu, (const void*)enc_fwd, 512, LDS_BYTES) != hipSuccess || per_cu < 1) { fprintf(stderr, "kernel_launch: occupancy query says %d\n", per_cu); per_cu = 1; }
        (void)hipGetLastError();
        grid = cus * per_cu;
    }
    if (grid < 0) return;
    hipMemsetAsync((char*)d_ws + WS_CTL, 0, CTL_BYTES, stream);
    Args a{};
    for (int i = 0; i < 14; ++i) a.in[i] = (const float*)d_in[i];
    a.out = (float*)d_out; a.ws = (unsigned char*)d_ws;
    void* kargs[] = {&a};
    hipError_t e = hipLaunchCooperativeKernel((const void*)enc_fwd, dim3(grid), dim3(512), kargs, LDS_BYTES, stream);
    if (e != hipSuccess) fprintf(stderr, "cooperative launch failed: %s (grid %d)\n", hipGetErrorString(e), grid);
}
```

```cpp
#include <hip/hip_runtime.h>
#include <hip/hip_cooperative_groups.h>
#include <cstdio>
#include <cstdint>
namespace cg = cooperative_groups;
#ifndef PHM
#define PHM 0x1ff
#endif
#ifndef PROBE
#define PROBE 0
#endif
#ifndef PG_ALIGN
#define PG_ALIGN true
#endif
#ifndef PG_SP2
#define PG_SP2 true
#endif
#ifndef CHECKS
#define CHECKS 0
#endif
#ifndef TSTAMP
#define TSTAMP 0
#endif
#ifndef TS_A
#define TS_A 0
#endif
#ifndef TS_B
#define TS_B 1
#endif
namespace pg8 {
#define PG8_LAS __attribute__((address_space(3)))
typedef unsigned short bf16_t;
typedef short bf16x8 __attribute__((ext_vector_type(8)));
typedef float f32x4 __attribute__((ext_vector_type(4)));
typedef unsigned u32x4 __attribute__((ext_vector_type(4)));
constexpr int BM = 256, BK = 64, HALF = 128, HTB = HALF * BK * 2  , STAGE_BYTES = 8 * HTB, NXCD = 8, WGM = 8;

__host__ __device__ __forceinline__ int lds_byte(int r, int c) { const int st = (r >> 4) * 2 + (c >> 5), rr = r & 15, cc = c & 31, ob = rr * 64 + cc * 2; return st * 1024 + (ob ^ (((ob >> 9) & 1) << 5)); }
__host__ __device__ __forceinline__ void stage_rc(int b, int& R, int& C) { const int st = b / 1024, sb = b % 1024, swz = sb ^ (((sb >> 9) & 1) << 5); R = (st >> 1) * 16 + swz / 64; C = (st & 1) * 32 + (swz % 64) / 2; }
__host__ __device__ __forceinline__ int perm32(int rho) { const int n = rho >> 4, i = rho & 15; return 8 * (i >> 2) + 4 * n + (i & 3); }

struct Unit { int pm, pn; };
struct Gemm { const bf16_t* A; const bf16_t* Bt; int M, N, K; };

struct StaticOrder {
    int nM, nN, nwg, G, c;
    __host__ __device__ void init(int M, int N, int G_, int c_) { nM = M / BM; nN = N / BM; nwg = nM * nN; G = G_; c = c_; }
    __host__ __device__ bool next(int i, Unit& u) const {
        const long L = (long)i * G + c; if (L >= nwg) return false;
        int wgid = (int)L; { const int q = nwg / NXCD, r = nwg % NXCD, xcd = wgid % NXCD, off = wgid / NXCD; wgid = (xcd < r ? xcd * (q + 1) : r * (q + 1) + (xcd - r) * q) + off; }
        const int nig = WGM * nN, gid = wgid / nig, fm = gid * WGM, gsz = (nM - fm) < WGM ? (nM - fm) : WGM;
        u.pm = fm + ((wgid % nig) % gsz); u.pn = (wgid % nig) / gsz; return true;
    }
    __device__ __forceinline__ void a_ready(const Unit&) const {}
    __device__ __forceinline__ void done(const Unit&) const {}
};

typedef float f32x2c_t __attribute__((ext_vector_type(2))); typedef __bf16 bf16x2c_t __attribute__((ext_vector_type(2)));
__device__ __forceinline__ unsigned cvt_pk_bf16(float lo, float hi) { f32x2c_t v = {lo, hi}; bf16x2c_t b = __builtin_convertvector(v, bf16x2c_t); return __builtin_bit_cast(unsigned, b); }
typedef float f32x2 __attribute__((ext_vector_type(2)));
template <class Epi, class Sched, bool ALIGN_EPI = false, bool SP2 = false>
__device__ __forceinline__ void gemm_phase(PG8_LAS unsigned char* lds, const Gemm g, const Sched& S, const Epi& E) {
    int tid_ = threadIdx.x; asm volatile("" : "+v"(tid_));
    const int tid = tid_, wid = __builtin_amdgcn_readfirstlane(tid >> 6), lane = tid & 63, wr = wid >> 2, wc = wid & 3, fr = lane & 15, fq = lane >> 4;
    const int K = g.K, nt = K / BK;
    unsigned voffA[2], voffB[2];
#pragma unroll
    for (int i = 0; i < 2; ++i) { int R, C; stage_rc(tid * 16 + i * 8192, R, C); const int Rb = Epi::PERM ? ((R & ~31) + perm32(R & 31)) : R;
        voffA[i] = (unsigned)(R * K + C) * 2u; voffB[i] = (unsigned)(Epi::brow(Rb) * K + C) * 2u; }
    const size_t kstep = (size_t)(BK * 2);
    const size_t hstep = (size_t)HALF * K * 2;
    const size_t tstep = 2 * hstep;
    const unsigned ldsw = (unsigned)wid * 1024u;
    const int aoff = lds_byte(wr * 64 + fr, fq * 8), boff = lds_byte(wc * 32 + fr, fq * 8);
#define PG8_SA(b, h) (((b) * 2 + (h)) * HTB)
#define PG8_SB(b, h) ((4 + (b) * 2 + (h)) * HTB)
#define PG8_STAGE(bufoff, gbase, voff) do { _Pragma("unroll") for (int _i = 0; _i < 2; ++_i) \
        __builtin_amdgcn_global_load_lds((const unsigned*)((const char*)(gbase) + (voff)[_i]), (PG8_LAS unsigned*)(lds + (bufoff) + ldsw + _i * 8192), 16, 0, 0); } while (0)
#define PG8_LDA(dst, b, h) do { _Pragma("unroll") for (int m = 0; m < 4; ++m) _Pragma("unroll") for (int k = 0; k < 2; ++k) dst[m][k] = *(const PG8_LAS bf16x8*)(lds + PG8_SA(b, h) + aoff + m * 2048 + k * 1024); } while (0)
#define PG8_LDB(dst, b, h) do { _Pragma("unroll") for (int n = 0; n < 2; ++n) _Pragma("unroll") for (int k = 0; k < 2; ++k) dst[n][k] = *(const PG8_LAS bf16x8*)(lds + PG8_SB(b, h) + boff + n * 2048 + k * 1024); } while (0)
#define PG8_MMA(ai, bj, At, Bt) do { __builtin_amdgcn_s_setprio(1); _Pragma("unroll") for (int m = 0; m < 4; ++m) _Pragma("unroll") for (int n = 0; n < 2; ++n) _Pragma("unroll") for (int k = 0; k < 2; ++k) \
        acc[ai][bj][m][n] = __builtin_amdgcn_mfma_f32_16x16x32_bf16(Bt[n][k], At[m][k], acc[ai][bj][m][n], 0, 0, 0); __builtin_amdgcn_s_setprio(0); } while (0)
#define PG8_WAIT_V(n) asm volatile("s_waitcnt vmcnt(" #n ")" ::: "memory")
#define PG8_WAIT_L(n) asm volatile("s_waitcnt lgkmcnt(" #n ")" ::: "memory")
#define PG8_BAR __builtin_amdgcn_s_barrier()
#define PG8_SCHED __builtin_amdgcn_sched_barrier(0)
    Unit cur, nxt; int ui = 0;
    if (!S.next(0, cur)) return;
    f32x4 acc[2][2][4][2];
#pragma unroll
    for (int a = 0; a < 2; ++a)
#pragma unroll
        for (int b = 0; b < 2; ++b)
#pragma unroll
            for (int m = 0; m < 4; ++m)
#pragma unroll
                for (int n = 0; n < 2; ++n) acc[a][b][m][n] = (f32x4){0.f, 0.f, 0.f, 0.f};
    bf16x8 At[4][2], B0[2][2], B1[2][2];
    const char* cA = (const char*)g.A + (size_t)cur.pm * tstep; const char* cB = (const char*)g.Bt + (size_t)cur.pn * tstep;
    S.a_ready(cur);
    if constexpr (SP2) {
        PG8_STAGE(PG8_SB(0, 0), cB, voffB); PG8_STAGE(PG8_SB(0, 1), cB + hstep, voffB); PG8_STAGE(PG8_SA(0, 0), cA, voffA); PG8_STAGE(PG8_SA(0, 1), cA + hstep, voffA);
        if (wr == 1) PG8_BAR;
        PG8_WAIT_V(2); PG8_BAR;
        PG8_STAGE(PG8_SB(1, 0), cB + kstep, voffB); PG8_STAGE(PG8_SA(1, 0), cA + kstep, voffA); PG8_STAGE(PG8_SB(1, 1), cB + hstep + kstep, voffB);
        PG8_WAIT_V(6); PG8_BAR;
    } else {
        PG8_STAGE(PG8_SB(0, 0), cB, voffB); PG8_STAGE(PG8_SA(0, 0), cA, voffA); PG8_STAGE(PG8_SB(0, 1), cB + hstep, voffB); PG8_STAGE(PG8_SA(0, 1), cA + hstep, voffA);
        if (wr == 1) PG8_BAR;
        PG8_WAIT_V(4); PG8_BAR;
        PG8_STAGE(PG8_SB(1, 0), cB + kstep, voffB); PG8_STAGE(PG8_SA(1, 0), cA + kstep, voffA); PG8_STAGE(PG8_SB(1, 1), cB + hstep + kstep, voffB);
        PG8_WAIT_V(6); PG8_BAR;
    }
    for (;;) {
        const bool has_next = S.next(ui + 1, nxt);
        const char* nA = has_next ? (const char*)g.A + (size_t)nxt.pm * tstep : cA; const char* nB = has_next ? (const char*)g.Bt + (size_t)nxt.pn * tstep : cB;
        for (int t = 0; t < nt; t += 2) {
            const bool last = (t == nt - 2);
            const char* a1 = cA + (size_t)(t + 1) * kstep;
            const char* a2 = last ? nA : cA + (size_t)(t + 2) * kstep; const char* b2 = last ? nB : cB + (size_t)(t + 2) * kstep;
            const char* a3 = a2 + kstep; const char* b3 = b2 + kstep;
            if (last && has_next) S.a_ready(nxt);
            if constexpr (SP2) {
            PG8_LDB(B0, 0, 0); PG8_LDB(B1, 0, 1); PG8_SCHED; PG8_LDA(At, 0, 0); PG8_STAGE(PG8_SA(1, 1), a1 + hstep, voffA);
            PG8_WAIT_V(8); PG8_WAIT_L(0); PG8_BAR; PG8_MMA(0, 0, At, B0); PG8_MMA(0, 1, At, B1); PG8_BAR; PG8_SCHED;
            PG8_LDA(At, 0, 1); PG8_STAGE(PG8_SB(0, 0), b2, voffB); PG8_STAGE(PG8_SB(0, 1), b2 + hstep, voffB); PG8_STAGE(PG8_SA(0, 0), a2, voffA);
            PG8_WAIT_V(8); PG8_WAIT_L(0); PG8_BAR; PG8_MMA(1, 0, At, B0); PG8_MMA(1, 1, At, B1); PG8_BAR; PG8_SCHED;
            PG8_LDB(B0, 1, 0); PG8_LDB(B1, 1, 1); PG8_SCHED; PG8_LDA(At, 1, 0); PG8_STAGE(PG8_SA(0, 1), a2 + hstep, voffA);
            PG8_WAIT_V(8); PG8_WAIT_L(0); PG8_BAR; PG8_MMA(0, 0, At, B0); PG8_MMA(0, 1, At, B1); PG8_BAR; PG8_SCHED;
            PG8_LDA(At, 1, 1); PG8_STAGE(PG8_SB(1, 0), b3, voffB); PG8_STAGE(PG8_SB(1, 1), b3 + hstep, voffB); PG8_STAGE(PG8_SA(1, 0), a3, voffA);
            PG8_WAIT_V(8); PG8_WAIT_L(0); PG8_BAR; PG8_MMA(1, 0, At, B0); PG8_MMA(1, 1, At, B1); PG8_BAR; PG8_SCHED;
            } else {
            PG8_LDB(B0, 0, 0); PG8_SCHED; PG8_LDA(At, 0, 0); PG8_STAGE(PG8_SA(1, 1), a1 + hstep, voffA);
            PG8_WAIT_L(8); PG8_BAR; PG8_WAIT_L(0); PG8_MMA(0, 0, At, B0); PG8_BAR; PG8_SCHED;
            PG8_LDB(B1, 0, 1); PG8_STAGE(PG8_SB(0, 0), b2, voffB);
            PG8_BAR; PG8_WAIT_L(0); PG8_MMA(0, 1, At, B1); PG8_BAR;
            PG8_LDA(At, 0, 1); PG8_STAGE(PG8_SA(0, 0), a2, voffA);
            PG8_BAR; PG8_WAIT_L(0); PG8_MMA(1, 0, At, B0); PG8_BAR; PG8_SCHED;
            PG8_STAGE(PG8_SB(0, 1), b2 + hstep, voffB);
            PG8_WAIT_V(6); PG8_BAR; PG8_MMA(1, 1, At, B1); PG8_BAR;
            PG8_LDB(B0, 1, 0); PG8_SCHED; PG8_LDA(At, 1, 0); PG8_STAGE(PG8_SA(0, 1), a2 + hstep, voffA);
            PG8_WAIT_L(8); PG8_BAR; PG8_WAIT_L(0); PG8_MMA(0, 0, At, B0); PG8_BAR; PG8_SCHED;
            PG8_LDB(B1, 1, 1); PG8_STAGE(PG8_SB(1, 0), b3, voffB);
            PG8_BAR; PG8_WAIT_L(0); PG8_MMA(0, 1, At, B1); PG8_BAR;
            PG8_LDA(At, 1, 1); PG8_STAGE(PG8_SA(1, 0), a3, voffA);
            PG8_BAR; PG8_WAIT_L(0); PG8_MMA(1, 0, At, B0); PG8_BAR; PG8_SCHED;
            PG8_STAGE(PG8_SB(1, 1), b3 + hstep, voffB);
            PG8_WAIT_V(6); PG8_BAR; PG8_MMA(1, 1, At, B1); PG8_BAR;
            }
        }
        if constexpr (ALIGN_EPI) { if (wr == 0) PG8_BAR; }
        if constexpr (!Epi::AFTER_DRAIN) { E(acc, cur, wr, wc, fr, fq); S.done(cur); }
        if (!has_next) break;
#pragma unroll
        for (int a = 0; a < 2; ++a)
#pragma unroll
            for (int b = 0; b < 2; ++b)
#pragma unroll
                for (int m = 0; m < 4; ++m)
#pragma unroll
                    for (int n = 0; n < 2; ++n) acc[a][b][m][n] = (f32x4){0.f, 0.f, 0.f, 0.f};
        cur = nxt; cA = nA; cB = nB; ++ui;
        if constexpr (ALIGN_EPI) { if (wr == 1) PG8_BAR; }
    }
    PG8_WAIT_V(0);
    if constexpr (!ALIGN_EPI) { if (wr == 0) PG8_BAR; }
    PG8_BAR;
    if constexpr (Epi::AFTER_DRAIN) { E.fused(acc, cur, wr, wc, fr, fq, lds, wid, lane); S.done(cur); }
#undef PG8_SA
#undef PG8_SB
#undef PG8_STAGE
#undef PG8_LDA
#undef PG8_LDB
#undef PG8_MMA
#undef PG8_WAIT_V
#undef PG8_WAIT_L
#undef PG8_BAR
#undef PG8_SCHED
}
}
constexpr int NTOK = 98304;
constexpr int NMT = NTOK / 256;
constexpr int P_TOK = 32768;
constexpr int LP = 2064, LS = 8208;
constexpr int KPP = 2176, KPS = 8320;
constexpr int MTP = 5, MTS = 17;
constexpr size_t KV_S_OFF = (size_t)16 * 2 * KPP * 64;
constexpr float EPS = 1e-6f;
constexpr float QC2 = 0.125f * 1.4426950408889634f;

namespace pg8 {
__device__ __forceinline__ u32x4 pack8(f32x4 a, f32x4 b) { u32x4 w; w.x = cvt_pk_bf16(a[0], a[1]); w.y = cvt_pk_bf16(a[2], a[3]); w.z = cvt_pk_bf16(b[0], b[1]); w.w = cvt_pk_bf16(b[2], b[3]); return w; }
__device__ __forceinline__ void unpack8(u32x4 w, f32x4& a, f32x4& b) {
    a[0] = __uint_as_float(w.x << 16); a[1] = __uint_as_float(w.x & 0xffff0000u); a[2] = __uint_as_float(w.y << 16); a[3] = __uint_as_float(w.y & 0xffff0000u);
    b[0] = __uint_as_float(w.z << 16); b[1] = __uint_as_float(w.z & 0xffff0000u); b[2] = __uint_as_float(w.w << 16); b[3] = __uint_as_float(w.w & 0xffff0000u); }
__device__ __forceinline__ float sigm(float x) { return __builtin_amdgcn_rcpf(1.0f + __expf(-x)); }
__device__ __forceinline__ float dot4(f32x4 a) { return (a[0] * a[0] + a[1] * a[1]) + (a[2] * a[2] + a[3] * a[3]); }
__device__ __forceinline__ size_t kvoff(int seq, int kvh) { return seq < 16 ? (size_t)(seq * 2 + kvh) * KPP * 64 : KV_S_OFF + (size_t)((seq - 16) * 2 + kvh) * KPS * 64; }
__device__ __forceinline__ int seqlen(int seq) { return seq < 16 ? 2048 : 8192; }

struct EpiBase { static constexpr bool PERM = true, AFTER_DRAIN = false; static __host__ __device__ __forceinline__ int brow(int R) { return R; } };

struct G1Order {
    StaticOrder so; int nwg, G, c;
    __device__ void init(int G_, int c_) { so.init(NTOK, 2816, G_, c_); nwg = so.nwg; G = G_; c = c_; }
    __device__ bool next(int i, Unit& u) const { if (so.next(i, u)) return true; if ((long)i * G + c == (long)nwg + 72) { u.pm = NMT; u.pn = 2; return true; } return false; }
    __device__ __forceinline__ void a_ready(const Unit&) const {}
    __device__ __forceinline__ void done(const Unit&) const {}
};
struct DftOrder {
    int G, c, total, sample;
    __device__ bool next(int i, Unit& u) const {
        const long idx = (long)i * G + c; if (idx >= total) return false; const int id = (int)idx;
        if (sample) { if (id < 256) { const int x = id & 7, slot = id >> 3; u.pm = 2 * x + (slot >> 4); u.pn = slot & 15; } else { u.pm = 16; u.pn = id - 256; } }
        else { u.pm = id >> 5; u.pn = id & 31; }
        return true; }
    __device__ __forceinline__ void a_ready(const Unit&) const {}
    __device__ __forceinline__ void done(const Unit&) const {}
};

struct EpiG1 : EpiBase {
    bf16_t *Q, *KB, *VB, *GA; const float *rope, *gq, *gk;
    __device__ __forceinline__ void qk_row(const f32x4& a00, const f32x4& a01, const f32x4& a10, const f32x4& a11, const f32x4 (&gv)[2][2], int prow, int pcol, int fq, float osc, u32x4 (&w)[2]) const {
        float ss = (dot4(a00) + dot4(a01)) + (dot4(a10) + dot4(a11));
        ss += __shfl_xor(ss, 16); ss += __shfl_xor(ss, 32);
        const float rs = rsqrtf(ss * (1.0f / 64.0f) + EPS) ;
        { const int pp = prow + 1; const f32x4 c = *(const f32x4*)(rope + pp * 32 + 4 * fq), s = *(const f32x4*)(rope + pp * 32 + 16 + 4 * fq);
          const f32x4 x1 = a00 * rs * gv[0][0], x2 = a01 * rs * gv[0][1]; w[0] = pack8((x1 * c - x2 * s) * osc, (x2 * c + x1 * s) * osc); }
        { const int pp = pcol + 1; const f32x4 c = *(const f32x4*)(rope + pp * 32 + 4 * fq), s = *(const f32x4*)(rope + pp * 32 + 16 + 4 * fq);
          const f32x4 x1 = a10 * rs * gv[1][0], x2 = a11 * rs * gv[1][1]; w[1] = pack8((x1 * c - x2 * s) * osc, (x2 * c + x1 * s) * osc); }
    }
    __device__ __forceinline__ void operator()(const f32x4 (&acc)[2][2][4][2], const Unit& u, int wr, int wc, int fr, int fq) const {
        asm volatile("" : "+v"(fr), "+v"(fq));
        const int pm = u.pm, pn = u.pn;
        if (pm == NMT) {
            if (pn != 2 || wr != 0) return;
            u32x4 w[2]; bf16_t* base;
            if (wc < 2) { f32x4 gv[2][2];
#pragma unroll
                for (int bj = 0; bj < 2; ++bj)
#pragma unroll
                    for (int n = 0; n < 2; ++n) gv[bj][n] = *(const f32x4*)(gk + 32 * bj + 16 * n + 4 * fq);
                qk_row(acc[0][0][0][0], acc[0][0][0][1], acc[0][1][0][0], acc[0][1][0][1], gv, -1, fr, fq, 1.0f, w); base = KB; }
            else { w[0] = pack8(acc[0][0][0][0], acc[0][0][0][1]); w[1] = pack8(acc[0][1][0][0], acc[0][1][0][1]); base = VB; }
            const int kvh = wc & 1;
#pragma unroll 1
            for (int s = 0; s < 24; ++s) { bf16_t* d = base + kvoff(s, kvh) + (size_t)(seqlen(s) + fr) * 64 + 8 * fq; *(u32x4*)d = w[0]; *(u32x4*)(d + 32) = w[1]; }
            return;
        }
        if (pn >= 3) {
            const int col0 = (pn - 3) * 256 + wc * 32 + 8 * fq;
#pragma unroll
            for (int ai = 0; ai < 2; ++ai)
#pragma unroll
                for (int m = 0; m < 4; ++m) { bf16_t* rp = GA + (size_t)(pm * 256 + ai * 128 + wr * 64 + m * 16 + fr) * 2048 + col0;
#pragma unroll
                    for (int bj = 0; bj < 2; ++bj) { f32x4 v0 = acc[ai][bj][m][0], v1 = acc[ai][bj][m][1];
#pragma unroll
                        for (int j = 0; j < 4; ++j) { v0[j] = sigm(v0[j]); v1[j] = sigm(v1[j]); }
                        *(u32x4*)(rp + bj * 128) = pack8(v0, v1); } }
            return;
        }
        const int t0 = pm * 256; int seq, p0;
        if (t0 < P_TOK) { seq = t0 >> 11; p0 = t0 & 2047; } else { const int ts = t0 - P_TOK; seq = 16 + (ts >> 13); p0 = ts & 8191; }
        const bool isq = pn < 2;
        if (!isq && wc >= 2) {
            bf16_t* vb = VB + kvoff(seq, wc - 2) + (size_t)p0 * 64 + 8 * fq;
#pragma unroll
            for (int ai = 0; ai < 2; ++ai)
#pragma unroll
                for (int m = 0; m < 4; ++m) { const int rloc = ai * 128 + wr * 64 + m * 16 + fr;
#pragma unroll
                    for (int bj = 0; bj < 2; ++bj) *(u32x4*)(vb + (size_t)rloc * 64 + 32 * bj) = pack8(acc[ai][bj][m][0], acc[ai][bj][m][1]); }
            return;
        }
        const float* g = isq ? gq : gk; const float osc = isq ? QC2 : 1.0f;
        bf16_t* ob = isq ? Q + (size_t)t0 * 512 + (4 * pn + wc) * 64 + 8 * fq : KB + kvoff(seq, wc) + (size_t)p0 * 64 + 8 * fq; const int opitch = isq ? 512 : 64;
        f32x4 gv[2][2];
#pragma unroll
        for (int bj = 0; bj < 2; ++bj)
#pragma unroll
            for (int n = 0; n < 2; ++n) gv[bj][n] = *(const f32x4*)(g + 32 * bj + 16 * n + 4 * fq);
#pragma unroll
        for (int ai = 0; ai < 2; ++ai)
#pragma unroll
            for (int m = 0; m < 4; ++m) { const int rloc = ai * 128 + wr * 64 + m * 16 + fr; const int p = p0 + rloc;
                u32x4 w[2]; qk_row(acc[ai][0][m][0], acc[ai][0][m][1], acc[ai][1][m][0], acc[ai][1][m][1], gv, p >> 6, p & 63, fq, osc, w);
                bf16_t* d = ob + (size_t)rloc * opitch; *(u32x4*)d = w[0]; *(u32x4*)(d + 32) = w[1];
                asm volatile("" ::: "memory"); }
    }
};
struct EpiGT : EpiBase {
    bf16_t *GTp, *GTs;
    __device__ __forceinline__ bf16_t* dst(int seq, int ch) const { return seq < 16 ? GTp + ((size_t)seq * 512 + ch) * KPP : GTs + ((size_t)(seq - 16) * 512 + ch) * KPS; }
    __device__ __forceinline__ void operator()(const f32x4 (&acc)[2][2][4][2], const Unit& u, int wr, int wc, int fr, int fq) const {
        asm volatile("" : "+v"(fr), "+v"(fq));
        const bool meta = (u.pn == NMT);
        const int t0 = u.pn * 256; int seq, p0;
        if (t0 < P_TOK) { seq = t0 >> 11; p0 = t0 & 2047; } else { const int ts = t0 - P_TOK; seq = 16 + (ts >> 13); p0 = ts & 8191; }
#pragma unroll
        for (int ai = 0; ai < 2; ++ai)
#pragma unroll
            for (int m = 0; m < 4; ++m) { const int ch = u.pm * 256 + ai * 128 + wr * 64 + m * 16 + fr;
#pragma unroll
                for (int bj = 0; bj < 2; ++bj) { const u32x4 w = pack8(acc[ai][bj][m][0], acc[ai][bj][m][1]);
                    if (!meta) *(u32x4*)(dst(seq, ch) + 64 + p0 + bj * 128 + wc * 32 + 8 * fq) = w;
                    else if (bj == 0 && wc < 2) { for (int s = 0; s < 24; ++s) *(u32x4*)(dst(s, ch) + wc * 32 + 8 * fq) = w; } } }
    }
};
struct EpiDftP : EpiBase {
    static __host__ __device__ __forceinline__ int brow(int R) { return R <= 64 ? R : 128 - R; }
    float* dump; int nMt;
    __device__ __forceinline__ void operator()(const f32x4 (&acc)[2][2][4][2], const Unit& u, int wr, int wc, int fr, int fq) const {
        asm volatile("" : "+v"(fr), "+v"(fq));
        int tx_ = threadIdx.x; asm volatile("" : "+v"(tx_)); f32x4* d = (f32x4*)dump + (size_t)(u.pn * nMt + u.pm) * 32 * 512 + tx_;
#pragma unroll
        for (int ai = 0; ai < 2; ++ai)
#pragma unroll
            for (int bj = 0; bj < 2; ++bj)
#pragma unroll
                for (int m = 0; m < 4; ++m)
#pragma unroll
                    for (int n = 0; n < 2; ++n) d[(size_t)(((ai * 2 + bj) * 4 + m) * 2 + n) * 512] = acc[ai][bj][m][n];
    }
};
struct EpiDftQ : EpiBase {
    static __host__ __device__ __forceinline__ int brow(int R) { return (R == 0 || R == 64) ? 0 : (R < 64 ? 64 + R : 192 - R); }
    const float* dump; int nMt; bf16_t* F; int L, tokbase, nseq; float scale;
    __device__ __forceinline__ void operator()(const f32x4 (&acc)[2][2][4][2], const Unit& u, int wr, int wc, int fr, int fq) const {
        asm volatile("" : "+v"(fr), "+v"(fq));
        int tx_ = threadIdx.x; asm volatile("" : "+v"(tx_)); const f32x4* d = (const f32x4*)dump + (size_t)(u.pn * nMt + u.pm) * 32 * 512 + tx_;
        const int b = u.pn >> 1, pnl = u.pn & 1, tb = tokbase + b * nseq - 16, L2 = L >> 1;
        const float sg = (wc < 2) ? scale : -scale; const bool z0 = (fq == 0) && ((wc & 1) == 0);
#pragma unroll
        for (int ai = 0; ai < 2; ++ai)
#pragma unroll
            for (int m = 0; m < 4; ++m) { const int lp = u.pm * 256 + ai * 128 + wr * 64 + m * 16 + fr;
#pragma unroll
                for (int bj = 0; bj < 2; ++bj) {
                    const f32x4 P0 = d[(size_t)(((ai * 2 + bj) * 4 + m) * 2 + 0) * 512] * scale, P1 = d[(size_t)(((ai * 2 + bj) * 4 + m) * 2 + 1) * 512] * scale;
                    f32x4 q0 = acc[ai][bj][m][0] * sg, q1 = acc[ai][bj][m][1] * sg; if (z0) q0[0] = 0.f;
                    const int col = (pnl * 2 + bj) * 128 + wc * 32 + 8 * fq;
                    if (lp >= 16 && lp <= L2) *(u32x4*)(F + (size_t)(tb + lp) * 512 + col) = pack8(P0 - q0, P1 - q1);
                    if (lp >= 1 && lp < L2) *(u32x4*)(F + (size_t)(tb + L - lp) * 512 + col) = pack8(P0 + q0, P1 + q1); } }
    }
};
template <int SECOND> struct EpiMerge : EpiBase {
    const bf16_t* GA; bf16_t* MG;
    __device__ __forceinline__ void operator()(const f32x4 (&acc)[2][2][4][2], const Unit& u, int wr, int wc, int fr, int fq) const {
        asm volatile("" : "+v"(fr), "+v"(fq));
        const int col0 = u.pn * 256 + wc * 32 + 8 * fq;
#pragma unroll
        for (int ai = 0; ai < 2; ++ai)
#pragma unroll
            for (int m = 0; m < 4; ++m) { const size_t t = (size_t)(u.pm * 256 + ai * 128 + wr * 64 + m * 16 + fr);
#pragma unroll
                for (int bj = 0; bj < 2; ++bj) { const int c = col0 + bj * 128;
                    f32x4 g0, g1; unpack8(*(const u32x4*)(GA + t * 2048 + SECOND * 1024 + c), g0, g1);
                    f32x4 o0 = g0 * acc[ai][bj][m][0], o1 = g1 * acc[ai][bj][m][1];
                    if (SECOND) { f32x4 p0, p1; unpack8(*(const u32x4*)(MG + t * 1024 + c), p0, p1); o0 += p0; o1 += p1; }
                    *(u32x4*)(MG + t * 1024 + c) = pack8(o0, o1); } }
    }
};
struct EpiX1 : EpiBase {
    const float *xp, *xs; float* out; bf16_t* X1B; float* ss1;
    __device__ __forceinline__ void operator()(const f32x4 (&acc)[2][2][4][2], const Unit& u, int wr, int wc, int fr, int fq) const {
        asm volatile("" : "+v"(fr), "+v"(fq));
        const int col0 = u.pn * 256 + wc * 32 + 8 * fq;
#pragma unroll
        for (int ai = 0; ai < 2; ++ai)
#pragma unroll
            for (int m = 0; m < 4; ++m) { const int t = u.pm * 256 + ai * 128 + wr * 64 + m * 16 + fr;
                const float* xr = t < P_TOK ? xp + (size_t)t * 1024 : xs + (size_t)(t - P_TOK) * 1024; float part = 0.f;
#pragma unroll
                for (int bj = 0; bj < 2; ++bj) { const int c = col0 + bj * 128;
                    const f32x4 v0 = *(const f32x4*)(xr + c) + acc[ai][bj][m][0], v1 = *(const f32x4*)(xr + c + 4) + acc[ai][bj][m][1];
                    *(f32x4*)(out + (size_t)t * 1024 + c) = v0; *(f32x4*)(out + (size_t)t * 1024 + c + 4) = v1;
                    *(u32x4*)(X1B + (size_t)t * 1024 + c) = pack8(v0, v1); part += dot4(v0) + dot4(v1); }
                part += __shfl_xor(part, 16); part += __shfl_xor(part, 32);
                if (fq == 0) atomicAdd(ss1 + t, part); }
    }
};
struct EpiF1 : EpiBase {
    const float* ss1; bf16_t* U;
    __device__ __forceinline__ void operator()(const f32x4 (&acc)[2][2][4][2], const Unit& u, int wr, int wc, int fr, int fq) const {
        asm volatile("" : "+v"(fr), "+v"(fq));
        typedef unsigned u32x2 __attribute__((ext_vector_type(2)));
        const int col0 = u.pn * 128 + wc * 16 + 4 * fq;
#pragma unroll
        for (int ai = 0; ai < 2; ++ai)
#pragma unroll
            for (int m = 0; m < 4; ++m) { const int t = u.pm * 256 + ai * 128 + wr * 64 + m * 16 + fr;
                const float rs = rsqrtf(__hip_atomic_load(ss1 + t, __ATOMIC_RELAXED, __HIP_MEMORY_SCOPE_AGENT) * (1.0f / 1024.0f) + EPS);
#pragma unroll
                for (int bj = 0; bj < 2; ++bj) { const f32x4 gt = acc[ai][bj][m][0] * rs, up = acc[ai][bj][m][1] * rs; f32x4 o;
#pragma unroll
                    for (int j = 0; j < 4; ++j) o[j] = gt[j] * sigm(gt[j]) * up[j];
                    u32x2 w; w.x = cvt_pk_bf16(o[0], o[1]); w.y = cvt_pk_bf16(o[2], o[3]);
                    *(u32x2*)(U + (size_t)t * 2816 + col0 + bj * 64) = w; } }
    }
};
struct EpiF2 : EpiBase {
    float* out; float* ss2;
    __device__ __forceinline__ void operator()(const f32x4 (&acc)[2][2][4][2], const Unit& u, int wr, int wc, int fr, int fq) const {
        asm volatile("" : "+v"(fr), "+v"(fq));
        const int col0 = u.pn * 256 + wc * 32 + 8 * fq;
#pragma unroll
        for (int ai = 0; ai < 2; ++ai)
#pragma unroll
            for (int m = 0; m < 4; ++m) { const int t = u.pm * 256 + ai * 128 + wr * 64 + m * 16 + fr; float part = 0.f;
#pragma unroll
                for (int bj = 0; bj < 2; ++bj) { float* o = out + (size_t)t * 1024 + col0 + bj * 128;
                    const f32x4 v0 = *(const f32x4*)o + acc[ai][bj][m][0], v1 = *(const f32x4*)(o + 4) + acc[ai][bj][m][1];
                    *(f32x4*)o = v0; *(f32x4*)(o + 4) = v1; part += dot4(v0) + dot4(v1); }
                part += __shfl_xor(part, 16); part += __shfl_xor(part, 32);
                if (fq == 0) atomicAdd(ss2 + t, part); }
    }
};
}
#include <hip/hip_bf16.h>
#include <cmath>
namespace attn_body {
using bf16=__hip_bfloat16;
using bf16x8=__attribute__((ext_vector_type(8)))short;
using s16x4=__attribute__((ext_vector_type(4)))short;
using f32x16=__attribute__((ext_vector_type(16)))float;
using u32x4=__attribute__((ext_vector_type(4)))unsigned;
constexpr int D=64,QP=512,KP=64;
constexpr int NW=8,QBLK=32,QB=QBLK*NW,KVBLK=64;

__device__ __forceinline__ int crow(int r,int hi){return (r&3)+8*(r>>2)+4*hi;}
#define SBAR() __builtin_amdgcn_sched_barrier(0)
__device__ __forceinline__ void kmask(f32x16&p0,f32x16&p1,bool full){
  const float NEG=-INFINITY;
  #pragma unroll
  for(int r=0;r<16;++r){ if(full||r>=8)p0[r]=NEG; p1[r]=NEG; }
}

constexpr int NSLOT=3, SLOTB=8192;
constexpr int LDS_K=0, LDS_V=NSLOT*SLOTB, LDS_WS=2*NSLOT*SLOTB, LDS_OST=LDS_WS+NW*64*4, LDS_BYTES=LDS_OST+NW*4096;
constexpr float C2=0.125f*1.4426950408889634f;
__device__ __forceinline__ void glds16(const void*gsrc,unsigned lds_dst){unsigned keep;
  asm volatile("s_mov_b32 %0, m0\n\ts_mov_b32 m0, %2\n\ts_nop 0\n\tglobal_load_lds_dwordx4 %1, off\n\ts_mov_b32 m0, %0":"=&s"(keep):"v"(gsrc),"s"(lds_dst):"memory");}
__device__ __forceinline__ float max3f(float a,float b,float c){float r;asm("v_max3_f32 %0, %1, %2, %3":"=v"(r):"v"(a),"v"(b),"v"(c));return r;}
__device__ __forceinline__ float max2f(float a,float b){float r;asm("v_max_f32_e32 %0, %1, %2":"=v"(r):"v"(a),"v"(b));return r;}
__device__ __forceinline__ float fadd_s(float a,float b){float r;asm("v_add_f32_e32 %0, %1, %2":"=v"(r):"v"(a),"v"(b));return r;}
__device__ __forceinline__ float fsub_s(float a,float b){float r;asm("v_sub_f32_e32 %0, %1, %2":"=v"(r):"v"(a),"v"(b));return r;}
typedef float f32x2_t __attribute__((ext_vector_type(2))); typedef __bf16 bf16x2_t __attribute__((ext_vector_type(2)));
__device__ __forceinline__ unsigned cvtpk_s(float lo,float hi){f32x2_t v={lo,hi};bf16x2_t b=__builtin_convertvector(v,bf16x2_t);return __builtin_bit_cast(unsigned,b);}
#define WAIT_BAR(N) asm volatile("s_waitcnt vmcnt(" #N ") lgkmcnt(0)\n\ts_barrier":::"memory")

__device__ __forceinline__ void qkt(f32x16&p0,f32x16&p1,const char*Kslot,const bf16x8*qr,const f32x16&negm,int r32,int hi){
  const char*kb=Kslot+hi*1024+r32*16;
  #pragma unroll
  for(int d0=0;d0<4;++d0){
    const bf16x8 b0=*reinterpret_cast<const bf16x8*>(kb+d0*2048);
    const bf16x8 b1=*reinterpret_cast<const bf16x8*>(kb+d0*2048+512);
    if(d0==0){p0=__builtin_amdgcn_mfma_f32_32x32x16_bf16(b0,qr[0],negm,0,0,0);p1=__builtin_amdgcn_mfma_f32_32x32x16_bf16(b1,qr[0],negm,0,0,0);}
    else{p0=__builtin_amdgcn_mfma_f32_32x32x16_bf16(b0,qr[d0],p0,0,0,0);p1=__builtin_amdgcn_mfma_f32_32x32x16_bf16(b1,qr[d0],p1,0,0,0);}}
}
typedef __attribute__((address_space(3))) const char* lds_cptr;
typedef short v4i16_t __attribute__((ext_vector_type(4)));
__device__ __forceinline__ void kload8(bf16x8*kf,lds_cptr kp){
  kf[0]=*(const __attribute__((address_space(3))) bf16x8*)(kp);      kf[1]=*(const __attribute__((address_space(3))) bf16x8*)(kp+512);
  kf[2]=*(const __attribute__((address_space(3))) bf16x8*)(kp+2048); kf[3]=*(const __attribute__((address_space(3))) bf16x8*)(kp+2560);
  kf[4]=*(const __attribute__((address_space(3))) bf16x8*)(kp+4096); kf[5]=*(const __attribute__((address_space(3))) bf16x8*)(kp+4608);
  kf[6]=*(const __attribute__((address_space(3))) bf16x8*)(kp+6144); kf[7]=*(const __attribute__((address_space(3))) bf16x8*)(kp+6656);
}
__device__ __forceinline__ void kload2(bf16x8*kf,lds_cptr kp,int j){ kf[2*j]=*(const __attribute__((address_space(3))) bf16x8*)(kp+j*2048); kf[2*j+1]=*(const __attribute__((address_space(3))) bf16x8*)(kp+j*2048+512); }
__device__ __forceinline__ s16x4 vtr(lds_cptr p){ return __builtin_bit_cast(s16x4,__builtin_amdgcn_ds_read_tr16_b64_v4i16((__attribute__((address_space(3))) v4i16_t*)p)); }
__device__ __forceinline__ float rowmax(const f32x16&p0,const f32x16&p1){
  float a=max3f(p0[0],p0[1],p1[0]),b=max3f(p0[2],p0[3],p1[1]);a=max3f(a,p1[2],p1[3]);
  #pragma unroll
  for(int r=4;r<16;r+=4){a=max3f(a,p0[r],p0[r+1]);b=max3f(b,p0[r+2],p0[r+3]);a=max3f(a,p1[r],p1[r+1]);b=max3f(b,p1[r+2],p1[r+3]);}
  const float m=max2f(a,b);
  auto rr=__builtin_amdgcn_permlane32_swap(__float_as_uint(m),__float_as_uint(m),false,false);
  return max2f(__uint_as_float(rr[0]),__uint_as_float(rr[1]));
}
__device__ __forceinline__ void pv(f32x16*o,int vb,bf16x8 pa0,bf16x8 pa1,bf16x8 pa2,bf16x8 pa3){
  #pragma unroll
  for(int d0=0;d0<2;++d0){s16x4 lo[4],hi[4];
    #pragma unroll
    for(int ks=0;ks<4;++ks){
      asm volatile("ds_read_b64_tr_b16 %0,%1 offset:%c2":"=&v"(lo[ks]):"v"(vb),"i"(d0*4096+ks*1024):"memory");
      asm volatile("ds_read_b64_tr_b16 %0,%1 offset:%c2":"=&v"(hi[ks]):"v"(vb),"i"(d0*4096+ks*1024+512):"memory");}
    asm volatile("s_waitcnt lgkmcnt(0)":::"memory");SBAR();
    #define PK(k) (bf16x8){lo[k][0],lo[k][1],lo[k][2],lo[k][3],hi[k][0],hi[k][1],hi[k][2],hi[k][3]}
    o[d0]=__builtin_amdgcn_mfma_f32_32x32x16_bf16(pa0,PK(0),o[d0],0,0,0);
    o[d0]=__builtin_amdgcn_mfma_f32_32x32x16_bf16(pa1,PK(1),o[d0],0,0,0);
    o[d0]=__builtin_amdgcn_mfma_f32_32x32x16_bf16(pa2,PK(2),o[d0],0,0,0);
    o[d0]=__builtin_amdgcn_mfma_f32_32x32x16_bf16(pa3,PK(3),o[d0],0,0,0);
    #undef PK
  }
}

#ifndef ATTN_STORE16
#define ATTN_STORE16(p,v) (*(u32x4*)(p)=(v))
#endif
template<int THRL> __device__ __forceinline__ void attn_unit(const bf16*Qblk,const bf16*__restrict__ Kh,const bf16*__restrict__ Vh,bf16*Oblk,const int NT,char*shm){
  int tid_=threadIdx.x; asm volatile("":"+v"(tid_));
  const int tid=tid_,lane=tid&63,r32=lane&31,hi=lane>>5; const int wid=__builtin_amdgcn_readfirstlane(tid>>6);

  const bf16*Qw=Qblk+(long)(wid*QBLK)*QP;

  const unsigned lds0=(unsigned)(uintptr_t)shm;
  float*wsf=(float*)(shm+LDS_WS)+wid*64;
  const bf16*ksrc=Kh+(long)lane*KP+wid*8;
  const bf16*vsrc=Vh+(long)(16*(wid&3)+(lane>>2))*KP+(wid>>2)*32+(lane&3)*8;
  const unsigned kdst=lds0+LDS_K+wid*1024, vdst=lds0+LDS_V+wid*1024;
  #define DMA_K(t,slot) glds16(ksrc+(long)(t)*KVBLK*KP,(unsigned)__builtin_amdgcn_readfirstlane(kdst+(slot)))
  #define DMA_V(t,slot) glds16(vsrc+(long)(t)*KVBLK*KP,(unsigned)__builtin_amdgcn_readfirstlane(vdst+(slot)))
  const int vb0=(int)(lds0+LDS_V)+((lane>>4)&1)*32+(lane&3)*8+(4*hi+((lane&15)>>2))*64;
  const char*Kbase=shm+LDS_K; bf16x8 kf[8];
  const lds_cptr shm3=(lds_cptr)shm; const lds_cptr kp0=shm3+LDS_K+hi*1024+r32*16; const lds_cptr vp0=shm3+LDS_V+((lane>>4)&1)*32+(lane&3)*8+(4*hi+((lane&15)>>2))*64;
  DMA_K(0,0);DMA_V(0,0);DMA_K(1,SLOTB);
  bf16x8 qr[4];
  #pragma unroll
  for(int d0=0;d0<4;++d0)qr[d0]=*reinterpret_cast<const bf16x8*>(&Qw[(long)r32*QP+d0*16+hi*8]);
  float mhat=0.f,l_reg=0.f;f32x16 o[2];o[0]=f32x16{};o[1]=f32x16{};f32x16 negm=f32x16{};asm volatile("":"+v"(negm));
  const int qrel=wid*QBLK+r32;
  #define CMASK(P0,P1,t) do{}while(0)
  bool resc=false;
  #define START(P0,P1) do{ const float rm=rowmax(P0,P1); resc=false; \
    { const float dl=rm; mhat=fadd_s(mhat,dl); \
      _Pragma("unroll") for(int r=0;r<16;++r){P0[r]=fsub_s(P0[r],dl);P1[r]=fsub_s(P1[r],dl);} \
      _Pragma("unroll") for(int r=0;r<16;++r)negm[r]=-mhat; asm volatile("":"+v"(negm)); } \
    _Pragma("unroll") for(int r=0;r<16;++r)P0[r]=__builtin_amdgcn_exp2f(P0[r]); }while(0)
  #define RESC() do{ if(resc){ asm volatile("s_waitcnt lgkmcnt(0)":::"memory"); \
      _Pragma("unroll") for(int d_=0;d_<2;++d_) _Pragma("unroll") for(int r=0;r<16;++r)o[d_][r]*=wsf[crow(r,hi)]; } }while(0)
  f32x16 pA0,pA1,pB0,pB1;
  int sl_prev=0,sl_cur=0,sl_next=SLOTB;
  #define ROT() do{sl_prev=sl_cur;sl_cur=sl_next;sl_next=(sl_next==(NSLOT-1)*SLOTB)?0:sl_next+SLOTB;}while(0)
  DMA_K(2,2*SLOTB);
  WAIT_BAR(3);
  qkt(pA0,pA1,Kbase,qr,negm,r32,hi);asm volatile("s_nop 15\n\ts_nop 7":"+v"(pA0),"+v"(pA1));CMASK(pA0,pA1,0);
  START(pA0,pA1);
  _Pragma("unroll") for(int r=0;r<16;++r)pA1[r]=__builtin_amdgcn_exp2f(pA1[r]);
  WAIT_BAR(0);
  DMA_K(3,0);DMA_V(1,SLOTB);
  ROT();
  kload8(kf,kp0+sl_cur);
  WAIT_BAR(2);
  s16x4 vlo[8],vhi[8]; u32x4 pw0,pw1,pw2,pw3;
  #define PKW(P,B) cvtpk_s(P[B],P[B+1])
  #define PAF(k) __builtin_bit_cast(bf16x8,pw##k)
  #define VFR(i) (bf16x8){vlo[i][0],vlo[i][1],vlo[i][2],vlo[i][3],vhi[i][0],vhi[i][1],vhi[i][2],vhi[i][3]}
  #define PIN(x) asm volatile("":"+v"(x))
  #define MX3(a,b,c) __builtin_fmaxf(__builtin_fmaxf((a),(b)),(c))
  #define GAPA(MF,A0,A1,A2,A3,W0,W1,PW) do{ MF; sacc+=A0; sacc+=A1; sacc+=A2; sacc+=A3; PIN(sacc); W0; W1; PIN(PW); SBAR(); }while(0)
  #define EX(v) __builtin_amdgcn_exp2f(v)
  #define GAPB(MF,X,B) do{ MF; X[B]=EX(X[B]); X[B+1]=EX(X[B+1]); X[B+2]=EX(X[B+2]); X[B+3]=EX(X[B+3]); PIN(X); SBAR(); }while(0)
  #define VRD(i) do{ vlo[i]=vtr(vp_+(((i)>>2)*4096+((i)&3)*1024)); vhi[i]=vtr(vp_+(((i)>>2)*4096+((i)&3)*1024+512)); }while(0)
  #define KRD(G,j) do{ if(G){ kload2(kf,kp0+sl_next,j); SBAR(); } }while(0)
  #define STEP(C0,C1,P0,P1,t,GK,GV,GL) do{ SBAR(); \
    const lds_cptr vp_=vp0+sl_prev; \
    VRD(0); SBAR(); float sacc=(P0[0]+P0[1]); \
    GAPA(C0=__builtin_amdgcn_mfma_f32_32x32x16_bf16(kf[0],qr[0],negm,0,0,0), P0[2],P0[3],P0[4],P0[5],     pw0[0]=PKW(P0,0), pw0[1]=PKW(P0,2), pw0); \
    VRD(4); SBAR(); GAPA(C1=__builtin_amdgcn_mfma_f32_32x32x16_bf16(kf[1],qr[0],negm,0,0,0), P0[6],P0[7],P0[8],P0[9],     pw0[2]=PKW(P0,4), pw0[3]=PKW(P0,6), pw0); \
    VRD(1); SBAR(); GAPA(C0=__builtin_amdgcn_mfma_f32_32x32x16_bf16(kf[2],qr[1],C0,0,0,0),   P0[10],P0[11],P0[12],P0[13], pw1[0]=PKW(P0,8), pw1[1]=PKW(P0,10), pw1); \
    VRD(5); SBAR(); GAPA(C1=__builtin_amdgcn_mfma_f32_32x32x16_bf16(kf[3],qr[1],C1,0,0,0),   P0[14],P0[15],P1[0],P1[1],   pw1[2]=PKW(P0,12),pw1[3]=PKW(P0,14), pw1); \
    VRD(2); SBAR(); GAPA(C0=__builtin_amdgcn_mfma_f32_32x32x16_bf16(kf[4],qr[2],C0,0,0,0),   P1[2],P1[3],P1[4],P1[5],     pw2[0]=PKW(P1,0), pw2[1]=PKW(P1,2), pw2); \
    VRD(6); SBAR(); GAPA(C1=__builtin_amdgcn_mfma_f32_32x32x16_bf16(kf[5],qr[2],C1,0,0,0),   P1[6],P1[7],P1[8],P1[9],     pw2[2]=PKW(P1,4), pw2[3]=PKW(P1,6), pw2); \
    VRD(3); SBAR(); GAPA(C0=__builtin_amdgcn_mfma_f32_32x32x16_bf16(kf[6],qr[3],C0,0,0,0),   P1[10],P1[11],P1[12],P1[13], pw3[0]=PKW(P1,8), pw3[1]=PKW(P1,10), pw3); \
    VRD(7); SBAR(); GAPA(C1=__builtin_amdgcn_mfma_f32_32x32x16_bf16(kf[7],qr[3],C1,0,0,0),   P1[14],P1[15],0.f,0.f,       pw3[2]=PKW(P1,12),pw3[3]=PKW(P1,14), pw3); \
    l_reg+=sacc; \
    if(GK){DMA_K((t)+3,sl_cur);} if(GV){DMA_V((t)+1,sl_next);} \
    CMASK(C0,C1,t); \
    { float a=MX3(C0[0],C0[1],C1[0]),b=MX3(C0[2],C0[3],C1[1]); a=MX3(a,C1[2],C1[3]); \
      _Pragma("unroll") for(int r=4;r<16;r+=4){a=MX3(a,C0[r],C0[r+1]);b=MX3(b,C0[r+2],C0[r+3]);a=MX3(a,C1[r],C1[r+1]);b=MX3(b,C1[r+2],C1[r+3]);} \
      float rm=__builtin_fmaxf(a,b); { auto rr=__builtin_amdgcn_permlane32_swap(__float_as_uint(rm),__float_as_uint(rm),false,false); rm=__builtin_fmaxf(__uint_as_float(rr[0]),__uint_as_float(rr[1])); } \
      resc=false; \
      if(__builtin_expect(__any(rm>(float)THRL),0)){ const float dl=__builtin_fmaxf(rm,0.f); mhat+=dl; \
        _Pragma("unroll") for(int r=0;r<16;++r){C0[r]-=dl;C1[r]-=dl;} \
        _Pragma("unroll") for(int r=0;r<16;++r)negm[r]=-mhat; asm volatile("":"+v"(negm)); \
        const float f=__builtin_amdgcn_exp2f(-dl); l_reg*=f; if(hi==0)wsf[r32]=f; resc=true; } } \
    SBAR(); \
    GAPB(o[0]=__builtin_amdgcn_mfma_f32_32x32x16_bf16(PAF(0),VFR(0),o[0],0,0,0), C0,0); \
    GAPB(o[1]=__builtin_amdgcn_mfma_f32_32x32x16_bf16(PAF(0),VFR(4),o[1],0,0,0), C0,4); \
    KRD(GL,0); GAPB(o[0]=__builtin_amdgcn_mfma_f32_32x32x16_bf16(PAF(1),VFR(1),o[0],0,0,0), C0,8); \
    KRD(GL,1); GAPB(o[1]=__builtin_amdgcn_mfma_f32_32x32x16_bf16(PAF(1),VFR(5),o[1],0,0,0), C0,12); \
    KRD(GL,2); GAPB(o[0]=__builtin_amdgcn_mfma_f32_32x32x16_bf16(PAF(2),VFR(2),o[0],0,0,0), C1,0); \
    KRD(GL,3); GAPB(o[1]=__builtin_amdgcn_mfma_f32_32x32x16_bf16(PAF(2),VFR(6),o[1],0,0,0), C1,4); \
    GAPB(o[0]=__builtin_amdgcn_mfma_f32_32x32x16_bf16(PAF(3),VFR(3),o[0],0,0,0), C1,8); \
    GAPB(o[1]=__builtin_amdgcn_mfma_f32_32x32x16_bf16(PAF(3),VFR(7),o[1],0,0,0), C1,12); \
    }while(0)
  int t=1;
  #undef CMASK
  #define CMASK(P0,P1,t) do{}while(0)
  for(;t+5<NT;t+=2){
    STEP(pB0,pB1,pA0,pA1,t,true,true,true);     WAIT_BAR(2); RESC(); ROT();
    STEP(pA0,pA1,pB0,pB1,t+1,true,true,true);   WAIT_BAR(2); RESC(); ROT();
  }
  #undef CMASK
  #define CMASK(P0,P1,t) do{ if((t)>=NT-2) kmask(P0,P1,(t)==NT-1); }while(0)
  #define ENDW(tt) do{ if((tt)+3<NT){WAIT_BAR(2);} else if((tt)+2<NT){WAIT_BAR(1);} else {WAIT_BAR(0);} }while(0)
  for(;t+1<NT;t+=2){
    STEP(pB0,pB1,pA0,pA1,t,(t+3<NT),(t+1<NT),(t+1<NT));       ENDW(t);   RESC(); ROT();
    STEP(pA0,pA1,pB0,pB1,t+1,(t+4<NT),(t+2<NT),(t+2<NT));     ENDW(t+1); RESC(); ROT();
  }
  STEP(pB0,pB1,pA0,pA1,NT-1,false,false,false); RESC();
  { float sacc=pB0[0]+pB0[1]; _Pragma("unroll") for(int r=2;r<16;++r)sacc+=pB0[r]; _Pragma("unroll") for(int r=0;r<16;++r)sacc+=pB1[r]; l_reg+=sacc;
    pw0=(u32x4){PKW(pB0,0),PKW(pB0,2),PKW(pB0,4),PKW(pB0,6)};pw1=(u32x4){PKW(pB0,8),PKW(pB0,10),PKW(pB0,12),PKW(pB0,14)};pw2=(u32x4){PKW(pB1,0),PKW(pB1,2),PKW(pB1,4),PKW(pB1,6)};pw3=(u32x4){PKW(pB1,8),PKW(pB1,10),PKW(pB1,12),PKW(pB1,14)};
    SBAR(); pv(o,vb0+sl_cur,PAF(0),PAF(1),PAF(2),PAF(3)); }
  #undef PKW
  #undef PAF
  #undef VFR
  #undef PIN
  #undef MX3
  #undef GAPA
  #undef GAPB
  #undef EX
  #undef VRD
  #undef KRD
  #undef STEP
  #undef ENDW
  {auto rr=__builtin_amdgcn_permlane32_swap(__float_as_uint(l_reg),__float_as_uint(l_reg),false,false);l_reg=__uint_as_float(rr[0])+__uint_as_float(rr[1]);}
  if(hi==0)wsf[32+r32]=l_reg;asm volatile("s_waitcnt lgkmcnt(0)":::"memory");
  float rli[16];
  #pragma unroll
  for(int r=0;r<16;++r)rli[r]=__builtin_amdgcn_rcpf(wsf[32+crow(r,hi)]);
  bf16*Ow=Oblk+(long)(wid*QBLK)*QP;
  { bf16*stg=(bf16*)(shm+LDS_OST)+wid*2048;
    #pragma unroll
    for(int r=0;r<16;++r){const int orow=crow(r,hi);
      #pragma unroll
      for(int d0=0;d0<2;++d0)stg[orow*64+d0*32+r32]=__float2bfloat16(o[d0][r]*rli[r]);}
    asm volatile("s_waitcnt lgkmcnt(0)":::"memory");
    #pragma unroll
    for(int i=0;i<4;++i){const int row=i*8+(lane>>3),ch=lane&7; const u32x4 v=*(const u32x4*)(stg+row*64+ch*8); ATTN_STORE16(Ow+(long)row*QP+ch*8,v);} }
  asm volatile("s_waitcnt lgkmcnt(0)\n\ts_barrier":::"memory");
  #undef DMA_K
  #undef DMA_V
  #undef CMASK
  #undef START
  #undef RESC
  #undef ROT
}
#undef SBAR
#undef WAIT_BAR
}
#define GAS __attribute__((address_space(1)))
#define LAS __attribute__((address_space(3)))
typedef unsigned short bf16;
typedef unsigned v4u __attribute__((ext_vector_type(4)));
typedef float f32x4 __attribute__((ext_vector_type(4)));
constexpr size_t MiB = 1u << 20;
constexpr size_t WS_CTL = 0, CTL_BYTES = 4096;
constexpr size_t WS_ROPE = 1 * MiB, WS_SS1 = 2 * MiB, WS_SS2 = 3 * MiB;
constexpr size_t WS_WIN = 4 * MiB, WS_WG = 10 * MiB, WS_WA = 11 * MiB, WS_WF = 12 * MiB, WS_WO = 13 * MiB, WS_WFFN = 15 * MiB, WS_WDN = 26 * MiB;
constexpr size_t WS_GA = 32 * MiB, WS_X1B = 32 * MiB, WS_Q = 416 * MiB, WS_KB = 512 * MiB, WS_VB = 537 * MiB, WS_GTP = 562 * MiB, WS_GTS = 596 * MiB;
constexpr size_t WS_CS = 661 * MiB, WS_SS = 731 * MiB, WS_CP = 801 * MiB, WS_SP = 807 * MiB, WS_H = 813 * MiB, WS_F = 813 * MiB, WS_DS = 909 * MiB, WS_DP = 977 * MiB, WS_END = 1017 * MiB;
constexpr size_t WS_U = 224 * MiB, WS_MG = 512 * MiB;
static_assert(WS_GA + (size_t)NTOK * 2048 * 2 <= WS_Q && WS_Q + (size_t)NTOK * 512 * 2 <= WS_KB && WS_KB + (KV_S_OFF + (size_t)16 * KPS * 64) * 2 <= WS_VB && WS_VB + (KV_S_OFF + (size_t)16 * KPS * 64) * 2 <= WS_GTP, "ws map 1");
static_assert(WS_GTP + (size_t)16 * 512 * KPP * 2 <= WS_GTS && WS_GTS + (size_t)8 * 512 * KPS * 2 <= WS_CS && WS_CS + (size_t)MTS * 256 * KPS * 2 <= WS_SS && WS_SS + (size_t)MTS * 256 * KPS * 2 <= WS_CP, "ws map 2");
static_assert(WS_CP + (size_t)MTP * 256 * KPP * 2 <= WS_SP && WS_SP + (size_t)MTP * 256 * KPP * 2 <= WS_H && WS_H + (size_t)(NTOK + 256) * 1024 * 2 <= WS_END && WS_F + (size_t)NTOK * 512 * 2 <= WS_DS && WS_DS + (size_t)272 * 262144 <= WS_DP && WS_DP + (size_t)160 * 262144 <= WS_END, "ws map 3");
static_assert(WS_U + (size_t)NTOK * 2816 * 2 <= WS_END && WS_X1B + (size_t)NTOK * 1024 * 2 <= WS_U && WS_MG + (size_t)NTOK * 1024 * 2 <= WS_F && WS_WDN + (size_t)1024 * 2816 * 2 <= WS_GA && WS_WFFN + (size_t)5632 * 1024 * 2 <= WS_WDN && WS_WIN + (size_t)2816 * 1024 * 2 <= WS_WG, "ws map 4");
constexpr int LDS_BYTES = 147456, MISC_OFF = 131072 + 320;
constexpr int NATT = 3072;

__device__ __forceinline__ unsigned f2bf(float f) { unsigned u = __builtin_bit_cast(unsigned, f); return (u + 0x7fffu + ((u >> 16) & 1u)) >> 16; }
__device__ __forceinline__ unsigned pk2(float lo, float hi) { return f2bf(lo) | (f2bf(hi) << 16); }
__device__ __forceinline__ float wave_sum(float v) {
#pragma unroll
    for (int o = 1; o < 64; o <<= 1) v += __shfl_xor(v, o);
    return v; }

__device__ __forceinline__ int src_col(int mat, int n) {
    if (mat == 0) {
        if (n >= 768) return 1280 + (n - 768);
        const int ct = n & 255, bj = ct >> 7, wc = (ct >> 5) & 3, fq = (ct >> 3) & 3, nn = (ct >> 2) & 1, j = ct & 3;
        if (n < 512) return ((n >> 8) * 4 + wc) * 64 + 32 * bj + 16 * nn + 4 * fq + j;
        if (wc < 2) return 512 + wc * 64 + 32 * bj + 16 * nn + 4 * fq + j;
        return 640 + (wc - 2) * 64 + 32 * bj + 8 * fq + 4 * nn + j;
    }
    if (mat == 4) { const int pn = n >> 8, ct = n & 255, nn = (ct >> 2) & 1, j = ct & 3, q8 = ct >> 3; return (nn ? 2816 : 0) + 128 * pn + 4 * q8 + j; }
    return n;
}
__device__ __forceinline__ void tr_item(const float* W, int ldw, int K, int ND, bf16* WT, int mat, const float* ksc, LAS float* scr, int item, int lane) {
    const int nblk = ND / 32, kb = item / nblk, nb = item % nblk, k0 = 64 * kb, n0 = 32 * nb;
    const int sc = src_col(mat, n0 + (lane & 31));
#pragma unroll 8
    for (int i = 0; i < 32; ++i) { const int kk = 2 * i + (lane >> 5); float v = W[(size_t)(k0 + kk) * ldw + sc]; if (ksc) v *= ksc[k0 + kk]; scr[kk * 33 + (lane & 31)] = v; }
    asm volatile("s_waitcnt lgkmcnt(0)" ::: "memory");
    const int c = lane & 7;
#pragma unroll
    for (int j = 0; j < 4; ++j) { const int n = (lane >> 3) + 8 * j; const LAS float* s = scr + (8 * c) * 33 + n;
        v4u o; o.x = pk2(s[0 * 33], s[1 * 33]); o.y = pk2(s[2 * 33], s[3 * 33]); o.z = pk2(s[4 * 33], s[5 * 33]); o.w = pk2(s[6 * 33], s[7 * 33]);
        *(v4u*)(WT + (size_t)(n0 + n) * K + k0 + 8 * c) = o; }
    asm volatile("s_waitcnt lgkmcnt(0)" ::: "memory");
}
__device__ __forceinline__ void rms_row_bf16(const float* xrow, const float* g, bf16* orow, int lane) {
    const f32x4* xr = (const f32x4*)xrow + lane; const f32x4* gr = (const f32x4*)g + lane;
    f32x4 v[4]; float s = 0.f;
#pragma unroll
    for (int j = 0; j < 4; ++j) { v[j] = xr[64 * j]; s += (v[j].x * v[j].x + v[j].y * v[j].y) + (v[j].z * v[j].z + v[j].w * v[j].w); }
    const float rstd = rsqrtf(wave_sum(s) * (1.f / 1024.f) + EPS);
    unsigned long long* o8 = (unsigned long long*)orow + lane;
#pragma unroll
    for (int j = 0; j < 4; ++j) { const f32x4 gg = gr[64 * j]; o8[64 * j] = (unsigned long long)pk2(v[j].x * rstd * gg.x, v[j].y * rstd * gg.y) | ((unsigned long long)pk2(v[j].z * rstd * gg.z, v[j].w * rstd * gg.w) << 32); }
}
__device__ __forceinline__ void dft_fill(bf16* C, bf16* S, int rows, int KP_, int L, long gtid, long nthr) {
    const int per_row = KP_ / 8; const long items = (long)rows * per_row; const float inv = 2.0f / (float)L;
    for (long it = gtid; it < items; it += nthr) { const int r = (int)(it / per_row), k0 = (int)(it % per_row) * 8;
        const int l0 = k0 < 16 ? k0 : k0 - 48; const bool rv = (r >= 1 && r <= L / 2) && !(k0 >= 16 && k0 < 64);
        unsigned cw[4], sw[4]; int m = rv ? (int)(((long)r * l0) % L) : 0;
#pragma unroll
        for (int e = 0; e < 4; ++e) { float c0 = 0.f, s0 = 0.f, c1 = 0.f, s1 = 0.f;
            if (rv && l0 + 2 * e < L) sincospif((float)m * inv, &s0, &c0);
            m += r; if (m >= L) m -= L;
            if (rv && l0 + 2 * e + 1 < L) sincospif((float)m * inv, &s1, &c1);
            m += r; if (m >= L) m -= L;
            cw[e] = pk2(c0, c1); sw[e] = pk2(s0, s1); }
        *(v4u*)(C + (size_t)r * KP_ + k0) = (v4u){cw[0], cw[1], cw[2], cw[3]}; *(v4u*)(S + (size_t)r * KP_ + k0) = (v4u){sw[0], sw[1], sw[2], sw[3]}; }
}

__device__ __forceinline__ void my_bar(unsigned* cnt, unsigned target) {
    __syncthreads();
    if (threadIdx.x == 0) {
        __builtin_amdgcn_fence(__ATOMIC_RELEASE, "agent");
        __hip_atomic_fetch_add(cnt, 1u, __ATOMIC_RELAXED, __HIP_MEMORY_SCOPE_AGENT);
        while (__hip_atomic_load(cnt, __ATOMIC_RELAXED, __HIP_MEMORY_SCOPE_AGENT) < target) __builtin_amdgcn_s_sleep(2);
        __builtin_amdgcn_fence(__ATOMIC_ACQUIRE, "agent");
    }
    __syncthreads();
}
struct Args { const float* in[14]; float* out; unsigned char* ws; };

#if CHECKS
#define BF(v) (__uint_as_float(((unsigned)(v)) << 16))
__device__ __forceinline__ void chk(unsigned* ctl, int stage, float got, float ref, float rt) {
    const bool bad = !(fabsf(got - ref) <= rt * (1.0f + fabsf(ref)));
    const unsigned long long m = __ballot(bad);
    if ((threadIdx.x & 63) == 0 && m) atomicAdd(ctl + 200 + stage, (unsigned)__popcll(m));
}
__device__ __forceinline__ void tok_geom(int t, int& seq, int& p) { if (t < P_TOK) { seq = t >> 11; p = t & 2047; } else { seq = 16 + ((t - P_TOK) >> 13); p = (t - P_TOK) & 8191; } }
#define RUN_CHECKS(stage) do { run_checks((stage), bx * 8 + wave, lane); GRID_SYNC(); } while (0)
__device__ __forceinline__ void run_checks(int stage, int gw, int lane) {
    typedef __attribute__((address_space(4))) const Args CArgs;
    CArgs* ap_ = (CArgs*)__builtin_amdgcn_kernarg_segment_ptr(); unsigned char* ws = ap_->ws; unsigned* ctl = (unsigned*)(ws + WS_CTL);
    const int t = (int)(((long)gw * 48 + (gw >> 3)) % NTOK); int seq, p; tok_geom(t, seq, p);
    if (stage == 1) {
        const bf16* hrow = (const bf16*)(ws + WS_H) + (size_t)t * 1024; const float* w_in = ap_->in[4]; const int c = lane * 32 + (gw & 31);
        float z = 0.f; for (int k = 0; k < 1024; ++k) z += BF(hrow[k]) * w_in[(size_t)k * 3328 + 1280 + c];
        chk(ctl, 1, BF(((const bf16*)(ws + WS_GA))[(size_t)t * 2048 + c]), 1.f / (1.f + expf(-z)), 0.02f);
        { const float* xr = t < P_TOK ? ap_->in[0] + (size_t)t * 1024 : ap_->in[1] + (size_t)(t - P_TOK) * 1024; float s = 0.f; for (int k = lane; k < 1024; k += 64) s += xr[k] * xr[k];
          s = wave_sum(s); const float rs = rsqrtf(s * (1.f / 1024.f) + EPS); const int k = lane * 16 + (gw & 15); chk(ctl, 0, BF(hrow[k]), xr[k] * rs * ap_->in[3][k], 0.01f); }
    } else if (stage == 2) {
        const int L = seq < 16 ? LP : LS, lp = 16 + p, KP_ = seq < 16 ? KPP : KPS; const float scale = rsqrtf((float)L * 128.0f);
        const int c = lane * 8 + (gw & 7), g = c >> 7, cp = c & 127;
        const int rc = cp <= 64 ? cp : 128 - cp, rs_ = (cp == 0 || cp == 64) ? -1 : (cp < 64 ? 64 + cp : 192 - cp); const float sg = cp < 64 ? 1.f : -1.f;
        const bf16* gb = seq < 16 ? (const bf16*)(ws + WS_GTP) + ((size_t)seq * 512 + g * 128) * KPP : (const bf16*)(ws + WS_GTS) + ((size_t)(seq - 16) * 512 + g * 128) * KPS;
        float a = 0.f; int m = 0;
        for (int l = 0; l < L; ++l) { const int ph = l < 16 ? l : l + 48; float sn, cs; sincospif(2.0f * (float)m / (float)L, &sn, &cs);
            a += cs * BF(gb[(size_t)rc * KP_ + ph]); if (rs_ >= 0) a -= sg * sn * BF(gb[(size_t)rs_ * KP_ + ph]);
            m += lp; if (m >= L) m -= L; }
        chk(ctl, 2, BF(((const bf16*)(ws + WS_F))[(size_t)t * 512 + c]), a * scale, 0.04f);
    } else if (stage == 3) {
        const int c = lane * 16 + (gw & 15); float a = 0.f, f = 0.f;
        for (int k = 0; k < 512; ++k) { a += BF(((const bf16*)(ws + WS_Q))[(size_t)t * 512 + k]) * ap_->in[7][(size_t)k * 1024 + c]; f += BF(((const bf16*)(ws + WS_F))[(size_t)t * 512 + k]) * ap_->in[8][(size_t)k * 1024 + c]; }
        const bf16* ga = (const bf16*)(ws + WS_GA) + (size_t)t * 2048;
        chk(ctl, 3, BF(((const bf16*)(ws + WS_MG))[(size_t)t * 1024 + c]), BF(ga[c]) * a + BF(ga[1024 + c]) * f, 0.03f);
    } else if (stage == 4) {
        const float* xr = t < P_TOK ? ap_->in[0] + (size_t)t * 1024 : ap_->in[1] + (size_t)(t - P_TOK) * 1024; const float* o = ap_->out + (size_t)t * 1024;
        const int c = lane * 16 + (gw & 15); float a = 0.f; for (int k = 0; k < 1024; ++k) a += BF(((const bf16*)(ws + WS_MG))[(size_t)t * 1024 + k]) * ap_->in[9][(size_t)k * 1024 + c];
        chk(ctl, 4, o[c], xr[c] + a, 0.02f);
        chk(ctl, 4, BF(((const bf16*)(ws + WS_X1B))[(size_t)t * 1024 + c]), o[c], 0.01f);
        { float s = 0.f; for (int cc = lane; cc < 1024; cc += 64) s += o[cc] * o[cc]; s = wave_sum(s); chk(ctl, 4, ((const float*)(ws + WS_SS1))[t], s, 0.002f); }
    } else if (stage == 5) {
        const bf16* xb = (const bf16*)(ws + WS_X1B) + (size_t)t * 1024; const float rs = rsqrtf(((const float*)(ws + WS_SS1))[t] * (1.f / 1024.f) + EPS);
        const int j = lane * 44 + (gw % 44); float g = 0.f, u = 0.f;
        for (int k = 0; k < 1024; ++k) { const float xv = BF(xb[k]) * ap_->in[10][k]; g += xv * ap_->in[11][(size_t)k * 5632 + j]; u += xv * ap_->in[11][(size_t)k * 5632 + 2816 + j]; }
        g *= rs; u *= rs;
        chk(ctl, 5, BF(((const bf16*)(ws + WS_U))[(size_t)t * 2816 + j]), g / (1.f + expf(-g)) * u, 0.03f);
    } else if (stage == 6) {
        const int c = lane * 16 + (gw & 15); float a = 0.f; for (int k = 0; k < 2816; ++k) a += BF(((const bf16*)(ws + WS_U))[(size_t)t * 2816 + k]) * ap_->in[12][(size_t)k * 1024 + c];
        const float* o = ap_->out + (size_t)t * 1024;
        chk(ctl, 6, o[c], BF(((const bf16*)(ws + WS_X1B))[(size_t)t * 1024 + c]) + a, 0.03f);
        { float s = 0.f; for (int cc = lane; cc < 1024; cc += 64) s += o[cc] * o[cc]; s = wave_sum(s); chk(ctl, 6, ((const float*)(ws + WS_SS2))[t], s, 0.002f); }
    }
}
#else
#define RUN_CHECKS(stage) do {} while (0)
#endif

__global__ void __launch_bounds__(512, 2) enc_fwd(Args args) {
    extern __shared__ __attribute__((aligned(16))) unsigned char lds[];
    cg::grid_group grid = cg::this_grid();
    LAS unsigned char* L3 = (LAS unsigned char*)lds;
    volatile LAS unsigned* MISC = (volatile LAS unsigned*)(L3 + MISC_OFF);
    const int tid = threadIdx.x, lane = tid & 63, wave = __builtin_amdgcn_readfirstlane(tid >> 6);
    const int G = gridDim.x, bx = blockIdx.x; int nsync_ = 0;
#if TSTAMP
    unsigned long long ts_[9]; for (int i_ = 0; i_ < 9; ++i_) ts_[i_] = 0; ts_[0] = __builtin_amdgcn_s_memrealtime();
#endif
    typedef __attribute__((address_space(4))) const Args CArgs;
#define LOAD_ARGS() CArgs* ap_ = (CArgs*)__builtin_amdgcn_kernarg_segment_ptr(); asm volatile("" : "+s"(ap_)); unsigned char* ws = ap_->ws; (void)ws
#define WSP(T, off) ((T*)(ws + (off)))
#define AIN(i) (ap_->in[i])
#define AOUT() (ap_->out)
#if TSTAMP
#define TS_MARK() do { if (nsync_ < 9) ts_[nsync_] = __builtin_amdgcn_s_memrealtime(); } while (0)
#else
#define TS_MARK() do {} while (0)
#endif
#define GRID_SYNC() do { asm volatile("s_waitcnt vmcnt(0) lgkmcnt(0)" ::: "memory"); grid.sync(); ++nsync_; __builtin_amdgcn_fence(__ATOMIC_ACQUIRE, "agent"); asm volatile("s_waitcnt vmcnt(0)" ::: "memory"); TS_MARK(); } while (0)
#define WSPC(T, off) ((T*)(((CArgs*)__builtin_amdgcn_kernarg_segment_ptr())->ws + (off)))

#if (PHM>>0)&1
    { LOAD_ARGS();
        const int gw = bx * 8 + wave, NGW = G * 8; const long gtid = (long)bx * 512 + tid, nthr = (long)G * 512;
        LAS float* tab = (LAS float*)L3;
        if (tid < 128) { tab[tid] = cospif((float)tid * (1.0f / 64.0f)); }
        __syncthreads();
        LAS float* scr = (LAS float*)(L3 + 1024 + wave * 8704);
        constexpr int I0 = 16 * 88, I1 = 8 * 32, I2 = 8 * 32, I3 = 16 * 32, I4 = 16 * 176, I5 = 44 * 32;
        for (int it = gw; it < I0 + I1 + I2 + I3 + I4 + I5; it += NGW) { int r = it;
            if (r < I0) { tr_item(AIN(4), 3328, 1024, 2816, WSP(bf16, WS_WIN), 0, nullptr, scr, r, lane); continue; } r -= I0;
            if (r < I1) { tr_item(AIN(7), 1024, 512, 1024, WSP(bf16, WS_WA), 1, nullptr, scr, r, lane); continue; } r -= I1;
            if (r < I2) { tr_item(AIN(8), 1024, 512, 1024, WSP(bf16, WS_WF), 2, nullptr, scr, r, lane); continue; } r -= I2;
            if (r < I3) { tr_item(AIN(9), 1024, 1024, 1024, WSP(bf16, WS_WO), 3, nullptr, scr, r, lane); continue; } r -= I3;
            if (r < I4) { tr_item(AIN(11), 5632, 1024, 5632, WSP(bf16, WS_WFFN), 4, AIN(10), scr, r, lane); continue; } r -= I4;
            tr_item(AIN(12), 1024, 2816, 1024, WSP(bf16, WS_WDN), 5, nullptr, scr, r, lane); }
        for (long id = gtid; id < 512 * 128; id += nthr) { const int wv = (int)id >> 6, ln = (int)id & 63, chunk = (wv & 15) * 8 + (ln & 7), row = (wv >> 4) * 8 + (ln >> 3), s = row & 127, g = row >> 7, k = chunk * 8;
            const float* wr_ = AIN(4) + (size_t)k * 3328 + 768 + g * 128; float a[8];
#pragma unroll
            for (int j = 0; j < 8; ++j) a[j] = 0.f;
            const int sm = s <= 64 ? s : s - 64, sh = s <= 64 ? 0 : 96;
            for (int c = 0; c < 128; ++c) { const float tv = tab[(c * sm + sh) & 127];
#pragma unroll
                for (int j = 0; j < 8; ++j) a[j] += wr_[(size_t)j * 3328 + c] * tv; }
            *(v4u*)(WSP(bf16, WS_WG) + (size_t)row * 1024 + k) = (v4u){pk2(a[0], a[1]), pk2(a[2], a[3]), pk2(a[4], a[5]), pk2(a[6], a[7])}; }
        for (int m = gw; m < NTOK + 256; m += NGW) {
            bf16* orow = WSP(bf16, WS_H) + (size_t)m * 1024;
            if (m < P_TOK) rms_row_bf16(AIN(0) + (size_t)m * 1024, AIN(3), orow, lane);
            else if (m < NTOK) rms_row_bf16(AIN(1) + (size_t)(m - P_TOK) * 1024, AIN(3), orow, lane);
            else if (m < NTOK + 16) rms_row_bf16(AIN(2) + (size_t)(m - NTOK) * 1024, AIN(3), orow, lane);
            else { unsigned long long* o8 = (unsigned long long*)orow + lane;
#pragma unroll
                for (int j = 0; j < 4; ++j) o8[64 * j] = 0ull; } }
        dft_fill(WSP(bf16, WS_CS), WSP(bf16, WS_SS), MTS * 256, KPS, LS, gtid, nthr);
        dft_fill(WSP(bf16, WS_CP), WSP(bf16, WS_SP), MTP * 256, KPP, LP, gtid, nthr);
        for (long id = gtid; id < 130 * 16; id += nthr) { const int pp = (int)id >> 4, i = (int)id & 15;
            const double ang = (double)(pp - 1) * pow(10000.0, -(double)i / 16.0);
            WSP(float, WS_ROPE)[pp * 32 + i] = (float)cos(ang); WSP(float, WS_ROPE)[pp * 32 + 16 + i] = (float)sin(ang); }
        for (long id = gtid; id < NTOK; id += nthr) { WSP(float, WS_SS1)[id] = 0.f; WSP(float, WS_SS2)[id] = 0.f; }
        for (long id = gtid; id < 48L * 112 * 8; id += nthr) { const int g = (int)(id / 896), rem = (int)(id % 896), r = rem >> 3, ch = rem & 7;
            const int seq = g >> 1, kvh = g & 1; const size_t off = pg8::kvoff(seq, kvh) + (size_t)(pg8::seqlen(seq) + 16 + r) * 64 + ch * 8;
            *(v4u*)(WSP(bf16, WS_KB) + off) = (v4u){0u, 0u, 0u, 0u}; *(v4u*)(WSP(bf16, WS_VB) + off) = (v4u){0u, 0u, 0u, 0u}; }
        for (long id = gtid; id < 24L * 512 * 8; id += nthr) { const int row = (int)(id >> 3), ch = (int)(id & 7), seq = row >> 9, c = row & 511;
            bf16* d = seq < 16 ? WSP(bf16, WS_GTP) + ((size_t)seq * 512 + c) * KPP + 64 + 2048 : WSP(bf16, WS_GTS) + ((size_t)(seq - 16) * 512 + c) * KPS + 64 + 8192;
            *(v4u*)(d + ch * 8) = (v4u){0u, 0u, 0u, 0u}; }
        asm volatile("s_waitcnt vmcnt(0) lgkmcnt(0)" ::: "memory");
    }
#endif
    GRID_SYNC();
    RUN_CHECKS(0);

#if (PHM>>1)&1
    { LOAD_ARGS();
        pg8::Gemm g{WSP(bf16, WS_H), WSP(bf16, WS_WIN), NTOK + 256, 2816, 1024}; pg8::G1Order S; S.init(G, bx);
        pg8::EpiG1 E; E.Q = WSP(bf16, WS_Q); E.KB = WSP(bf16, WS_KB); E.VB = WSP(bf16, WS_VB); E.GA = WSP(bf16, WS_GA); E.rope = WSP(float, WS_ROPE); E.gq = AIN(5); E.gk = AIN(6);
        pg8::gemm_phase<pg8::EpiG1, pg8::G1Order, PG_ALIGN, PG_SP2>(L3, g, S, E);
    }
#endif
#if (PHM>>2)&1
    { LOAD_ARGS();
        pg8::Gemm g{WSP(bf16, WS_WG), WSP(bf16, WS_H), 512, NTOK + 256, 1024}; pg8::StaticOrder S; S.init(512, NTOK + 256, G, G - 1 - bx);
        pg8::EpiGT E; E.GTp = WSP(bf16, WS_GTP); E.GTs = WSP(bf16, WS_GTS);
        pg8::gemm_phase<pg8::EpiGT, pg8::StaticOrder, PG_ALIGN, PG_SP2>(L3, g, S, E);
    }
#endif
    GRID_SYNC();
    RUN_CHECKS(1);

#if (PHM>>3)&1
    for (int ps = 0; ps < 2; ++ps) { LOAD_ARGS();
        const int K = ps ? KPP : KPS, nMt = ps ? MTP : MTS, Lq = ps ? LP : LS;
        pg8::DftOrder S; S.G = G; S.c = ps ? (bx + G - 16) % G : bx; S.total = ps ? 160 : 272; S.sample = !ps;
        { pg8::Gemm g{ps ? WSP(bf16, WS_CP) : WSP(bf16, WS_CS), ps ? WSP(bf16, WS_GTP) : WSP(bf16, WS_GTS), nMt * 256, ps ? 16 * 512 : 8 * 512, K};
          pg8::EpiDftP E; E.dump = ps ? WSP(float, WS_DP) : WSP(float, WS_DS); E.nMt = nMt;
          pg8::gemm_phase<pg8::EpiDftP, pg8::DftOrder, PG_ALIGN, PG_SP2>(L3, g, S, E); }
        { pg8::Gemm g{ps ? WSP(bf16, WS_SP) : WSP(bf16, WS_SS), ps ? WSP(bf16, WS_GTP) : WSP(bf16, WS_GTS), nMt * 256, ps ? 16 * 512 : 8 * 512, K};
          pg8::EpiDftQ E; E.dump = ps ? WSP(float, WS_DP) : WSP(float, WS_DS); E.nMt = nMt; E.F = WSP(bf16, WS_F); E.L = Lq; E.tokbase = ps ? 0 : P_TOK; E.nseq = ps ? 2048 : 8192; E.scale = rsqrtf((float)Lq * 128.0f);
          pg8::gemm_phase<pg8::EpiDftQ, pg8::DftOrder, PG_ALIGN, PG_SP2>(L3, g, S, E); }
    }
#endif
#if (PHM>>4)&1
    for (;;) { LOAD_ARGS();
        if (tid == 0) MISC[0] = atomicAdd(WSP(unsigned, WS_CTL) + 64, 1u);
        __syncthreads();
        const int idx = (int)MISC[0];
        __syncthreads();
        if (idx >= NATT) break;
        int tok0, NT, hq; size_t kvo;
        if (idx < 2048) { const int gk = idx >> 7, r = idx & 127, b = gk >> 1, kvh = gk & 1; hq = kvh * 4 + (r >> 5); tok0 = P_TOK + b * 8192 + (r & 31) * 256; NT = 130; kvo = KV_S_OFF + (size_t)gk * KPS * 64; }
        else { const int j = idx - 2048, gk = j >> 5, r = j & 31, b = gk >> 1, kvh = gk & 1; hq = kvh * 4 + (r >> 3); tok0 = b * 2048 + (r & 7) * 256; NT = 34; kvo = (size_t)gk * KPP * 64; }
        attn_body::attn_unit<8>((const attn_body::bf16*)(WSP(bf16, WS_Q) + (size_t)tok0 * 512 + hq * 64), (const attn_body::bf16*)(WSP(bf16, WS_KB) + kvo), (const attn_body::bf16*)(WSP(bf16, WS_VB) + kvo), (attn_body::bf16*)(WSP(bf16, WS_Q) + (size_t)tok0 * 512 + hq * 64), NT, (char*)lds);
    }
#endif
    GRID_SYNC();
    RUN_CHECKS(2);

#if PROBE == 1
    {
        LOAD_ARGS();
        const long gtid = (long)bx * 512 + tid, nthr = (long)G * 512;
        for (long id = gtid; id < (long)NTOK * 128; id += nthr) { const long t = id >> 7; const int c = (int)(id & 127) * 8;
            const bf16* src = c < 512 ? WSP(bf16, WS_F) + t * 512 + c : WSP(bf16, WS_Q) + t * 512 + (c - 512);
            const v4u w = *(const v4u*)src; float* o = AOUT() + t * 1024 + c;
            o[0] = __uint_as_float(w.x << 16); o[1] = __uint_as_float(w.x & 0xffff0000u); o[2] = __uint_as_float(w.y << 16); o[3] = __uint_as_float(w.y & 0xffff0000u);
            o[4] = __uint_as_float(w.z << 16); o[5] = __uint_as_float(w.z & 0xffff0000u); o[6] = __uint_as_float(w.w << 16); o[7] = __uint_as_float(w.w & 0xffff0000u); }
        return;
    }
#endif
#if (PHM>>5)&1
    { LOAD_ARGS();
        pg8::StaticOrder S; S.init(NTOK, 1024, G, bx);
        { pg8::Gemm g{WSP(bf16, WS_Q), WSP(bf16, WS_WA), NTOK, 1024, 512}; pg8::EpiMerge<0> E; E.GA = WSP(bf16, WS_GA); E.MG = WSP(bf16, WS_MG);
          pg8::gemm_phase<pg8::EpiMerge<0>, pg8::StaticOrder, PG_ALIGN, PG_SP2>(L3, g, S, E); }
        { pg8::Gemm g{WSP(bf16, WS_F), WSP(bf16, WS_WF), NTOK, 1024, 512}; pg8::EpiMerge<1> E; E.GA = WSP(bf16, WS_GA); E.MG = WSP(bf16, WS_MG);
          pg8::gemm_phase<pg8::EpiMerge<1>, pg8::StaticOrder, PG_ALIGN, PG_SP2>(L3, g, S, E); }
    }
    GRID_SYNC();
    RUN_CHECKS(3);
#endif
#if PROBE == 4
    {
        LOAD_ARGS();
        const int gw = bx * 8 + wave, NGW = G * 8;
        for (int m = gw; m < NTOK; m += NGW) { const bf16* gr = WSP(bf16, WS_GA) + (size_t)m * 2048;
            const v4u a = *(const v4u*)(gr + lane * 8), b = *(const v4u*)(gr + 1024 + lane * 8);
            asm volatile("s_waitcnt vmcnt(0)" ::: "memory");
            float* o = AOUT() + (size_t)m * 1024 + lane * 8;
            o[0] = __uint_as_float(a.x << 16); o[1] = __uint_as_float(a.x & 0xffff0000u); o[2] = __uint_as_float(a.y << 16); o[3] = __uint_as_float(a.y & 0xffff0000u);
            o[4] = __uint_as_float(a.z << 16); o[5] = __uint_as_float(a.z & 0xffff0000u); o[6] = __uint_as_float(a.w << 16); o[7] = __uint_as_float(a.w & 0xffff0000u);
            o += 512;
            o[0] = __uint_as_float(b.x << 16); o[1] = __uint_as_float(b.x & 0xffff0000u); o[2] = __uint_as_float(b.y << 16); o[3] = __uint_as_float(b.y & 0xffff0000u);
            o[4] = __uint_as_float(b.z << 16); o[5] = __uint_as_float(b.z & 0xffff0000u); o[6] = __uint_as_float(b.w << 16); o[7] = __uint_as_float(b.w & 0xffff0000u); }
        return;
    }
#endif
#if PROBE == 3
    {
        LOAD_ARGS();
        const long gtid = (long)bx * 512 + tid, nthr = (long)G * 512;
        for (long id = gtid; id < (long)NTOK * 128; id += nthr) { const long t = id >> 7; const int c = (int)(id & 127) * 8;
            const v4u w = *(const v4u*)(WSP(bf16, WS_MG) + t * 1024 + c); float* o = AOUT() + t * 1024 + c;
            o[0] = __uint_as_float(w.x << 16); o[1] = __uint_as_float(w.x & 0xffff0000u); o[2] = __uint_as_float(w.y << 16); o[3] = __uint_as_float(w.y & 0xffff0000u);
            o[4] = __uint_as_float(w.z << 16); o[5] = __uint_as_float(w.z & 0xffff0000u); o[6] = __uint_as_float(w.w << 16); o[7] = __uint_as_float(w.w & 0xffff0000u); }
        return;
    }
#endif
#if (PHM>>6)&1
    { LOAD_ARGS();
        pg8::Gemm g{WSP(bf16, WS_MG), WSP(bf16, WS_WO), NTOK, 1024, 1024}; pg8::StaticOrder S; S.init(NTOK, 1024, G, bx);
        pg8::EpiX1 E; E.xp = AIN(0); E.xs = AIN(1); E.out = AOUT(); E.X1B = WSP(bf16, WS_X1B); E.ss1 = WSP(float, WS_SS1);
        pg8::gemm_phase<pg8::EpiX1, pg8::StaticOrder, PG_ALIGN, PG_SP2>(L3, g, S, E);
    }
#endif
    GRID_SYNC();
    RUN_CHECKS(4);
#if PROBE == 2
    return;
#endif
#if (PHM>>7)&1
    { LOAD_ARGS();
        pg8::Gemm g{WSP(bf16, WS_X1B), WSP(bf16, WS_WFFN), NTOK, 5632, 1024}; pg8::StaticOrder S; S.init(NTOK, 5632, G, bx);
        pg8::EpiF1 E; E.ss1 = WSP(float, WS_SS1); E.U = WSP(bf16, WS_U);
        pg8::gemm_phase<pg8::EpiF1, pg8::StaticOrder, PG_ALIGN, PG_SP2>(L3, g, S, E);
    }
#endif
    GRID_SYNC();
    RUN_CHECKS(5);
#if (PHM>>8)&1
    { LOAD_ARGS();
        pg8::Gemm g{WSP(bf16, WS_U), WSP(bf16, WS_WDN), NTOK, 1024, 2816}; pg8::StaticOrder S; S.init(NTOK, 1024, G, bx);
        pg8::EpiF2 E; E.out = AOUT(); E.ss2 = WSP(float, WS_SS2);
        pg8::gemm_phase<pg8::EpiF2, pg8::StaticOrder, PG_ALIGN, PG_SP2>(L3, g, S, E);
    }
#endif
    GRID_SYNC();
    RUN_CHECKS(6);
    { LOAD_ARGS();
        const int gw = bx * 8 + wave, NGW = G * 8; const f32x4* gf = (const f32x4*)AIN(13) + lane;
        for (int m = gw; m < NTOK; m += NGW) { f32x4* o = (f32x4*)(AOUT() + (size_t)m * 1024) + lane; const float rs = rsqrtf(__hip_atomic_load(WSP(float, WS_SS2) + m, __ATOMIC_RELAXED, __HIP_MEMORY_SCOPE_AGENT) * (1.f / 1024.f) + EPS);
#pragma unroll
            for (int j = 0; j < 4; ++j) o[64 * j] = o[64 * j] * rs * gf[64 * j]; }
    }
#if TSTAMP
    { asm volatile("s_waitcnt vmcnt(0)" ::: "memory"); grid.sync(); LOAD_ARGS(); const unsigned long long tend = __builtin_amdgcn_s_memrealtime();
      if (bx == 0 && tid == 0) { const unsigned long long a_ = ts_[TS_A], b_ = (TS_B == 8) ? tend : ts_[TS_B]; AOUT()[0] = 1000.0f * (float)(b_ - a_) * 0.01f; } }
#endif
#if CHECKS
    { asm volatile("s_waitcnt vmcnt(0)" ::: "memory"); grid.sync(); LOAD_ARGS(); if (bx == 0 && tid == 0) { for (int st = 0; st < 7; ++st) { const unsigned v = __hip_atomic_load(WSP(unsigned, WS_CTL) + 200 + st, __ATOMIC_RELAXED, __HIP_MEMORY_SCOPE_AGENT);
        if (v) { AOUT()[0] = (float)st * 1e7f + 1e6f + 8e6f * (float)v / 131072.0f; break; } } } }
#endif
}

extern "C" void kernel_launch(void* const* d_in, const int* in_sizes, int n_in, void* d_out, int out_size, void* d_ws, size_t ws_size, hipStream_t stream) {
    static int grid = 0;
    if (grid == 0) {
        if (n_in != 14 || out_size != NTOK * 1024 || ws_size < WS_END) { fprintf(stderr, "kernel_launch: unexpected shapes: n_in %d out %d ws %zu (need %zu)\n", n_in, out_size, ws_size, (size_t)WS_END); grid = -1; return; }
        int dev = 0, cus = 0, per_cu = 0;
        hipGetDevice(&dev); hipDeviceGetAttribute(&cus, hipDeviceAttributeMultiprocessorCount, dev);
        if (hipFuncSetAttribute((const void*)enc_fwd, hipFuncAttributeMaxDynamicSharedMemorySize, LDS_BYTES) != hipSuccess) { fprintf(stderr, "kernel_launch: hipFuncSetAttribute failed\n"); grid = -1; return; }
        if (hipOccupancyMaxActiveBlocksPerMultiprocessor(&per_cu, (const void*)enc_fwd, 512, LDS_BYTES) != hipSuccess || per_cu < 1) { fprintf(stderr, "kernel_launch: occupancy query says %d\n", per_cu); per_cu = 1; }
        (void)hipGetLastError();
        grid = cus * per_cu;
    }
    if (grid < 0) return;
    hipMemsetAsync((char*)d_ws + WS_CTL, 0, CTL_BYTES, stream);
    Args a{};
    for (int i = 0; i < 14; ++i) a.in[i] = (const float*)d_in[i];
    a.out = (float*)d_out; a.ws = (unsigned char*)d_ws;
    void* kargs[] = {&a};
    hipError_t e = hipLaunchCooperativeKernel((const void*)enc_fwd, dim3(grid), dim3(512), kargs, LDS_BYTES, stream);
    if (e != hipSuccess) fprintf(stderr, "cooperative launch failed: %s (grid %d)\n", hipGetErrorString(e), grid);
}
```

```cpp
#include <hip/hip_runtime.h>
#include <hip/hip_cooperative_groups.h>
#include <cstdio>
#include <cstdint>
namespace cg = cooperative_groups;
#ifndef PHM
#define PHM 0x1ff
#endif
#ifndef PROBE
#define PROBE 0
#endif
#ifndef PG_ALIGN
#define PG_ALIGN true
#endif
#ifndef PG_SP2
#define PG_SP2 true
#endif
#ifndef CHECKS
#define CHECKS 0
#endif
#ifndef TSTAMP
#define TSTAMP 0
#endif
#ifndef TS_A
#define TS_A 0
#endif
#ifndef TS_B
#define TS_B 1
#endif
namespace pg8 {
#define PG8_LAS __attribute__((address_space(3)))
typedef unsigned short bf16_t;
typedef short bf16x8 __attribute__((ext_vector_type(8)));
typedef float f32x4 __attribute__((ext_vector_type(4)));
typedef unsigned u32x4 __attribute__((ext_vector_type(4)));
constexpr int BM = 256, BK = 64, HALF = 128, HTB = HALF * BK * 2  , STAGE_BYTES = 8 * HTB, NXCD = 8, WGM = 8;

__host__ __device__ __forceinline__ int lds_byte(int r, int c) { const int st = (r >> 4) * 2 + (c >> 5), rr = r & 15, cc = c & 31, ob = rr * 64 + cc * 2; return st * 1024 + (ob ^ (((ob >> 9) & 1) << 5)); }
__host__ __device__ __forceinline__ void stage_rc(int b, int& R, int& C) { const int st = b / 1024, sb = b % 1024, swz = sb ^ (((sb >> 9) & 1) << 5); R = (st >> 1) * 16 + swz / 64; C = (st & 1) * 32 + (swz % 64) / 2; }
__host__ __device__ __forceinline__ int perm32(int rho) { const int n = rho >> 4, i = rho & 15; return 8 * (i >> 2) + 4 * n + (i & 3); }

struct Unit { int pm, pn; };
struct Gemm { const bf16_t* A; const bf16_t* Bt; int M, N, K; };

struct StaticOrder {
    int nM, nN, nwg, G, c;
    __host__ __device__ void init(int M, int N, int G_, int c_) { nM = M / BM; nN = N / BM; nwg = nM * nN; G = G_; c = c_; }
    __host__ __device__ bool next(int i, Unit& u) const {
        const long L = (long)i * G + c; if (L >= nwg) return false;
        int wgid = (int)L; { const int q = nwg / NXCD, r = nwg % NXCD, xcd = wgid % NXCD, off = wgid / NXCD; wgid = (xcd < r ? xcd * (q + 1) : r * (q + 1) + (xcd - r) * q) + off; }
        const int nig = WGM * nN, gid = wgid / nig, fm = gid * WGM, gsz = (nM - fm) < WGM ? (nM - fm) : WGM;
        u.pm = fm + ((wgid % nig) % gsz); u.pn = (wgid % nig) / gsz; return true;
    }
    __device__ __forceinline__ void a_ready(const Unit&) const {}
    __device__ __forceinline__ void done(const Unit&) const {}
};

typedef float f32x2c_t __attribute__((ext_vector_type(2))); typedef __bf16 bf16x2c_t __attribute__((ext_vector_type(2)));
__device__ __forceinline__ unsigned cvt_pk_bf16(float lo, float hi) { f32x2c_t v = {lo, hi}; bf16x2c_t b = __builtin_convertvector(v, bf16x2c_t); return __builtin_bit_cast(unsigned, b); }
typedef float f32x2 __attribute__((ext_vector_type(2)));
template <class Epi, class Sched, bool ALIGN_EPI = false, bool SP2 = false>
__device__ __forceinline__ void gemm_phase(PG8_LAS unsigned char* lds, const Gemm g, const Sched& S, const Epi& E) {
    int tid_ = threadIdx.x; asm volatile("" : "+v"(tid_));
    const int tid = tid_, wid = __builtin_amdgcn_readfirstlane(tid >> 6), lane = tid & 63, wr = wid >> 2, wc = wid & 3, fr = lane & 15, fq = lane >> 4;
    const int K = g.K, nt = K / BK;
    unsigned voffA[2], voffB[2];
#pragma unroll
    for (int i = 0; i < 2; ++i) { int R, C; stage_rc(tid * 16 + i * 8192, R, C); const int Rb = Epi::PERM ? ((R & ~31) + perm32(R & 31)) : R;
        voffA[i] = (unsigned)(R * K + C) * 2u; voffB[i] = (unsigned)(Epi::brow(Rb) * K + C) * 2u; }
    const size_t kstep = (size_t)(BK * 2);
    const size_t hstep = (size_t)HALF * K * 2;
    const size_t tstep = 2 * hstep;
    const unsigned ldsw = (unsigned)wid * 1024u;
    const int aoff = lds_byte(wr * 64 + fr, fq * 8), boff = lds_byte(wc * 32 + fr, fq * 8);
#define PG8_SA(b, h) (((b) * 2 + (h)) * HTB)
#define PG8_SB(b, h) ((4 + (b) * 2 + (h)) * HTB)
#define PG8_STAGE(bufoff, gbase, voff) do { _Pragma("unroll") for (int _i = 0; _i < 2; ++_i) \
        __builtin_amdgcn_global_load_lds((const unsigned*)((const char*)(gbase) + (voff)[_i]), (PG8_LAS unsigned*)(lds + (bufoff) + ldsw + _i * 8192), 16, 0, 0); } while (0)
#define PG8_LDA(dst, b, h) do { _Pragma("unroll") for (int m = 0; m < 4; ++m) _Pragma("unroll") for (int k = 0; k < 2; ++k) dst[m][k] = *(const PG8_LAS bf16x8*)(lds + PG8_SA(b, h) + aoff + m * 2048 + k * 1024); } while (0)
#define PG8_LDB(dst, b, h) do { _Pragma("unroll") for (int n = 0; n < 2; ++n) _Pragma("unroll") for (int k = 0; k < 2; ++k) dst[n][k] = *(const PG8_LAS bf16x8*)(lds + PG8_SB(b, h) + boff + n * 2048 + k * 1024); } while (0)
#define PG8_MMA(ai, bj, At, Bt) do { __builtin_amdgcn_s_setprio(1); _Pragma("unroll") for (int m = 0; m < 4; ++m) _Pragma("unroll") for (int n = 0; n < 2; ++n) _Pragma("unroll") for (int k = 0; k < 2; ++k) \
        acc[ai][bj][m][n] = __builtin_amdgcn_mfma_f32_16x16x32_bf16(Bt[n][k], At[m][k], acc[ai][bj][m][n], 0, 0, 0); __builtin_amdgcn_s_setprio(0); } while (0)
#define PG8_WAIT_V(n) asm volatile("s_waitcnt vmcnt(" #n ")" ::: "memory")
#define PG8_WAIT_L(n) asm volatile("s_waitcnt lgkmcnt(" #n ")" ::: "memory")
#define PG8_BAR __builtin_amdgcn_s_barrier()
#define PG8_SCHED __builtin_amdgcn_sched_barrier(0)
    Unit cur, nxt; int ui = 0;
    if (!S.next(0, cur)) return;
    f32x4 acc[2][2][4][2];
#pragma unroll
    for (int a = 0; a < 2; ++a)
#pragma unroll
        for (int b = 0; b < 2; ++b)
#pragma unroll
            for (int m = 0; m < 4; ++m)
#pragma unroll
                for (int n = 0; n < 2; ++n) acc[a][b][m][n] = (f32x4){0.f, 0.f, 0.f, 0.f};
    bf16x8 At[4][2], B0[2][2], B1[2][2];
    const char* cA = (const char*)g.A + (size_t)cur.pm * tstep; const char* cB = (const char*)g.Bt + (size_t)cur.pn * tstep;
    S.a_ready(cur);
    if constexpr (SP2) {
        PG8_STAGE(PG8_SB(0, 0), cB, voffB); PG8_STAGE(PG8_SB(0, 1), cB + hstep, voffB); PG8_STAGE(PG8_SA(0, 0), cA, voffA); PG8_STAGE(PG8_SA(0, 1), cA + hstep, voffA);
        if (wr == 1) PG8_BAR;
        PG8_WAIT_V(2); PG8_BAR;
        PG8_STAGE(PG8_SB(1, 0), cB + kstep, voffB); PG8_STAGE(PG8_SA(1, 0), cA + kstep, voffA); PG8_STAGE(PG8_SB(1, 1), cB + hstep + kstep, voffB);
        PG8_WAIT_V(6); PG8_BAR;
    } else {
        PG8_STAGE(PG8_SB(0, 0), cB, voffB); PG8_STAGE(PG8_SA(0, 0), cA, voffA); PG8_STAGE(PG8_SB(0, 1), cB + hstep, voffB); PG8_STAGE(PG8_SA(0, 1), cA + hstep, voffA);
        if (wr == 1) PG8_BAR;
        PG8_WAIT_V(4); PG8_BAR;
        PG8_STAGE(PG8_SB(1, 0), cB + kstep, voffB); PG8_STAGE(PG8_SA(1, 0), cA + kstep, voffA); PG8_STAGE(PG8_SB(1, 1), cB + hstep + kstep, voffB);
        PG8_WAIT_V(6); PG8_BAR;
    }
    for (;;) {
        const bool has_next = S.next(ui + 1, nxt);
        const char* nA = has_next ? (const char*)g.A + (size_t)nxt.pm * tstep : cA; const char* nB = has_next ? (const char*)g.Bt + (size_t)nxt.pn * tstep : cB;
        for (int t = 0; t < nt; t += 2) {
            const bool last = (t == nt - 2);
            const char* a1 = cA + (size_t)(t + 1) * kstep;
            const char* a2 = last ? nA : cA + (size_t)(t + 2) * kstep; const char* b2 = last ? nB : cB + (size_t)(t + 2) * kstep;
            const char* a3 = a2 + kstep; const char* b3 = b2 + kstep;
            if (last && has_next) S.a_ready(nxt);
            if constexpr (SP2) {
            PG8_LDB(B0, 0, 0); PG8_LDB(B1, 0, 1); PG8_SCHED; PG8_LDA(At, 0, 0); PG8_STAGE(PG8_SA(1, 1), a1 + hstep, voffA);
            PG8_WAIT_V(8); PG8_WAIT_L(0); PG8_BAR; PG8_MMA(0, 0, At, B0); PG8_MMA(0, 1, At, B1); PG8_BAR; PG8_SCHED;
            PG8_LDA(At, 0, 1); PG8_STAGE(PG8_SB(0, 0), b2, voffB); PG8_STAGE(PG8_SB(0, 1), b2 + hstep, voffB); PG8_STAGE(PG8_SA(0, 0), a2, voffA);
            PG8_WAIT_V(8); PG8_WAIT_L(0); PG8_BAR; PG8_MMA(1, 0, At, B0); PG8_MMA(1, 1, At, B1); PG8_BAR; PG8_SCHED;
            PG8_LDB(B0, 1, 0); PG8_LDB(B1, 1, 1); PG8_SCHED; PG8_LDA(At, 1, 0); PG8_STAGE(PG8_SA(0, 1), a2 + hstep, voffA);
            PG8_WAIT_V(8); PG8_WAIT_L(0); PG8_BAR; PG8_MMA(0, 0, At, B0); PG8_MMA(0, 1, At, B1); PG8_BAR; PG8_SCHED;
            PG8_LDA(At, 1, 1); PG8_STAGE(PG8_SB(1, 0), b3, voffB); PG8_STAGE(PG8_SB(1, 1), b3 + hstep, voffB); PG8_STAGE(PG8_SA(1, 0), a3, voffA);
            PG8_WAIT_V(8); PG8_WAIT_L(0); PG8_BAR; PG8_MMA(1, 0, At, B0); PG8_MMA(1, 1, At, B1); PG8_BAR; PG8_SCHED;
            } else {
            PG8_LDB(B0, 0, 0); PG8_SCHED; PG8_LDA(At, 0, 0); PG8_STAGE(PG8_SA(1, 1), a1 + hstep, voffA);
            PG8_WAIT_L(8); PG8_BAR; PG8_WAIT_L(0); PG8_MMA(0, 0, At, B0); PG8_BAR; PG8_SCHED;
            PG8_LDB(B1, 0, 1); PG8_STAGE(PG8_SB(0, 0), b2, voffB);
            PG8_BAR; PG8_WAIT_L(0); PG8_MMA(0, 1, At, B1); PG8_BAR;
            PG8_LDA(At, 0, 1); PG8_STAGE(PG8_SA(0, 0), a2, voffA);
            PG8_BAR; PG8_WAIT_L(0); PG8_MMA(1, 0, At, B0); PG8_BAR; PG8_SCHED;
            PG8_STAGE(PG8_SB(0, 1), b2 + hstep, voffB);
            PG8_WAIT_V(6); PG8_BAR; PG8_MMA(1, 1, At, B1); PG8_BAR;
            PG8_LDB(B0, 1, 0); PG8_SCHED; PG8_LDA(At, 1, 0); PG8_STAGE(PG8_SA(0, 1), a2 + hstep, voffA);
            PG8_WAIT_L(8); PG8_BAR; PG8_WAIT_L(0); PG8_MMA(0, 0, At, B0); PG8_BAR; PG8_SCHED;
            PG8_LDB(B1, 1, 1); PG8_STAGE(PG8_SB(1, 0), b3, voffB);
            PG8_BAR; PG8_WAIT_L(0); PG8_MMA(0, 1, At, B1); PG8_BAR;
            PG8_LDA(At, 1, 1); PG8_STAGE(PG8_SA(1, 0), a3, voffA);
            PG8_BAR; PG8_WAIT_L(0); PG8_MMA(1, 0, At, B0); PG8_BAR; PG8_SCHED;
            PG8_STAGE(PG8_SB(1, 1), b3 + hstep, voffB);
            PG8_WAIT_V(6); PG8_BAR; PG8_MMA(1, 1, At, B1); PG8_BAR;
            }
        }
        if constexpr (ALIGN_EPI) { if (wr == 0) PG8_BAR; }
        if constexpr (!Epi::AFTER_DRAIN) { E(acc, cur, wr, wc, fr, fq); S.done(cur); }
        if (!has_next) break;
#pragma unroll
        for (int a = 0; a < 2; ++a)
#pragma unroll
            for (int b = 0; b < 2; ++b)
#pragma unroll
                for (int m = 0; m < 4; ++m)
#pragma unroll
                    for (int n = 0; n < 2; ++n) acc[a][b][m][n] = (f32x4){0.f, 0.f, 0.f, 0.f};
        cur = nxt; cA = nA; cB = nB; ++ui;
        if constexpr (ALIGN_EPI) { if (wr == 1) PG8_BAR; }
    }
    PG8_WAIT_V(0);
    if constexpr (!ALIGN_EPI) { if (wr == 0) PG8_BAR; }
    PG8_BAR;
    if constexpr (Epi::AFTER_DRAIN) { E.fused(acc, cur, wr, wc, fr, fq, lds, wid, lane); S.done(cur); }
#undef PG8_SA
#undef PG8_SB
#undef PG8_STAGE
#undef PG8_LDA
#undef PG8_LDB
#undef PG8_MMA
#undef PG8_WAIT_V
#undef PG8_WAIT_L
#undef PG8_BAR
#undef PG8_SCHED
}
}
constexpr int NTOK = 98304;
constexpr int NMT = NTOK / 256;
constexpr int P_TOK = 32768;
constexpr int LP = 2064, LS = 8208;
constexpr int KPP = 2176, KPS = 8320;
constexpr int MTP = 5, MTS = 17;
constexpr int K2P = 1152, K2S = 4224;
constexpr size_t KV_S_OFF = (size_t)16 * 2 * KPP * 64;
constexpr float EPS = 1e-6f;
constexpr float QC2 = 0.125f * 1.4426950408889634f;

namespace pg8 {
__device__ __forceinline__ u32x4 pack8(f32x4 a, f32x4 b) { u32x4 w; w.x = cvt_pk_bf16(a[0], a[1]); w.y = cvt_pk_bf16(a[2], a[3]); w.z = cvt_pk_bf16(b[0], b[1]); w.w = cvt_pk_bf16(b[2], b[3]); return w; }
__device__ __forceinline__ void unpack8(u32x4 w, f32x4& a, f32x4& b) {
    a[0] = __uint_as_float(w.x << 16); a[1] = __uint_as_float(w.x & 0xffff0000u); a[2] = __uint_as_float(w.y << 16); a[3] = __uint_as_float(w.y & 0xffff0000u);
    b[0] = __uint_as_float(w.z << 16); b[1] = __uint_as_float(w.z & 0xffff0000u); b[2] = __uint_as_float(w.w << 16); b[3] = __uint_as_float(w.w & 0xffff0000u); }
__device__ __forceinline__ float sigm(float x) { return __builtin_amdgcn_rcpf(1.0f + __expf(-x)); }
__device__ __forceinline__ float dot4(f32x4 a) { return (a[0] * a[0] + a[1] * a[1]) + (a[2] * a[2] + a[3] * a[3]); }
__device__ __forceinline__ size_t kvoff(int seq, int kvh) { return seq < 16 ? (size_t)(seq * 2 + kvh) * KPP * 64 : KV_S_OFF + (size_t)((seq - 16) * 2 + kvh) * KPS * 64; }
__device__ __forceinline__ int seqlen(int seq) { return seq < 16 ? 2048 : 8192; }

struct EpiBase { static constexpr bool PERM = true, AFTER_DRAIN = false; static __host__ __device__ __forceinline__ int brow(int R) { return R; } };

struct G1Order {
    StaticOrder so; int nwg, G, c;
    __device__ void init(int G_, int c_) { so.init(NTOK, 2816, G_, c_); nwg = so.nwg; G = G_; c = c_; }
    __device__ bool next(int i, Unit& u) const { if (so.next(i, u)) return true; if ((long)i * G + c == (long)nwg + 72) { u.pm = NMT; u.pn = 2; return true; } return false; }
    __device__ __forceinline__ void a_ready(const Unit&) const {}
    __device__ __forceinline__ void done(const Unit&) const {}
};
struct DftOrder {
    int G, c, total, sample;
    __device__ bool next(int i, Unit& u) const {
        const long idx = (long)i * G + c; if (idx >= total) return false; const int id = (int)idx;
        if (sample) { if (id < 256) { const int x = id & 7, slot = id >> 3; u.pm = 2 * x + (slot >> 4); u.pn = slot & 15; } else { u.pm = 16; u.pn = id - 256; } }
        else { u.pm = id >> 5; u.pn = id & 31; }
        return true; }
    __device__ __forceinline__ void a_ready(const Unit&) const {}
    __device__ __forceinline__ void done(const Unit&) const {}
};

struct EpiG1 : EpiBase {
    bf16_t *Q, *KB, *VB, *GA; const float *rope, *gq, *gk;
    __device__ __forceinline__ void qk_row(const f32x4& a00, const f32x4& a01, const f32x4& a10, const f32x4& a11, const f32x4 (&gv)[2][2], int prow, int pcol, int fq, float osc, u32x4 (&w)[2]) const {
        float ss = (dot4(a00) + dot4(a01)) + (dot4(a10) + dot4(a11));
        ss += __shfl_xor(ss, 16); ss += __shfl_xor(ss, 32);
        const float rs = rsqrtf(ss * (1.0f / 64.0f) + EPS) ;
        { const int pp = prow + 1; const f32x4 c = *(const f32x4*)(rope + pp * 32 + 4 * fq), s = *(const f32x4*)(rope + pp * 32 + 16 + 4 * fq);
          const f32x4 x1 = a00 * rs * gv[0][0], x2 = a01 * rs * gv[0][1]; w[0] = pack8((x1 * c - x2 * s) * osc, (x2 * c + x1 * s) * osc); }
        { const int pp = pcol + 1; const f32x4 c = *(const f32x4*)(rope + pp * 32 + 4 * fq), s = *(const f32x4*)(rope + pp * 32 + 16 + 4 * fq);
          const f32x4 x1 = a10 * rs * gv[1][0], x2 = a11 * rs * gv[1][1]; w[1] = pack8((x1 * c - x2 * s) * osc, (x2 * c + x1 * s) * osc); }
    }
    __device__ __forceinline__ void operator()(const f32x4 (&acc)[2][2][4][2], const Unit& u, int wr, int wc, int fr, int fq) const {
        asm volatile("" : "+v"(fr), "+v"(fq));
        const int pm = u.pm, pn = u.pn;
        if (pm == NMT) {
            if (pn != 2 || wr != 0) return;
            u32x4 w[2]; bf16_t* base;
            if (wc < 2) { f32x4 gv[2][2];
#pragma unroll
                for (int bj = 0; bj < 2; ++bj)
#pragma unroll
                    for (int n = 0; n < 2; ++n) gv[bj][n] = *(const f32x4*)(gk + 32 * bj + 16 * n + 4 * fq);
                qk_row(acc[0][0][0][0], acc[0][0][0][1], acc[0][1][0][0], acc[0][1][0][1], gv, -1, fr, fq, 1.0f, w); base = KB; }
            else { w[0] = pack8(acc[0][0][0][0], acc[0][0][0][1]); w[1] = pack8(acc[0][1][0][0], acc[0][1][0][1]); base = VB; }
            const int kvh = wc & 1;
#pragma unroll 1
            for (int s = 0; s < 24; ++s) { bf16_t* d = base + kvoff(s, kvh) + (size_t)(seqlen(s) + fr) * 64 + 8 * fq; *(u32x4*)d = w[0]; *(u32x4*)(d + 32) = w[1]; }
            return;
        }
        if (pn >= 3) {
            const int col0 = (pn - 3) * 256 + wc * 32 + 8 * fq;
#pragma unroll
            for (int ai = 0; ai < 2; ++ai)
#pragma unroll
                for (int m = 0; m < 4; ++m) { bf16_t* rp = GA + (size_t)(pm * 256 + ai * 128 + wr * 64 + m * 16 + fr) * 2048 + col0;
#pragma unroll
                    for (int bj = 0; bj < 2; ++bj) { f32x4 v0 = acc[ai][bj][m][0], v1 = acc[ai][bj][m][1];
#pragma unroll
                        for (int j = 0; j < 4; ++j) { v0[j] = sigm(v0[j]); v1[j] = sigm(v1[j]); }
                        *(u32x4*)(rp + bj * 128) = pack8(v0, v1); } }
            return;
        }
        const int t0 = pm * 256; int seq, p0;
        if (t0 < P_TOK) { seq = t0 >> 11; p0 = t0 & 2047; } else { const int ts = t0 - P_TOK; seq = 16 + (ts >> 13); p0 = ts & 8191; }
        const bool isq = pn < 2;
        if (!isq && wc >= 2) {
            bf16_t* vb = VB + kvoff(seq, wc - 2) + (size_t)p0 * 64 + 8 * fq;
#pragma unroll
            for (int ai = 0; ai < 2; ++ai)
#pragma unroll
                for (int m = 0; m < 4; ++m) { const int rloc = ai * 128 + wr * 64 + m * 16 + fr;
#pragma unroll
                    for (int bj = 0; bj < 2; ++bj) *(u32x4*)(vb + (size_t)rloc * 64 + 32 * bj) = pack8(acc[ai][bj][m][0], acc[ai][bj][m][1]); }
            return;
        }
        const float* g = isq ? gq : gk; const float osc = isq ? QC2 : 1.0f;
        bf16_t* ob = isq ? Q + (size_t)t0 * 512 + (4 * pn + wc) * 64 + 8 * fq : KB + kvoff(seq, wc) + (size_t)p0 * 64 + 8 * fq; const int opitch = isq ? 512 : 64;
        f32x4 gv[2][2];
#pragma unroll
        for (int bj = 0; bj < 2; ++bj)
#pragma unroll
            for (int n = 0; n < 2; ++n) gv[bj][n] = *(const f32x4*)(g + 32 * bj + 16 * n + 4 * fq);
#pragma unroll
        for (int ai = 0; ai < 2; ++ai)
#pragma unroll
            for (int m = 0; m < 4; ++m) { const int rloc = ai * 128 + wr * 64 + m * 16 + fr; const int p = p0 + rloc;
                u32x4 w[2]; qk_row(acc[ai][0][m][0], acc[ai][0][m][1], acc[ai][1][m][0], acc[ai][1][m][1], gv, p >> 6, p & 63, fq, osc, w);
                bf16_t* d = ob + (size_t)rloc * opitch; *(u32x4*)d = w[0]; *(u32x4*)(d + 32) = w[1];
                asm volatile("" ::: "memory"); }
    }
};
struct EpiGT : EpiBase {
    bf16_t *GTp, *GTs;
    __device__ __forceinline__ bf16_t* dst(int seq, int ch) const { return seq < 16 ? GTp + ((size_t)seq * 512 + ch) * KPP : GTs + ((size_t)(seq - 16) * 512 + ch) * KPS; }
    __device__ __forceinline__ void operator()(const f32x4 (&acc)[2][2][4][2], const Unit& u, int wr, int wc, int fr, int fq) const {
        asm volatile("" : "+v"(fr), "+v"(fq));
        const bool meta = (u.pn == NMT);
        const int t0 = u.pn * 256; int seq, p0;
        if (t0 < P_TOK) { seq = t0 >> 11; p0 = t0 & 2047; } else { const int ts = t0 - P_TOK; seq = 16 + (ts >> 13); p0 = ts & 8191; }
#pragma unroll
        for (int ai = 0; ai < 2; ++ai)
#pragma unroll
            for (int m = 0; m < 4; ++m) { const int ch = u.pm * 256 + ai * 128 + wr * 64 + m * 16 + fr;
#pragma unroll
                for (int bj = 0; bj < 2; ++bj) { const u32x4 w = pack8(acc[ai][bj][m][0], acc[ai][bj][m][1]);
                    if (!meta) *(u32x4*)(dst(seq, ch) + 64 + p0 + bj * 128 + wc * 32 + 8 * fq) = w;
                    else if (bj == 0 && wc < 2) { for (int s = 0; s < 24; ++s) *(u32x4*)(dst(s, ch) + wc * 32 + 8 * fq) = w; } } }
    }
};
struct EpiDftP : EpiBase {
    static __host__ __device__ __forceinline__ int brow(int R) { return R <= 64 ? R : 128 - R; }
    float* dump; int nMt;
    __device__ __forceinline__ void operator()(const f32x4 (&acc)[2][2][4][2], const Unit& u, int wr, int wc, int fr, int fq) const {
        asm volatile("" : "+v"(fr), "+v"(fq));
        int tx_ = threadIdx.x; asm volatile("" : "+v"(tx_)); f32x4* d = (f32x4*)dump + (size_t)(u.pn * nMt + u.pm) * 32 * 512 + tx_;
#pragma unroll
        for (int ai = 0; ai < 2; ++ai)
#pragma unroll
            for (int bj = 0; bj < 2; ++bj)
#pragma unroll
                for (int m = 0; m < 4; ++m)
#pragma unroll
                    for (int n = 0; n < 2; ++n) d[(size_t)(((ai * 2 + bj) * 4 + m) * 2 + n) * 512] = acc[ai][bj][m][n];
    }
};
struct EpiDftQ : EpiBase {
    static __host__ __device__ __forceinline__ int brow(int R) { return (R == 0 || R == 64) ? 0 : (R < 64 ? 64 + R : 192 - R); }
    const float* dump; int nMt; bf16_t* F; int L, tokbase, nseq; float scale;
    __device__ __forceinline__ void operator()(const f32x4 (&acc)[2][2][4][2], const Unit& u, int wr, int wc, int fr, int fq) const {
        asm volatile("" : "+v"(fr), "+v"(fq));
        int tx_ = threadIdx.x; asm volatile("" : "+v"(tx_)); const f32x4* d = (const f32x4*)dump + (size_t)(u.pn * nMt + u.pm) * 32 * 512 + tx_;
        const int b = u.pn >> 1, pnl = u.pn & 1, tb = tokbase + b * nseq - 16, L2 = L >> 1;
        const float sg = (wc < 2) ? scale : -scale; const bool z0 = (fq == 0) && ((wc & 1) == 0);
#pragma unroll
        for (int ai = 0; ai < 2; ++ai)
#pragma unroll
            for (int m = 0; m < 4; ++m) { const int lp = u.pm * 256 + ai * 128 + wr * 64 + m * 16 + fr;
#pragma unroll
                for (int bj = 0; bj < 2; ++bj) {
                    const f32x4 P0 = d[(size_t)(((ai * 2 + bj) * 4 + m) * 2 + 0) * 512] * scale, P1 = d[(size_t)(((ai * 2 + bj) * 4 + m) * 2 + 1) * 512] * scale;
                    f32x4 q0 = acc[ai][bj][m][0] * sg, q1 = acc[ai][bj][m][1] * sg; if (z0) q0[0] = 0.f;
                    const int col = (pnl * 2 + bj) * 128 + wc * 32 + 8 * fq;
                    if (lp >= 16 && lp <= L2) *(u32x4*)(F + (size_t)(tb + lp) * 512 + col) = pack8(P0 - q0, P1 - q1);
                    if (lp >= 1 && lp < L2) *(u32x4*)(F + (size_t)(tb + L - lp) * 512 + col) = pack8(P0 + q0, P1 + q1); } }
    }
};
template <int SECOND> struct EpiMerge : EpiBase {
    const bf16_t* GA; bf16_t* MG;
    __device__ __forceinline__ void operator()(const f32x4 (&acc)[2][2][4][2], const Unit& u, int wr, int wc, int fr, int fq) const {
        asm volatile("" : "+v"(fr), "+v"(fq));
        const int col0 = u.pn * 256 + wc * 32 + 8 * fq;
#pragma unroll
        for (int ai = 0; ai < 2; ++ai)
#pragma unroll
            for (int m = 0; m < 4; ++m) { const size_t t = (size_t)(u.pm * 256 + ai * 128 + wr * 64 + m * 16 + fr);
#pragma unroll
                for (int bj = 0; bj < 2; ++bj) { const int c = col0 + bj * 128;
                    f32x4 g0, g1; unpack8(*(const u32x4*)(GA + t * 2048 + SECOND * 1024 + c), g0, g1);
                    f32x4 o0 = g0 * acc[ai][bj][m][0], o1 = g1 * acc[ai][bj][m][1];
                    if (SECOND) { f32x4 p0, p1; unpack8(*(const u32x4*)(MG + t * 1024 + c), p0, p1); o0 += p0; o1 += p1; }
                    *(u32x4*)(MG + t * 1024 + c) = pack8(o0, o1); } }
    }
};
struct EpiX1 : EpiBase {
    const float *xp, *xs; float* out; bf16_t* X1B; float* ss1;
    __device__ __forceinline__ void operator()(const f32x4 (&acc)[2][2][4][2], const Unit& u, int wr, int wc, int fr, int fq) const {
        asm volatile("" : "+v"(fr), "+v"(fq));
        const int col0 = u.pn * 256 + wc * 32 + 8 * fq;
#pragma unroll
        for (int ai = 0; ai < 2; ++ai)
#pragma unroll
            for (int m = 0; m < 4; ++m) { const int t = u.pm * 256 + ai * 128 + wr * 64 + m * 16 + fr;
                const float* xr = t < P_TOK ? xp + (size_t)t * 1024 : xs + (size_t)(t - P_TOK) * 1024; float part = 0.f;
#pragma unroll
                for (int bj = 0; bj < 2; ++bj) { const int c = col0 + bj * 128;
                    const f32x4 v0 = *(const f32x4*)(xr + c) + acc[ai][bj][m][0], v1 = *(const f32x4*)(xr + c + 4) + acc[ai][bj][m][1];
                    *(f32x4*)(out + (size_t)t * 1024 + c) = v0; *(f32x4*)(out + (size_t)t * 1024 + c + 4) = v1;
                    *(u32x4*)(X1B + (size_t)t * 1024 + c) = pack8(v0, v1); part += dot4(v0) + dot4(v1); }
                part += __shfl_xor(part, 16); part += __shfl_xor(part, 32);
                if (fq == 0) atomicAdd(ss1 + t, part); }
    }
};
struct EpiF1 : EpiBase {
    const float* ss1; bf16_t* U;
    __device__ __forceinline__ void operator()(const f32x4 (&acc)[2][2][4][2], const Unit& u, int wr, int wc, int fr, int fq) const {
        asm volatile("" : "+v"(fr), "+v"(fq));
        typedef unsigned u32x2 __attribute__((ext_vector_type(2)));
        const int col0 = u.pn * 128 + wc * 16 + 4 * fq;
#pragma unroll
        for (int ai = 0; ai < 2; ++ai)
#pragma unroll
            for (int m = 0; m < 4; ++m) { const int t = u.pm * 256 + ai * 128 + wr * 64 + m * 16 + fr;
                const float rs = rsqrtf(__hip_atomic_load(ss1 + t, __ATOMIC_RELAXED, __HIP_MEMORY_SCOPE_AGENT) * (1.0f / 1024.0f) + EPS);
#pragma unroll
                for (int bj = 0; bj < 2; ++bj) { const f32x4 gt = acc[ai][bj][m][0] * rs, up = acc[ai][bj][m][1] * rs; f32x4 o;
#pragma unroll
                    for (int j = 0; j < 4; ++j) o[j] = gt[j] * sigm(gt[j]) * up[j];
                    u32x2 w; w.x = cvt_pk_bf16(o[0], o[1]); w.y = cvt_pk_bf16(o[2], o[3]);
                    *(u32x2*)(U + (size_t)t * 2816 + col0 + bj * 64) = w; } }
    }
};
struct EpiF2 : EpiBase {
    float* out; float* ss2;
    __device__ __forceinline__ void operator()(const f32x4 (&acc)[2][2][4][2], const Unit& u, int wr, int wc, int fr, int fq) const {
        asm volatile("" : "+v"(fr), "+v"(fq));
        const int col0 = u.pn * 256 + wc * 32 + 8 * fq;
#pragma unroll
        for (int ai = 0; ai < 2; ++ai)
#pragma unroll
            for (int m = 0; m < 4; ++m) { const int t = u.pm * 256 + ai * 128 + wr * 64 + m * 16 + fr; float part = 0.f;
#pragma unroll
                for (int bj = 0; bj < 2; ++bj) { float* o = out + (size_t)t * 1024 + col0 + bj * 128;
                    const f32x4 v0 = *(const f32x4*)o + acc[ai][bj][m][0], v1 = *(const f32x4*)(o + 4) + acc[ai][bj][m][1];
                    *(f32x4*)o = v0; *(f32x4*)(o + 4) = v1; part += dot4(v0) + dot4(v1); }
                part += __shfl_xor(part, 16); part += __shfl_xor(part, 32);
                if (fq == 0) atomicAdd(ss2 + t, part); }
    }
};
}
#include <hip/hip_bf16.h>
#include <cmath>
namespace attn_body {
using bf16=__hip_bfloat16;
using bf16x8=__attribute__((ext_vector_type(8)))short;
using s16x4=__attribute__((ext_vector_type(4)))short;
using f32x16=__attribute__((ext_vector_type(16)))float;
using u32x4=__attribute__((ext_vector_type(4)))unsigned;
constexpr int D=64,QP=512,KP=64;
constexpr int NW=8,QBLK=32,QB=QBLK*NW,KVBLK=64;

__device__ __forceinline__ int crow(int r,int hi){return (r&3)+8*(r>>2)+4*hi;}
#define SBAR() __builtin_amdgcn_sched_barrier(0)
__device__ __forceinline__ void kmask(f32x16&p0,f32x16&p1,bool full){
  const float NEG=-INFINITY;
  #pragma unroll
  for(int r=0;r<16;++r){ if(full||r>=8)p0[r]=NEG; p1[r]=NEG; }
}

constexpr int NSLOT=3, SLOTB=8192;
constexpr int LDS_K=0, LDS_V=NSLOT*SLOTB, LDS_WS=2*NSLOT*SLOTB, LDS_OST=LDS_WS+NW*64*4, LDS_BYTES=LDS_OST+NW*4096;
constexpr float C2=0.125f*1.4426950408889634f;
__device__ __forceinline__ void glds16(const void*gsrc,unsigned lds_dst){unsigned keep;
  asm volatile("s_mov_b32 %0, m0\n\ts_mov_b32 m0, %2\n\ts_nop 0\n\tglobal_load_lds_dwordx4 %1, off\n\ts_mov_b32 m0, %0":"=&s"(keep):"v"(gsrc),"s"(lds_dst):"memory");}
__device__ __forceinline__ float max3f(float a,float b,float c){float r;asm("v_max3_f32 %0, %1, %2, %3":"=v"(r):"v"(a),"v"(b),"v"(c));return r;}
__device__ __forceinline__ float max2f(float a,float b){float r;asm("v_max_f32_e32 %0, %1, %2":"=v"(r):"v"(a),"v"(b));return r;}
__device__ __forceinline__ float fadd_s(float a,float b){float r;asm("v_add_f32_e32 %0, %1, %2":"=v"(r):"v"(a),"v"(b));return r;}
__device__ __forceinline__ float fsub_s(float a,float b){float r;asm("v_sub_f32_e32 %0, %1, %2":"=v"(r):"v"(a),"v"(b));return r;}
typedef float f32x2_t __attribute__((ext_vector_type(2))); typedef __bf16 bf16x2_t __attribute__((ext_vector_type(2)));
__device__ __forceinline__ unsigned cvtpk_s(float lo,float hi){f32x2_t v={lo,hi};bf16x2_t b=__builtin_convertvector(v,bf16x2_t);return __builtin_bit_cast(unsigned,b);}
#define WAIT_BAR(N) asm volatile("s_waitcnt vmcnt(" #N ") lgkmcnt(0)\n\ts_barrier":::"memory")

__device__ __forceinline__ void qkt(f32x16&p0,f32x16&p1,const char*Kslot,const bf16x8*qr,const f32x16&negm,int r32,int hi){
  const char*kb=Kslot+hi*1024+r32*16;
  #pragma unroll
  for(int d0=0;d0<4;++d0){
    const bf16x8 b0=*reinterpret_cast<const bf16x8*>(kb+d0*2048);
    const bf16x8 b1=*reinterpret_cast<const bf16x8*>(kb+d0*2048+512);
    if(d0==0){p0=__builtin_amdgcn_mfma_f32_32x32x16_bf16(b0,qr[0],negm,0,0,0);p1=__builtin_amdgcn_mfma_f32_32x32x16_bf16(b1,qr[0],negm,0,0,0);}
    else{p0=__builtin_amdgcn_mfma_f32_32x32x16_bf16(b0,qr[d0],p0,0,0,0);p1=__builtin_amdgcn_mfma_f32_32x32x16_bf16(b1,qr[d0],p1,0,0,0);}}
}
typedef __attribute__((address_space(3))) const char* lds_cptr;
typedef short v4i16_t __attribute__((ext_vector_type(4)));
__device__ __forceinline__ void kload8(bf16x8*kf,lds_cptr kp){
  kf[0]=*(const __attribute__((address_space(3))) bf16x8*)(kp);      kf[1]=*(const __attribute__((address_space(3))) bf16x8*)(kp+512);
  kf[2]=*(const __attribute__((address_space(3))) bf16x8*)(kp+2048); kf[3]=*(const __attribute__((address_space(3))) bf16x8*)(kp+2560);
  kf[4]=*(const __attribute__((address_space(3))) bf16x8*)(kp+4096); kf[5]=*(const __attribute__((address_space(3))) bf16x8*)(kp+4608);
  kf[6]=*(const __attribute__((address_space(3))) bf16x8*)(kp+6144); kf[7]=*(const __attribute__((address_space(3))) bf16x8*)(kp+6656);
}
__device__ __forceinline__ void kload2(bf16x8*kf,lds_cptr kp,int j){ kf[2*j]=*(const __attribute__((address_space(3))) bf16x8*)(kp+j*2048); kf[2*j+1]=*(const __attribute__((address_space(3))) bf16x8*)(kp+j*2048+512); }
__device__ __forceinline__ s16x4 vtr(lds_cptr p){ return __builtin_bit_cast(s16x4,__builtin_amdgcn_ds_read_tr16_b64_v4i16((__attribute__((address_space(3))) v4i16_t*)p)); }
__device__ __forceinline__ float rowmax(const f32x16&p0,const f32x16&p1){
  float a=max3f(p0[0],p0[1],p1[0]),b=max3f(p0[2],p0[3],p1[1]);a=max3f(a,p1[2],p1[3]);
  #pragma unroll
  for(int r=4;r<16;r+=4){a=max3f(a,p0[r],p0[r+1]);b=max3f(b,p0[r+2],p0[r+3]);a=max3f(a,p1[r],p1[r+1]);b=max3f(b,p1[r+2],p1[r+3]);}
  const float m=max2f(a,b);
  auto rr=__builtin_amdgcn_permlane32_swap(__float_as_uint(m),__float_as_uint(m),false,false);
  return max2f(__uint_as_float(rr[0]),__uint_as_float(rr[1]));
}
__device__ __forceinline__ void pv(f32x16*o,int vb,bf16x8 pa0,bf16x8 pa1,bf16x8 pa2,bf16x8 pa3){
  #pragma unroll
  for(int d0=0;d0<2;++d0){s16x4 lo[4],hi[4];
    #pragma unroll
    for(int ks=0;ks<4;++ks){
      asm volatile("ds_read_b64_tr_b16 %0,%1 offset:%c2":"=&v"(lo[ks]):"v"(vb),"i"(d0*4096+ks*1024):"memory");
      asm volatile("ds_read_b64_tr_b16 %0,%1 offset:%c2":"=&v"(hi[ks]):"v"(vb),"i"(d0*4096+ks*1024+512):"memory");}
    asm volatile("s_waitcnt lgkmcnt(0)":::"memory");SBAR();
    #define PK(k) (bf16x8){lo[k][0],lo[k][1],lo[k][2],lo[k][3],hi[k][0],hi[k][1],hi[k][2],hi[k][3]}
    o[d0]=__builtin_amdgcn_mfma_f32_32x32x16_bf16(pa0,PK(0),o[d0],0,0,0);
    o[d0]=__builtin_amdgcn_mfma_f32_32x32x16_bf16(pa1,PK(1),o[d0],0,0,0);
    o[d0]=__builtin_amdgcn_mfma_f32_32x32x16_bf16(pa2,PK(2),o[d0],0,0,0);
    o[d0]=__builtin_amdgcn_mfma_f32_32x32x16_bf16(pa3,PK(3),o[d0],0,0,0);
    #undef PK
  }
}

#ifndef ATTN_STORE16
#define ATTN_STORE16(p,v) (*(u32x4*)(p)=(v))
#endif
template<int THRL> __device__ __forceinline__ void attn_unit(const bf16*Qblk,const bf16*__restrict__ Kh,const bf16*__restrict__ Vh,bf16*Oblk,const int NT,char*shm){
  int tid_=threadIdx.x; asm volatile("":"+v"(tid_));
  const int tid=tid_,lane=tid&63,r32=lane&31,hi=lane>>5; const int wid=__builtin_amdgcn_readfirstlane(tid>>6);

  const bf16*Qw=Qblk+(long)(wid*QBLK)*QP;

  const unsigned lds0=(unsigned)(uintptr_t)shm;
  float*wsf=(float*)(shm+LDS_WS)+wid*64;
  const bf16*ksrc=Kh+(long)lane*KP+wid*8;
  const bf16*vsrc=Vh+(long)(16*(wid&3)+(lane>>2))*KP+(wid>>2)*32+(lane&3)*8;
  const unsigned kdst=lds0+LDS_K+wid*1024, vdst=lds0+LDS_V+wid*1024;
  #define DMA_K(t,slot) glds16(ksrc+(long)(t)*KVBLK*KP,(unsigned)__builtin_amdgcn_readfirstlane(kdst+(slot)))
  #define DMA_V(t,slot) glds16(vsrc+(long)(t)*KVBLK*KP,(unsigned)__builtin_amdgcn_readfirstlane(vdst+(slot)))
  const int vb0=(int)(lds0+LDS_V)+((lane>>4)&1)*32+(lane&3)*8+(4*hi+((lane&15)>>2))*64;
  const char*Kbase=shm+LDS_K; bf16x8 kf[8];
  const lds_cptr shm3=(lds_cptr)shm; const lds_cptr kp0=shm3+LDS_K+hi*1024+r32*16; const lds_cptr vp0=shm3+LDS_V+((lane>>4)&1)*32+(lane&3)*8+(4*hi+((lane&15)>>2))*64;
  DMA_K(0,0);DMA_V(0,0);DMA_K(1,SLOTB);
  bf16x8 qr[4];
  #pragma unroll
  for(int d0=0;d0<4;++d0)qr[d0]=*reinterpret_cast<const bf16x8*>(&Qw[(long)r32*QP+d0*16+hi*8]);
  float mhat=0.f,l_reg=0.f;f32x16 o[2];o[0]=f32x16{};o[1]=f32x16{};f32x16 negm=f32x16{};asm volatile("":"+v"(negm));
  const int qrel=wid*QBLK+r32;
  #define CMASK(P0,P1,t) do{}while(0)
  bool resc=false;
  #define START(P0,P1) do{ const float rm=rowmax(P0,P1); resc=false; \
    { const float dl=rm; mhat=fadd_s(mhat,dl); \
      _Pragma("unroll") for(int r=0;r<16;++r){P0[r]=fsub_s(P0[r],dl);P1[r]=fsub_s(P1[r],dl);} \
      _Pragma("unroll") for(int r=0;r<16;++r)negm[r]=-mhat; asm volatile("":"+v"(negm)); } \
    _Pragma("unroll") for(int r=0;r<16;++r)P0[r]=__builtin_amdgcn_exp2f(P0[r]); }while(0)
  #define RESC() do{ if(resc){ asm volatile("s_waitcnt lgkmcnt(0)":::"memory"); \
      _Pragma("unroll") for(int d_=0;d_<2;++d_) _Pragma("unroll") for(int r=0;r<16;++r)o[d_][r]*=wsf[crow(r,hi)]; } }while(0)
  f32x16 pA0,pA1,pB0,pB1;
  int sl_prev=0,sl_cur=0,sl_next=SLOTB;
  #define ROT() do{sl_prev=sl_cur;sl_cur=sl_next;sl_next=(sl_next==(NSLOT-1)*SLOTB)?0:sl_next+SLOTB;}while(0)
  DMA_K(2,2*SLOTB);
  WAIT_BAR(3);
  qkt(pA0,pA1,Kbase,qr,negm,r32,hi);asm volatile("s_nop 15\n\ts_nop 7":"+v"(pA0),"+v"(pA1));CMASK(pA0,pA1,0);
  START(pA0,pA1);
  _Pragma("unroll") for(int r=0;r<16;++r)pA1[r]=__builtin_amdgcn_exp2f(pA1[r]);
  WAIT_BAR(0);
  DMA_K(3,0);DMA_V(1,SLOTB);
  ROT();
  kload8(kf,kp0+sl_cur);
  WAIT_BAR(2);
  s16x4 vlo[8],vhi[8]; u32x4 pw0,pw1,pw2,pw3;
  #define PKW(P,B) cvtpk_s(P[B],P[B+1])
  #define PAF(k) __builtin_bit_cast(bf16x8,pw##k)
  #define VFR(i) (bf16x8){vlo[i][0],vlo[i][1],vlo[i][2],vlo[i][3],vhi[i][0],vhi[i][1],vhi[i][2],vhi[i][3]}
  #define PIN(x) asm volatile("":"+v"(x))
  #define MX3(a,b,c) __builtin_fmaxf(__builtin_fmaxf((a),(b)),(c))
  #define GAPA(MF,A0,A1,A2,A3,W0,W1,PW) do{ MF; sacc+=A0; sacc+=A1; sacc+=A2; sacc+=A3; PIN(sacc); W0; W1; PIN(PW); SBAR(); }while(0)
  #define EX(v) __builtin_amdgcn_exp2f(v)
  #define GAPB(MF,X,B) do{ MF; X[B]=EX(X[B]); X[B+1]=EX(X[B+1]); X[B+2]=EX(X[B+2]); X[B+3]=EX(X[B+3]); PIN(X); SBAR(); }while(0)
  #define VRD(i) do{ vlo[i]=vtr(vp_+(((i)>>2)*4096+((i)&3)*1024)); vhi[i]=vtr(vp_+(((i)>>2)*4096+((i)&3)*1024+512)); }while(0)
  #define KRD(G,j) do{ if(G){ kload2(kf,kp0+sl_next,j); SBAR(); } }while(0)
  #define STEP(C0,C1,P0,P1,t,GK,GV,GL) do{ SBAR(); \
    const lds_cptr vp_=vp0+sl_prev; \
    VRD(0); SBAR(); float sacc=(P0[0]+P0[1]); \
    GAPA(C0=__builtin_amdgcn_mfma_f32_32x32x16_bf16(kf[0],qr[0],negm,0,0,0), P0[2],P0[3],P0[4],P0[5],     pw0[0]=PKW(P0,0), pw0[1]=PKW(P0,2), pw0); \
    VRD(4); SBAR(); GAPA(C1=__builtin_amdgcn_mfma_f32_32x32x16_bf16(kf[1],qr[0],negm,0,0,0), P0[6],P0[7],P0[8],P0[9],     pw0[2]=PKW(P0,4), pw0[3]=PKW(P0,6), pw0); \
    VRD(1); SBAR(); GAPA(C0=__builtin_amdgcn_mfma_f32_32x32x16_bf16(kf[2],qr[1],C0,0,0,0),   P0[10],P0[11],P0[12],P0[13], pw1[0]=PKW(P0,8), pw1[1]=PKW(P0,10), pw1); \
    VRD(5); SBAR(); GAPA(C1=__builtin_amdgcn_mfma_f32_32x32x16_bf16(kf[3],qr[1],C1,0,0,0),   P0[14],P0[15],P1[0],P1[1],   pw1[2]=PKW(P0,12),pw1[3]=PKW(P0,14), pw1); \
    VRD(2); SBAR(); GAPA(C0=__builtin_amdgcn_mfma_f32_32x32x16_bf16(kf[4],qr[2],C0,0,0,0),   P1[2],P1[3],P1[4],P1[5],     pw2[0]=PKW(P1,0), pw2[1]=PKW(P1,2), pw2); \
    VRD(6); SBAR(); GAPA(C1=__builtin_amdgcn_mfma_f32_32x32x16_bf16(kf[5],qr[2],C1,0,0,0),   P1[6],P1[7],P1[8],P1[9],     pw2[2]=PKW(P1,4), pw2[3]=PKW(P1,6), pw2); \
    VRD(3); SBAR(); GAPA(C0=__builtin_amdgcn_mfma_f32_32x32x16_bf16(kf[6],qr[3],C0,0,0,0),   P1[10],P1[11],P1[12],P1[13], pw3[0]=PKW(P1,8), pw3[1]=PKW(P1,10), pw3); \
    VRD(7); SBAR(); GAPA(C1=__builtin_amdgcn_mfma_f32_32x32x16_bf16(kf[7],qr[3],C1,0,0,0),   P1[14],P1[15],0.f,0.f,       pw3[2]=PKW(P1,12),pw3[3]=PKW(P1,14), pw3); \
    l_reg+=sacc; \
    if(GK){DMA_K((t)+3,sl_cur);} if(GV){DMA_V((t)+1,sl_next);} \
    CMASK(C0,C1,t); \
    { float a=MX3(C0[0],C0[1],C1[0]),b=MX3(C0[2],C0[3],C1[1]); a=MX3(a,C1[2],C1[3]); \
      _Pragma("unroll") for(int r=4;r<16;r+=4){a=MX3(a,C0[r],C0[r+1]);b=MX3(b,C0[r+2],C0[r+3]);a=MX3(a,C1[r],C1[r+1]);b=MX3(b,C1[r+2],C1[r+3]);} \
      float rm=__builtin_fmaxf(a,b); { auto rr=__builtin_amdgcn_permlane32_swap(__float_as_uint(rm),__float_as_uint(rm),false,false); rm=__builtin_fmaxf(__uint_as_float(rr[0]),__uint_as_float(rr[1])); } \
      resc=false; \
      if(__builtin_expect(__any(rm>(float)THRL),0)){ const float dl=__builtin_fmaxf(rm,0.f); mhat+=dl; \
        _Pragma("unroll") for(int r=0;r<16;++r){C0[r]-=dl;C1[r]-=dl;} \
        _Pragma("unroll") for(int r=0;r<16;++r)negm[r]=-mhat; asm volatile("":"+v"(negm)); \
        const float f=__builtin_amdgcn_exp2f(-dl); l_reg*=f; if(hi==0)wsf[r32]=f; resc=true; } } \
    SBAR(); \
    GAPB(o[0]=__builtin_amdgcn_mfma_f32_32x32x16_bf16(PAF(0),VFR(0),o[0],0,0,0), C0,0); \
    GAPB(o[1]=__builtin_amdgcn_mfma_f32_32x32x16_bf16(PAF(0),VFR(4),o[1],0,0,0), C0,4); \
    KRD(GL,0); GAPB(o[0]=__builtin_amdgcn_mfma_f32_32x32x16_bf16(PAF(1),VFR(1),o[0],0,0,0), C0,8); \
    KRD(GL,1); GAPB(o[1]=__builtin_amdgcn_mfma_f32_32x32x16_bf16(PAF(1),VFR(5),o[1],0,0,0), C0,12); \
    KRD(GL,2); GAPB(o[0]=__builtin_amdgcn_mfma_f32_32x32x16_bf16(PAF(2),VFR(2),o[0],0,0,0), C1,0); \
    KRD(GL,3); GAPB(o[1]=__builtin_amdgcn_mfma_f32_32x32x16_bf16(PAF(2),VFR(6),o[1],0,0,0), C1,4); \
    GAPB(o[0]=__builtin_amdgcn_mfma_f32_32x32x16_bf16(PAF(3),VFR(3),o[0],0,0,0), C1,8); \
    GAPB(o[1]=__builtin_amdgcn_mfma_f32_32x32x16_bf16(PAF(3),VFR(7),o[1],0,0,0), C1,12); \
    }while(0)
  int t=1;
  #undef CMASK
  #define CMASK(P0,P1,t) do{}while(0)
  for(;t+5<NT;t+=2){
    STEP(pB0,pB1,pA0,pA1,t,true,true,true);     WAIT_BAR(2); RESC(); ROT();
    STEP(pA0,pA1,pB0,pB1,t+1,true,true,true);   WAIT_BAR(2); RESC(); ROT();
  }
  #undef CMASK
  #define CMASK(P0,P1,t) do{ if((t)>=NT-2) kmask(P0,P1,(t)==NT-1); }while(0)
  #define ENDW(tt) do{ if((tt)+3<NT){WAIT_BAR(2);} else if((tt)+2<NT){WAIT_BAR(1);} else {WAIT_BAR(0);} }while(0)
  for(;t+1<NT;t+=2){
    STEP(pB0,pB1,pA0,pA1,t,(t+3<NT),(t+1<NT),(t+1<NT));       ENDW(t);   RESC(); ROT();
    STEP(pA0,pA1,pB0,pB1,t+1,(t+4<NT),(t+2<NT),(t+2<NT));     ENDW(t+1); RESC(); ROT();
  }
  STEP(pB0,pB1,pA0,pA1,NT-1,false,false,false); RESC();
  { float sacc=pB0[0]+pB0[1]; _Pragma("unroll") for(int r=2;r<16;++r)sacc+=pB0[r]; _Pragma("unroll") for(int r=0;r<16;++r)sacc+=pB1[r]; l_reg+=sacc;
    pw0=(u32x4){PKW(pB0,0),PKW(pB0,2),PKW(pB0,4),PKW(pB0,6)};pw1=(u32x4){PKW(pB0,8),PKW(pB0,10),PKW(pB0,12),PKW(pB0,14)};pw2=(u32x4){PKW(pB1,0),PKW(pB1,2),PKW(pB1,4),PKW(pB1,6)};pw3=(u32x4){PKW(pB1,8),PKW(pB1,10),PKW(pB1,12),PKW(pB1,14)};
    SBAR(); pv(o,vb0+sl_cur,PAF(0),PAF(1),PAF(2),PAF(3)); }
  #undef PKW
  #undef PAF
  #undef VFR
  #undef PIN
  #undef MX3
  #undef GAPA
  #undef GAPB
  #undef EX
  #undef VRD
  #undef KRD
  #undef STEP
  #undef ENDW
  {auto rr=__builtin_amdgcn_permlane32_swap(__float_as_uint(l_reg),__float_as_uint(l_reg),false,false);l_reg=__uint_as_float(rr[0])+__uint_as_float(rr[1]);}
  if(hi==0)wsf[32+r32]=l_reg;asm volatile("s_waitcnt lgkmcnt(0)":::"memory");
  float rli[16];
  #pragma unroll
  for(int r=0;r<16;++r)rli[r]=__builtin_amdgcn_rcpf(wsf[32+crow(r,hi)]);
  bf16*Ow=Oblk+(long)(wid*QBLK)*QP;
  { bf16*stg=(bf16*)(shm+LDS_OST)+wid*2048;
    #pragma unroll
    for(int r=0;r<16;++r){const int orow=crow(r,hi);
      #pragma unroll
      for(int d0=0;d0<2;++d0)stg[orow*64+d0*32+r32]=__float2bfloat16(o[d0][r]*rli[r]);}
    asm volatile("s_waitcnt lgkmcnt(0)":::"memory");
    #pragma unroll
    for(int i=0;i<4;++i){const int row=i*8+(lane>>3),ch=lane&7; const u32x4 v=*(const u32x4*)(stg+row*64+ch*8); ATTN_STORE16(Ow+(long)row*QP+ch*8,v);} }
  asm volatile("s_waitcnt lgkmcnt(0)\n\ts_barrier":::"memory");
  #undef DMA_K
  #undef DMA_V
  #undef CMASK
  #undef START
  #undef RESC
  #undef ROT
}
#undef SBAR
#undef WAIT_BAR
}
#define GAS __attribute__((address_space(1)))
#define LAS __attribute__((address_space(3)))
typedef unsigned short bf16;
typedef unsigned v4u __attribute__((ext_vector_type(4)));
typedef float f32x4 __attribute__((ext_vector_type(4)));
constexpr size_t MiB = 1u << 20;
constexpr size_t WS_CTL = 0, CTL_BYTES = 4096;
constexpr size_t WS_ROPE = 1 * MiB, WS_SS1 = 2 * MiB, WS_SS2 = 3 * MiB;
constexpr size_t WS_WIN = 4 * MiB, WS_WG = 10 * MiB, WS_WA = 11 * MiB, WS_WF = 12 * MiB, WS_WO = 13 * MiB, WS_WFFN = 15 * MiB, WS_WDN = 26 * MiB;
constexpr size_t WS_GA = 32 * MiB, WS_X1B = 32 * MiB, WS_Q = 416 * MiB, WS_KB = 512 * MiB, WS_VB = 537 * MiB, WS_GTP = 562 * MiB, WS_GTS = 596 * MiB;
constexpr size_t WS_CS = 661 * MiB, WS_SS = 697 * MiB, WS_CP = 733 * MiB, WS_SP = 736 * MiB, WS_GFS = 739 * MiB, WS_GFP = 772 * MiB, WS_H = 813 * MiB, WS_F = 813 * MiB, WS_DS = 909 * MiB, WS_DP = 977 * MiB, WS_END = 1017 * MiB;
constexpr size_t WS_U = 224 * MiB, WS_MG = 512 * MiB;
static_assert(WS_GA + (size_t)NTOK * 2048 * 2 <= WS_Q && WS_Q + (size_t)NTOK * 512 * 2 <= WS_KB && WS_KB + (KV_S_OFF + (size_t)16 * KPS * 64) * 2 <= WS_VB && WS_VB + (KV_S_OFF + (size_t)16 * KPS * 64) * 2 <= WS_GTP, "ws map 1");
static_assert(WS_GTP + (size_t)16 * 512 * KPP * 2 <= WS_GTS && WS_GTS + (size_t)8 * 512 * KPS * 2 <= WS_CS && WS_CS + (size_t)MTS * 256 * K2S * 2 <= WS_SS && WS_SS + (size_t)MTS * 256 * K2S * 2 <= WS_CP, "ws map 2");
static_assert(WS_CP + (size_t)MTP * 256 * K2P * 2 <= WS_SP && WS_SP + (size_t)MTP * 256 * K2P * 2 <= WS_GFS && WS_GFS + (size_t)8 * 512 * K2S * 2 <= WS_GFP && WS_GFP + (size_t)16 * 512 * K2P * 2 <= WS_H && WS_H + (size_t)(NTOK + 256) * 1024 * 2 <= WS_END && WS_F + (size_t)NTOK * 512 * 2 <= WS_DS && WS_DS + (size_t)272 * 262144 <= WS_DP && WS_DP + (size_t)160 * 262144 <= WS_END, "ws map 3");
static_assert(WS_U + (size_t)NTOK * 2816 * 2 <= WS_END && WS_X1B + (size_t)NTOK * 1024 * 2 <= WS_U && WS_MG + (size_t)NTOK * 1024 * 2 <= WS_F && WS_WDN + (size_t)1024 * 2816 * 2 <= WS_GA && WS_WFFN + (size_t)5632 * 1024 * 2 <= WS_WDN && WS_WIN + (size_t)2816 * 1024 * 2 <= WS_WG, "ws map 4");
constexpr int LDS_BYTES = 147456, MISC_OFF = 131072 + 320;
constexpr int NATT = 3072;

__device__ __forceinline__ unsigned f2bf(float f) { unsigned u = __builtin_bit_cast(unsigned, f); return (u + 0x7fffu + ((u >> 16) & 1u)) >> 16; }
__device__ __forceinline__ unsigned pk2(float lo, float hi) { return f2bf(lo) | (f2bf(hi) << 16); }
__device__ __forceinline__ float wave_sum(float v) {
#pragma unroll
    for (int o = 1; o < 64; o <<= 1) v += __shfl_xor(v, o);
    return v; }

__device__ __forceinline__ int src_col(int mat, int n) {
    if (mat == 0) {
        if (n >= 768) return 1280 + (n - 768);
        const int ct = n & 255, bj = ct >> 7, wc = (ct >> 5) & 3, fq = (ct >> 3) & 3, nn = (ct >> 2) & 1, j = ct & 3;
        if (n < 512) return ((n >> 8) * 4 + wc) * 64 + 32 * bj + 16 * nn + 4 * fq + j;
        if (wc < 2) return 512 + wc * 64 + 32 * bj + 16 * nn + 4 * fq + j;
        return 640 + (wc - 2) * 64 + 32 * bj + 8 * fq + 4 * nn + j;
    }
    if (mat == 4) { const int pn = n >> 8, ct = n & 255, nn = (ct >> 2) & 1, j = ct & 3, q8 = ct >> 3; return (nn ? 2816 : 0) + 128 * pn + 4 * q8 + j; }
    return n;
}
__device__ __forceinline__ void tr_item(const float* W, int ldw, int K, int ND, bf16* WT, int mat, const float* ksc, LAS float* scr, int item, int lane) {
    const int nblk = ND / 32, kb = item / nblk, nb = item % nblk, k0 = 64 * kb, n0 = 32 * nb;
    const int sc = src_col(mat, n0 + (lane & 31));
#pragma unroll 8
    for (int i = 0; i < 32; ++i) { const int kk = 2 * i + (lane >> 5); float v = W[(size_t)(k0 + kk) * ldw + sc]; if (ksc) v *= ksc[k0 + kk]; scr[kk * 33 + (lane & 31)] = v; }
    asm volatile("s_waitcnt lgkmcnt(0)" ::: "memory");
    const int c = lane & 7;
#pragma unroll
    for (int j = 0; j < 4; ++j) { const int n = (lane >> 3) + 8 * j; const LAS float* s = scr + (8 * c) * 33 + n;
        v4u o; o.x = pk2(s[0 * 33], s[1 * 33]); o.y = pk2(s[2 * 33], s[3 * 33]); o.z = pk2(s[4 * 33], s[5 * 33]); o.w = pk2(s[6 * 33], s[7 * 33]);
        *(v4u*)(WT + (size_t)(n0 + n) * K + k0 + 8 * c) = o; }
    asm volatile("s_waitcnt lgkmcnt(0)" ::: "memory");
}
__device__ __forceinline__ void rms_row_bf16(const float* xrow, const float* g, bf16* orow, int lane) {
    const f32x4* xr = (const f32x4*)xrow + lane; const f32x4* gr = (const f32x4*)g + lane;
    f32x4 v[4]; float s = 0.f;
#pragma unroll
    for (int j = 0; j < 4; ++j) { v[j] = xr[64 * j]; s += (v[j].x * v[j].x + v[j].y * v[j].y) + (v[j].z * v[j].z + v[j].w * v[j].w); }
    const float rstd = rsqrtf(wave_sum(s) * (1.f / 1024.f) + EPS);
    unsigned long long* o8 = (unsigned long long*)orow + lane;
#pragma unroll
    for (int j = 0; j < 4; ++j) { const f32x4 gg = gr[64 * j]; o8[64 * j] = (unsigned long long)pk2(v[j].x * rstd * gg.x, v[j].y * rstd * gg.y) | ((unsigned long long)pk2(v[j].z * rstd * gg.z, v[j].w * rstd * gg.w) << 32); }
}
__device__ __forceinline__ void dft_fill(bf16* C, bf16* S, int rows, int KP_, int L, long gtid, long nthr) {
    const int per_row = KP_ / 8; const long items = (long)rows * per_row; const float inv = 2.0f / (float)L;
    for (long it = gtid; it < items; it += nthr) { const int r = (int)(it / per_row), l0 = (int)(it % per_row) * 8;
        const bool rv = (r >= 1 && r <= L / 2);
        unsigned cw[4], sw[4]; int m = rv ? (int)(((long)r * l0) % L) : 0;
#pragma unroll
        for (int e = 0; e < 4; ++e) { float c0 = 0.f, s0 = 0.f, c1 = 0.f, s1 = 0.f;
            if (rv && l0 + 2 * e <= L / 2) sincospif((float)m * inv, &s0, &c0);
            m += r; if (m >= L) m -= L;
            if (rv && l0 + 2 * e + 1 <= L / 2) sincospif((float)m * inv, &s1, &c1);
            m += r; if (m >= L) m -= L;
            cw[e] = pk2(c0, c1); sw[e] = pk2(s0, s1); }
        *(v4u*)(C + (size_t)r * KP_ + l0) = (v4u){cw[0], cw[1], cw[2], cw[3]}; *(v4u*)(S + (size_t)r * KP_ + l0) = (v4u){sw[0], sw[1], sw[2], sw[3]}; }
}
__device__ __forceinline__ void gt_fold(const bf16* GT, bf16* GF, int nseq, int KPin, int K2, int L, long gtid, long nthr) {
    const int per_row = K2 / 8; const long items = (long)nseq * 512 * per_row; const int L2 = L / 2;
    for (long it = gtid; it < items; it += nthr) { const int row = (int)(it / per_row), l0 = (int)(it % per_row) * 8; const bf16* g = GT + (size_t)row * KPin;
        const bool odd = ((row & 127) > 64); float o[8];
#pragma unroll
        for (int j = 0; j < 8; ++j) { const int l = l0 + j; float v = 0.f;
            if (l <= L2) { const float a = __uint_as_float((unsigned)g[l < 16 ? l : l + 48] << 16);
                if (l == 0 || l == L2) v = odd ? 0.f : a;
                else { const float b = __uint_as_float((unsigned)g[L - l + 48] << 16); v = odd ? a - b : a + b; } }
            o[j] = v; }
        *(v4u*)(GF + (size_t)row * K2 + l0) = (v4u){pk2(o[0], o[1]), pk2(o[2], o[3]), pk2(o[4], o[5]), pk2(o[6], o[7])}; }
}

__device__ __forceinline__ void my_bar(unsigned* cnt, unsigned target) {
    __syncthreads();
    if (threadIdx.x == 0) {
        __builtin_amdgcn_fence(__ATOMIC_RELEASE, "agent");
        __hip_atomic_fetch_add(cnt, 1u, __ATOMIC_RELAXED, __HIP_MEMORY_SCOPE_AGENT);
        while (__hip_atomic_load(cnt, __ATOMIC_RELAXED, __HIP_MEMORY_SCOPE_AGENT) < target) __builtin_amdgcn_s_sleep(2);
        __builtin_amdgcn_fence(__ATOMIC_ACQUIRE, "agent");
    }
    __syncthreads();
}
struct Args { const float* in[14]; float* out; unsigned char* ws; };

#if CHECKS
#define BF(v) (__uint_as_float(((unsigned)(v)) << 16))
__device__ __forceinline__ void chk(unsigned* ctl, int stage, float got, float ref, float rt) {
    const bool bad = !(fabsf(got - ref) <= rt * (1.0f + fabsf(ref)));
    const unsigned long long m = __ballot(bad);
    if ((threadIdx.x & 63) == 0 && m) atomicAdd(ctl + 200 + stage, (unsigned)__popcll(m));
}
__device__ __forceinline__ void tok_geom(int t, int& seq, int& p) { if (t < P_TOK) { seq = t >> 11; p = t & 2047; } else { seq = 16 + ((t - P_TOK) >> 13); p = (t - P_TOK) & 8191; } }
#define RUN_CHECKS(stage) do { run_checks((stage), bx * 8 + wave, lane); GRID_SYNC(); } while (0)
__device__ __forceinline__ void run_checks(int stage, int gw, int lane) {
    typedef __attribute__((address_space(4))) const Args CArgs;
    CArgs* ap_ = (CArgs*)__builtin_amdgcn_kernarg_segment_ptr(); unsigned char* ws = ap_->ws; unsigned* ctl = (unsigned*)(ws + WS_CTL);
    const int t = (int)(((long)gw * 48 + (gw >> 3)) % NTOK); int seq, p; tok_geom(t, seq, p);
    if (stage == 1) {
        const bf16* hrow = (const bf16*)(ws + WS_H) + (size_t)t * 1024; const float* w_in = ap_->in[4]; const int c = lane * 32 + (gw & 31);
        float z = 0.f; for (int k = 0; k < 1024; ++k) z += BF(hrow[k]) * w_in[(size_t)k * 3328 + 1280 + c];
        chk(ctl, 1, BF(((const bf16*)(ws + WS_GA))[(size_t)t * 2048 + c]), 1.f / (1.f + expf(-z)), 0.02f);
        { const float* xr = t < P_TOK ? ap_->in[0] + (size_t)t * 1024 : ap_->in[1] + (size_t)(t - P_TOK) * 1024; float s = 0.f; for (int k = lane; k < 1024; k += 64) s += xr[k] * xr[k];
          s = wave_sum(s); const float rs = rsqrtf(s * (1.f / 1024.f) + EPS); const int k = lane * 16 + (gw & 15); chk(ctl, 0, BF(hrow[k]), xr[k] * rs * ap_->in[3][k], 0.01f); }
    } else if (stage == 2) {
        const int L = seq < 16 ? LP : LS, lp = 16 + p, KP_ = seq < 16 ? KPP : KPS; const float scale = rsqrtf((float)L * 128.0f);
        const int c = lane * 8 + (gw & 7), g = c >> 7, cp = c & 127;
        const int rc = cp <= 64 ? cp : 128 - cp, rs_ = (cp == 0 || cp == 64) ? -1 : (cp < 64 ? 64 + cp : 192 - cp); const float sg = cp < 64 ? 1.f : -1.f;
        const bf16* gb = seq < 16 ? (const bf16*)(ws + WS_GTP) + ((size_t)seq * 512 + g * 128) * KPP : (const bf16*)(ws + WS_GTS) + ((size_t)(seq - 16) * 512 + g * 128) * KPS;
        float a = 0.f; int m = 0;
        for (int l = 0; l < L; ++l) { const int ph = l < 16 ? l : l + 48; float sn, cs; sincospif(2.0f * (float)m / (float)L, &sn, &cs);
            a += cs * BF(gb[(size_t)rc * KP_ + ph]); if (rs_ >= 0) a -= sg * sn * BF(gb[(size_t)rs_ * KP_ + ph]);
            m += lp; if (m >= L) m -= L; }
        chk(ctl, 2, BF(((const bf16*)(ws + WS_F))[(size_t)t * 512 + c]), a * scale, 0.04f);
    } else if (stage == 3) {
        const int c = lane * 16 + (gw & 15); float a = 0.f, f = 0.f;
        for (int k = 0; k < 512; ++k) { a += BF(((const bf16*)(ws + WS_Q))[(size_t)t * 512 + k]) * ap_->in[7][(size_t)k * 1024 + c]; f += BF(((const bf16*)(ws + WS_F))[(size_t)t * 512 + k]) * ap_->in[8][(size_t)k * 1024 + c]; }
        const bf16* ga = (const bf16*)(ws + WS_GA) + (size_t)t * 2048;
        chk(ctl, 3, BF(((const bf16*)(ws + WS_MG))[(size_t)t * 1024 + c]), BF(ga[c]) * a + BF(ga[1024 + c]) * f, 0.03f);
    } else if (stage == 4) {
        const float* xr = t < P_TOK ? ap_->in[0] + (size_t)t * 1024 : ap_->in[1] + (size_t)(t - P_TOK) * 1024; const float* o = ap_->out + (size_t)t * 1024;
        const int c = lane * 16 + (gw & 15); float a = 0.f; for (int k = 0; k < 1024; ++k) a += BF(((const bf16*)(ws + WS_MG))[(size_t)t * 1024 + k]) * ap_->in[9][(size_t)k * 1024 + c];
        chk(ctl, 4, o[c], xr[c] + a, 0.02f);
        chk(ctl, 4, BF(((const bf16*)(ws + WS_X1B))[(size_t)t * 1024 + c]), o[c], 0.01f);
        { float s = 0.f; for (int cc = lane; cc < 1024; cc += 64) s += o[cc] * o[cc]; s = wave_sum(s); chk(ctl, 4, ((const float*)(ws + WS_SS1))[t], s, 0.002f); }
    } else if (stage == 5) {
        const bf16* xb = (const bf16*)(ws + WS_X1B) + (size_t)t * 1024; const float rs = rsqrtf(((const float*)(ws + WS_SS1))[t] * (1.f / 1024.f) + EPS);
        const int j = lane * 44 + (gw % 44); float g = 0.f, u = 0.f;
        for (int k = 0; k < 1024; ++k) { const float xv = BF(xb[k]) * ap_->in[10][k]; g += xv * ap_->in[11][(size_t)k * 5632 + j]; u += xv * ap_->in[11][(size_t)k * 5632 + 2816 + j]; }
        g *= rs; u *= rs;
        chk(ctl, 5, BF(((const bf16*)(ws + WS_U))[(size_t)t * 2816 + j]), g / (1.f + expf(-g)) * u, 0.03f);
    } else if (stage == 6) {
        const int c = lane * 16 + (gw & 15); float a = 0.f; for (int k = 0; k < 2816; ++k) a += BF(((const bf16*)(ws + WS_U))[(size_t)t * 2816 + k]) * ap_->in[12][(size_t)k * 1024 + c];
        const float* o = ap_->out + (size_t)t * 1024;
        chk(ctl, 6, o[c], BF(((const bf16*)(ws + WS_X1B))[(size_t)t * 1024 + c]) + a, 0.03f);
        { float s = 0.f; for (int cc = lane; cc < 1024; cc += 64) s += o[cc] * o[cc]; s = wave_sum(s); chk(ctl, 6, ((const float*)(ws + WS_SS2))[t], s, 0.002f); }
    }
}
#else
#define RUN_CHECKS(stage) do {} while (0)
#endif

__global__ void __launch_bounds__(512, 2) enc_fwd(Args args) {
    extern __shared__ __attribute__((aligned(16))) unsigned char lds[];
    cg::grid_group grid = cg::this_grid();
    LAS unsigned char* L3 = (LAS unsigned char*)lds;
    volatile LAS unsigned* MISC = (volatile LAS unsigned*)(L3 + MISC_OFF);
    const int tid = threadIdx.x, lane = tid & 63, wave = __builtin_amdgcn_readfirstlane(tid >> 6);
    const int G = gridDim.x, bx = blockIdx.x; int nsync_ = 0;
#if TSTAMP
    unsigned long long ts_[9]; for (int i_ = 0; i_ < 9; ++i_) ts_[i_] = 0; ts_[0] = __builtin_amdgcn_s_memrealtime();
#endif
    typedef __attribute__((address_space(4))) const Args CArgs;
#define LOAD_ARGS() CArgs* ap_ = (CArgs*)__builtin_amdgcn_kernarg_segment_ptr(); asm volatile("" : "+s"(ap_)); unsigned char* ws = ap_->ws; (void)ws
#define WSP(T, off) ((T*)(ws + (off)))
#define AIN(i) (ap_->in[i])
#define AOUT() (ap_->out)
#if TSTAMP
#define TS_MARK() do { if (nsync_ < 9) ts_[nsync_] = __builtin_amdgcn_s_memrealtime(); } while (0)
#else
#define TS_MARK() do {} while (0)
#endif
#define GRID_SYNC() do { asm volatile("s_waitcnt vmcnt(0) lgkmcnt(0)" ::: "memory"); grid.sync(); ++nsync_; __builtin_amdgcn_fence(__ATOMIC_ACQUIRE, "agent"); asm volatile("s_waitcnt vmcnt(0)" ::: "memory"); TS_MARK(); } while (0)
#define WSPC(T, off) ((T*)(((CArgs*)__builtin_amdgcn_kernarg_segment_ptr())->ws + (off)))

#if (PHM>>0)&1
    { LOAD_ARGS();
        const int gw = bx * 8 + wave, NGW = G * 8; const long gtid = (long)bx * 512 + tid, nthr = (long)G * 512;
        LAS float* tab = (LAS float*)L3;
        if (tid < 128) { tab[tid] = cospif((float)tid * (1.0f / 64.0f)); }
        __syncthreads();
        LAS float* scr = (LAS float*)(L3 + 1024 + wave * 8704);
        constexpr int I0 = 16 * 88, I1 = 8 * 32, I2 = 8 * 32, I3 = 16 * 32, I4 = 16 * 176, I5 = 44 * 32;
        for (int it = gw; it < I0 + I1 + I2 + I3 + I4 + I5; it += NGW) { int r = it;
            if (r < I0) { tr_item(AIN(4), 3328, 1024, 2816, WSP(bf16, WS_WIN), 0, nullptr, scr, r, lane); continue; } r -= I0;
            if (r < I1) { tr_item(AIN(7), 1024, 512, 1024, WSP(bf16, WS_WA), 1, nullptr, scr, r, lane); continue; } r -= I1;
            if (r < I2) { tr_item(AIN(8), 1024, 512, 1024, WSP(bf16, WS_WF), 2, nullptr, scr, r, lane); continue; } r -= I2;
            if (r < I3) { tr_item(AIN(9), 1024, 1024, 1024, WSP(bf16, WS_WO), 3, nullptr, scr, r, lane); continue; } r -= I3;
            if (r < I4) { tr_item(AIN(11), 5632, 1024, 5632, WSP(bf16, WS_WFFN), 4, AIN(10), scr, r, lane); continue; } r -= I4;
            tr_item(AIN(12), 1024, 2816, 1024, WSP(bf16, WS_WDN), 5, nullptr, scr, r, lane); }
        for (long id = gtid; id < 512 * 128; id += nthr) { const int wv = (int)id >> 6, ln = (int)id & 63, chunk = (wv & 15) * 8 + (ln & 7), row = (wv >> 4) * 8 + (ln >> 3), s = row & 127, g = row >> 7, k = chunk * 8;
            const float* wr_ = AIN(4) + (size_t)k * 3328 + 768 + g * 128; float a[8];
#pragma unroll
            for (int j = 0; j < 8; ++j) a[j] = 0.f;
            const int sm = s <= 64 ? s : s - 64, sh = s <= 64 ? 0 : 96;
            for (int c = 0; c < 128; ++c) { const float tv = tab[(c * sm + sh) & 127];
#pragma unroll
                for (int j = 0; j < 8; ++j) a[j] += wr_[(size_t)j * 3328 + c] * tv; }
            *(v4u*)(WSP(bf16, WS_WG) + (size_t)row * 1024 + k) = (v4u){pk2(a[0], a[1]), pk2(a[2], a[3]), pk2(a[4], a[5]), pk2(a[6], a[7])}; }
        for (int m = gw; m < NTOK + 256; m += NGW) {
            bf16* orow = WSP(bf16, WS_H) + (size_t)m * 1024;
            if (m < P_TOK) rms_row_bf16(AIN(0) + (size_t)m * 1024, AIN(3), orow, lane);
            else if (m < NTOK) rms_row_bf16(AIN(1) + (size_t)(m - P_TOK) * 1024, AIN(3), orow, lane);
            else if (m < NTOK + 16) rms_row_bf16(AIN(2) + (size_t)(m - NTOK) * 1024, AIN(3), orow, lane);
            else { unsigned long long* o8 = (unsigned long long*)orow + lane;
#pragma unroll
                for (int j = 0; j < 4; ++j) o8[64 * j] = 0ull; } }
        dft_fill(WSP(bf16, WS_CS), WSP(bf16, WS_SS), MTS * 256, K2S, LS, gtid, nthr);
        dft_fill(WSP(bf16, WS_CP), WSP(bf16, WS_SP), MTP * 256, K2P, LP, gtid, nthr);
        for (long id = gtid; id < 130 * 16; id += nthr) { const int pp = (int)id >> 4, i = (int)id & 15;
            const double ang = (double)(pp - 1) * pow(10000.0, -(double)i / 16.0);
            WSP(float, WS_ROPE)[pp * 32 + i] = (float)cos(ang); WSP(float, WS_ROPE)[pp * 32 + 16 + i] = (float)sin(ang); }
        for (long id = gtid; id < NTOK; id += nthr) { WSP(float, WS_SS1)[id] = 0.f; WSP(float, WS_SS2)[id] = 0.f; }
        for (long id = gtid; id < 48L * 112 * 8; id += nthr) { const int g = (int)(id / 896), rem = (int)(id % 896), r = rem >> 3, ch = rem & 7;
            const int seq = g >> 1, kvh = g & 1; const size_t off = pg8::kvoff(seq, kvh) + (size_t)(pg8::seqlen(seq) + 16 + r) * 64 + ch * 8;
            *(v4u*)(WSP(bf16, WS_KB) + off) = (v4u){0u, 0u, 0u, 0u}; *(v4u*)(WSP(bf16, WS_VB) + off) = (v4u){0u, 0u, 0u, 0u}; }
        for (long id = gtid; id < 24L * 512 * 8; id += nthr) { const int row = (int)(id >> 3), ch = (int)(id & 7), seq = row >> 9, c = row & 511;
            bf16* d = seq < 16 ? WSP(bf16, WS_GTP) + ((size_t)seq * 512 + c) * KPP + 64 + 2048 : WSP(bf16, WS_GTS) + ((size_t)(seq - 16) * 512 + c) * KPS + 64 + 8192;
            *(v4u*)(d + ch * 8) = (v4u){0u, 0u, 0u, 0u}; }
        asm volatile("s_waitcnt vmcnt(0) lgkmcnt(0)" ::: "memory");
    }
#endif
    GRID_SYNC();
    RUN_CHECKS(0);

#if (PHM>>1)&1
    { LOAD_ARGS();
        pg8::Gemm g{WSP(bf16, WS_H), WSP(bf16, WS_WIN), NTOK + 256, 2816, 1024}; pg8::G1Order S; S.init(G, bx);
        pg8::EpiG1 E; E.Q = WSP(bf16, WS_Q); E.KB = WSP(bf16, WS_KB); E.VB = WSP(bf16, WS_VB); E.GA = WSP(bf16, WS_GA); E.rope = WSP(float, WS_ROPE); E.gq = AIN(5); E.gk = AIN(6);
        pg8::gemm_phase<pg8::EpiG1, pg8::G1Order, PG_ALIGN, PG_SP2>(L3, g, S, E);
    }
#endif
#if (PHM>>2)&1
    { LOAD_ARGS();
        pg8::Gemm g{WSP(bf16, WS_WG), WSP(bf16, WS_H), 512, NTOK + 256, 1024}; pg8::StaticOrder S; S.init(512, NTOK + 256, G, G - 1 - bx);
        pg8::EpiGT E; E.GTp = WSP(bf16, WS_GTP); E.GTs = WSP(bf16, WS_GTS);
        pg8::gemm_phase<pg8::EpiGT, pg8::StaticOrder, PG_ALIGN, PG_SP2>(L3, g, S, E);
    }
#endif
    GRID_SYNC();
    RUN_CHECKS(1);

#if (PHM>>3)&1
    { LOAD_ARGS(); const long gtid = (long)bx * 512 + tid, nthr = (long)G * 512;
      gt_fold(WSP(bf16, WS_GTS), WSP(bf16, WS_GFS), 8, KPS, K2S, LS, gtid, nthr);
      gt_fold(WSP(bf16, WS_GTP), WSP(bf16, WS_GFP), 16, KPP, K2P, LP, gtid, nthr); }
    GRID_SYNC();
#endif
#if (PHM>>3)&1
    for (int ps = 0; ps < 2; ++ps) { LOAD_ARGS();
        const int K = ps ? K2P : K2S, nMt = ps ? MTP : MTS, Lq = ps ? LP : LS;
        pg8::DftOrder S; S.G = G; S.c = ps ? (bx + G - 16) % G : bx; S.total = ps ? 160 : 272; S.sample = !ps;
        { pg8::Gemm g{ps ? WSP(bf16, WS_CP) : WSP(bf16, WS_CS), ps ? WSP(bf16, WS_GFP) : WSP(bf16, WS_GFS), nMt * 256, ps ? 16 * 512 : 8 * 512, K};
          pg8::EpiDftP E; E.dump = ps ? WSP(float, WS_DP) : WSP(float, WS_DS); E.nMt = nMt;
          pg8::gemm_phase<pg8::EpiDftP, pg8::DftOrder, PG_ALIGN, PG_SP2>(L3, g, S, E); }
        { pg8::Gemm g{ps ? WSP(bf16, WS_SP) : WSP(bf16, WS_SS), ps ? WSP(bf16, WS_GFP) : WSP(bf16, WS_GFS), nMt * 256, ps ? 16 * 512 : 8 * 512, K};
          pg8::EpiDftQ E; E.dump = ps ? WSP(float, WS_DP) : WSP(float, WS_DS); E.nMt = nMt; E.F = WSP(bf16, WS_F); E.L = Lq; E.tokbase = ps ? 0 : P_TOK; E.nseq = ps ? 2048 : 8192; E.scale = rsqrtf((float)Lq * 128.0f);
          pg8::gemm_phase<pg8::EpiDftQ, pg8::DftOrder, PG_ALIGN, PG_SP2>(L3, g, S, E); }
    }
#endif
#if (PHM>>4)&1
    for (;;) { LOAD_ARGS();
        if (tid == 0) MISC[0] = atomicAdd(WSP(unsigned, WS_CTL) + 64, 1u);
        __syncthreads();
        const int idx = (int)MISC[0];
        __syncthreads();
        if (idx >= NATT) break;
        int tok0, NT, hq; size_t kvo;
        if (idx < 2048) { const int gk = idx >> 7, r = idx & 127, b = gk >> 1, kvh = gk & 1; hq = kvh * 4 + (r >> 5); tok0 = P_TOK + b * 8192 + (r & 31) * 256; NT = 130; kvo = KV_S_OFF + (size_t)gk * KPS * 64; }
        else { const int j = idx - 2048, gk = j >> 5, r = j & 31, b = gk >> 1, kvh = gk & 1; hq = kvh * 4 + (r >> 3); tok0 = b * 2048 + (r & 7) * 256; NT = 34; kvo = (size_t)gk * KPP * 64; }
        attn_body::attn_unit<8>((const attn_body::bf16*)(WSP(bf16, WS_Q) + (size_t)tok0 * 512 + hq * 64), (const attn_body::bf16*)(WSP(bf16, WS_KB) + kvo), (const attn_body::bf16*)(WSP(bf16, WS_VB) + kvo), (attn_body::bf16*)(WSP(bf16, WS_Q) + (size_t)tok0 * 512 + hq * 64), NT, (char*)lds);
    }
#endif
    GRID_SYNC();
    RUN_CHECKS(2);

#if PROBE == 1
    {
        LOAD_ARGS();
        const long gtid = (long)bx * 512 + tid, nthr = (long)G * 512;
        for (long id = gtid; id < (long)NTOK * 128; id += nthr) { const long t = id >> 7; const int c = (int)(id & 127) * 8;
            const bf16* src = c < 512 ? WSP(bf16, WS_F) + t * 512 + c : WSP(bf16, WS_Q) + t * 512 + (c - 512);
            const v4u w = *(const v4u*)src; float* o = AOUT() + t * 1024 + c;
            o[0] = __uint_as_float(w.x << 16); o[1] = __uint_as_float(w.x & 0xffff0000u); o[2] = __uint_as_float(w.y << 16); o[3] = __uint_as_float(w.y & 0xffff0000u);
            o[4] = __uint_as_float(w.z << 16); o[5] = __uint_as_float(w.z & 0xffff0000u); o[6] = __uint_as_float(w.w << 16); o[7] = __uint_as_float(w.w & 0xffff0000u); }
        return;
    }
#endif
#if (PHM>>5)&1
    { LOAD_ARGS();
        pg8::StaticOrder S; S.init(NTOK, 1024, G, bx);
        { pg8::Gemm g{WSP(bf16, WS_Q), WSP(bf16, WS_WA), NTOK, 1024, 512}; pg8::EpiMerge<0> E; E.GA = WSP(bf16, WS_GA); E.MG = WSP(bf16, WS_MG);
          pg8::gemm_phase<pg8::EpiMerge<0>, pg8::StaticOrder, PG_ALIGN, PG_SP2>(L3, g, S, E); }
        { pg8::Gemm g{WSP(bf16, WS_F), WSP(bf16, WS_WF), NTOK, 1024, 512}; pg8::EpiMerge<1> E; E.GA = WSP(bf16, WS_GA); E.MG = WSP(bf16, WS_MG);
          pg8::gemm_phase<pg8::EpiMerge<1>, pg8::StaticOrder, PG_ALIGN, PG_SP2>(L3, g, S, E); }
    }
    GRID_SYNC();
    RUN_CHECKS(3);
#endif
#if PROBE == 4
    {
        LOAD_ARGS();
        const int gw = bx * 8 + wave, NGW = G * 8;
        for (int m = gw; m < NTOK; m += NGW) { const bf16* gr = WSP(bf16, WS_GA) + (size_t)m * 2048;
            const v4u a = *(const v4u*)(gr + lane * 8), b = *(const v4u*)(gr + 1024 + lane * 8);
            asm volatile("s_waitcnt vmcnt(0)" ::: "memory");
            float* o = AOUT() + (size_t)m * 1024 + lane * 8;
            o[0] = __uint_as_float(a.x << 16); o[1] = __uint_as_float(a.x & 0xffff0000u); o[2] = __uint_as_float(a.y << 16); o[3] = __uint_as_float(a.y & 0xffff0000u);
            o[4] = __uint_as_float(a.z << 16); o[5] = __uint_as_float(a.z & 0xffff0000u); o[6] = __uint_as_float(a.w << 16); o[7] = __uint_as_float(a.w & 0xffff0000u);
            o += 512;
            o[0] = __uint_as_float(b.x << 16); o[1] = __uint_as_float(b.x & 0xffff0000u); o[2] = __uint_as_float(b.y << 16); o[3] = __uint_as_float(b.y & 0xffff0000u);
            o[4] = __uint_as_float(b.z << 16); o[5] = __uint_as_float(b.z & 0xffff0000u); o[6] = __uint_as_float(b.w << 16); o[7] = __uint_as_float(b.w & 0xffff0000u); }
        return;
    }
#endif
#if PROBE == 3
    {
        LOAD_ARGS();
        const long gtid = (long)bx * 512 + tid, nthr = (long)G * 512;
        for (long id = gtid; id < (long)NTOK * 128; id += nthr) { const long t = id >> 7; const int c = (int)(id & 127) * 8;
            const v4u w = *(const v4u*)(WSP(bf16, WS_MG) + t * 1024 + c); float* o = AOUT() + t * 1024 + c;
            o[0] = __uint_as_float(w.x << 16); o[1] = __uint_as_float(w.x & 0xffff0000u); o[2] = __uint_as_float(w.y << 16); o[3] = __uint_as_float(w.y & 0xffff0000u);
            o[4] = __uint_as_float(w.z << 16); o[5] = __uint_as_float(w.z & 0xffff0000u); o[6] = __uint_as_float(w.w << 16); o[7] = __uint_as_float(w.w & 0xffff0000u); }
        return;
    }
#endif
#if (PHM>>6)&1
    { LOAD_ARGS();
        pg8::Gemm g{WSP(bf16, WS_MG), WSP(bf16, WS_WO), NTOK, 1024, 1024}; pg8::StaticOrder S; S.init(NTOK, 1024, G, bx);
        pg8::EpiX1 E; E.xp = AIN(0); E.xs = AIN(1); E.out = AOUT(); E.X1B = WSP(bf16, WS_X1B); E.ss1 = WSP(float, WS_SS1);
        pg8::gemm_phase<pg8::EpiX1, pg8::StaticOrder, PG_ALIGN, PG_SP2>(L3, g, S, E);
    }
#endif
    GRID_SYNC();
    RUN_CHECKS(4);
#if PROBE == 2
    return;
#endif
#if (PHM>>7)&1
    { LOAD_ARGS();
        pg8::Gemm g{WSP(bf16, WS_X1B), WSP(bf16, WS_WFFN), NTOK, 5632, 1024}; pg8::StaticOrder S; S.init(NTOK, 5632, G, bx);
        pg8::EpiF1 E; E.ss1 = WSP(float, WS_SS1); E.U = WSP(bf16, WS_U);
        pg8::gemm_phase<pg8::EpiF1, pg8::StaticOrder, PG_ALIGN, PG_SP2>(L3, g, S, E);
    }
#endif
    GRID_SYNC();
    RUN_CHECKS(5);
#if (PHM>>8)&1
    { LOAD_ARGS();
        pg8::Gemm g{WSP(bf16, WS_U), WSP(bf16, WS_WDN), NTOK, 1024, 2816}; pg8::StaticOrder S; S.init(NTOK, 1024, G, bx);
        pg8::EpiF2 E; E.out = AOUT(); E.ss2 = WSP(float, WS_SS2);
        pg8::gemm_phase<pg8::EpiF2, pg8::StaticOrder, PG_ALIGN, PG_SP2>(L3, g, S, E);
    }
#endif
    GRID_SYNC();
    RUN_CHECKS(6);
    { LOAD_ARGS();
        const int gw = bx * 8 + wave, NGW = G * 8; const f32x4* gf = (const f32x4*)AIN(13) + lane;
        for (int m = gw; m < NTOK; m += NGW) { f32x4* o = (f32x4*)(AOUT() + (size_t)m * 1024) + lane; const float rs = rsqrtf(__hip_atomic_load(WSP(float, WS_SS2) + m, __ATOMIC_RELAXED, __HIP_MEMORY_SCOPE_AGENT) * (1.f / 1024.f) + EPS);
#pragma unroll
            for (int j = 0; j < 4; ++j) o[64 * j] = o[64 * j] * rs * gf[64 * j]; }
    }
#if TSTAMP
    { asm volatile("s_waitcnt vmcnt(0)" ::: "memory"); grid.sync(); LOAD_ARGS(); const unsigned long long tend = __builtin_amdgcn_s_memrealtime();
      if (bx == 0 && tid == 0) { const unsigned long long a_ = ts_[TS_A], b_ = (TS_B == 8) ? tend : ts_[TS_B]; AOUT()[0] = 1000.0f * (float)(b_ - a_) * 0.01f; } }
#endif
#if CHECKS
    { asm volatile("s_waitcnt vmcnt(0)" ::: "memory"); grid.sync(); LOAD_ARGS(); if (bx == 0 && tid == 0) { for (int st = 0; st < 7; ++st) { const unsigned v = __hip_atomic_load(WSP(unsigned, WS_CTL) + 200 + st, __ATOMIC_RELAXED, __HIP_MEMORY_SCOPE_AGENT);
        if (v) { AOUT()[0] = (float)st * 1e7f + 1e6f + 8e6f * (float)v / 131072.0f; break; } } } }
#endif
}

extern "C" void kernel_launch(void* const* d_in, const int* in_sizes, int n_in, void* d_out, int out_size, void* d_ws, size_t ws_size, hipStream_t stream) {
    static int grid = 0;
    if (grid == 0) {
        if (n_in != 14 || out_size != NTOK * 1024 || ws_size < WS_END) { fprintf(stderr, "kernel_launch: unexpected shapes: n_in %d out %d ws %zu (need %zu)\n", n_in, out_size, ws_size, (size_t)WS_END); grid = -1; return; }
        int dev = 0, cus = 0, per_cu = 0;
        hipGetDevice(&dev); hipDeviceGetAttribute(&cus, hipDeviceAttributeMultiprocessorCount, dev);
        if (hipFuncSetAttribute((const void*)enc_fwd, hipFuncAttributeMaxDynamicSharedMemorySize, LDS_BYTES) != hipSuccess) { fprintf(stderr, "kernel_launch: hipFuncSetAttribute failed\n"); grid = -1; return; }
        if (hipOccupancyMaxActiveBlocksPerMultiprocessor(&per_cu, (const void*)enc_fwd, 512, LDS_BYTES) != hipSuccess || per_cu < 1) { fprintf(stderr, "kernel_launch: occupancy query says %d\n", per_cu); per_cu = 1; }
        (void)hipGetLastError();
        grid = cus * per_cu;
    }
    if (grid < 0) return;
    hipMemsetAsync((char*)d_ws + WS_CTL, 0, CTL_BYTES, stream);
    Args a{};
    for (int i = 0; i < 14; ++i) a.in[i] = (const float*)d_in[i];
    a.out = (float*)d_out; a.ws = (unsigned char*)d_ws;
    void* kargs[] = {&a};
    hipError_t e = hipLaunchCooperativeKernel((const void*)enc_fwd, dim3(grid), dim3(512), kargs, LDS_BYTES, stream);
    if (e != hipSuccess) fprintf(stderr, "cooperative launch failed: %s (grid %d)\n", hipGetErrorString(e), grid);
}
```

```cpp
#include <hip/hip_runtime.h>
#include <hip/hip_cooperative_groups.h>
#include <cstdio>
#include <cstdint>
namespace cg = cooperative_groups;
#ifndef PHM
#define PHM 0x1ff
#endif
#ifndef PROBE
#define PROBE 0
#endif
#ifndef PG_ALIGN
#define PG_ALIGN true
#endif
#ifndef PG_SP2
#define PG_SP2 true
#endif
#ifndef CHECKS
#define CHECKS 0
#endif
#ifndef TSTAMP
#define TSTAMP 0
#endif
#ifndef TS_A
#define TS_A 0
#endif
#ifndef TS_B
#define TS_B 1
#endif
namespace pg8 {
#define PG8_LAS __attribute__((address_space(3)))
typedef unsigned short bf16_t;
typedef short bf16x8 __attribute__((ext_vector_type(8)));
typedef float f32x4 __attribute__((ext_vector_type(4)));
typedef unsigned u32x4 __attribute__((ext_vector_type(4)));
constexpr int BM = 256, BK = 64, HALF = 128, HTB = HALF * BK * 2  , STAGE_BYTES = 8 * HTB, NXCD = 8, WGM = 8;

__host__ __device__ __forceinline__ int lds_byte(int r, int c) { const int st = (r >> 4) * 2 + (c >> 5), rr = r & 15, cc = c & 31, ob = rr * 64 + cc * 2; return st * 1024 + (ob ^ (((ob >> 9) & 1) << 5)); }
__host__ __device__ __forceinline__ void stage_rc(int b, int& R, int& C) { const int st = b / 1024, sb = b % 1024, swz = sb ^ (((sb >> 9) & 1) << 5); R = (st >> 1) * 16 + swz / 64; C = (st & 1) * 32 + (swz % 64) / 2; }
__host__ __device__ __forceinline__ int perm32(int rho) { const int n = rho >> 4, i = rho & 15; return 8 * (i >> 2) + 4 * n + (i & 3); }

struct Unit { int pm, pn; };
struct Gemm { const bf16_t* A; const bf16_t* Bt; int M, N, K; };

struct StaticOrder {
    int nM, nN, nwg, G, c;
    __host__ __device__ void init(int M, int N, int G_, int c_) { nM = M / BM; nN = N / BM; nwg = nM * nN; G = G_; c = c_; }
    __host__ __device__ bool next(int i, Unit& u) const {
        const long L = (long)i * G + c; if (L >= nwg) return false;
        int wgid = (int)L; { const int q = nwg / NXCD, r = nwg % NXCD, xcd = wgid % NXCD, off = wgid / NXCD; wgid = (xcd < r ? xcd * (q + 1) : r * (q + 1) + (xcd - r) * q) + off; }
        const int nig = WGM * nN, gid = wgid / nig, fm = gid * WGM, gsz = (nM - fm) < WGM ? (nM - fm) : WGM;
        u.pm = fm + ((wgid % nig) % gsz); u.pn = (wgid % nig) / gsz; return true;
    }
    __device__ __forceinline__ void a_ready(const Unit&) const {}
    __device__ __forceinline__ void done(const Unit&) const {}
};

typedef float f32x2c_t __attribute__((ext_vector_type(2))); typedef __bf16 bf16x2c_t __attribute__((ext_vector_type(2)));
__device__ __forceinline__ unsigned cvt_pk_bf16(float lo, float hi) { f32x2c_t v = {lo, hi}; bf16x2c_t b = __builtin_convertvector(v, bf16x2c_t); return __builtin_bit_cast(unsigned, b); }
typedef float f32x2 __attribute__((ext_vector_type(2)));
template <class Epi, class Sched, bool ALIGN_EPI = false, bool SP2 = false>
__device__ __forceinline__ void gemm_phase(PG8_LAS unsigned char* lds, const Gemm g, const Sched& S, const Epi& E) {
    int tid_ = threadIdx.x; asm volatile("" : "+v"(tid_));
    const int tid = tid_, wid = __builtin_amdgcn_readfirstlane(tid >> 6), lane = tid & 63, wr = wid >> 2, wc = wid & 3, fr = lane & 15, fq = lane >> 4;
    const int K = g.K, nt = K / BK;
    unsigned voffA[2], voffB[2];
#pragma unroll
    for (int i = 0; i < 2; ++i) { int R, C; stage_rc(tid * 16 + i * 8192, R, C); const int Rb = Epi::PERM ? ((R & ~31) + perm32(R & 31)) : R;
        voffA[i] = (unsigned)(R * K + C) * 2u; voffB[i] = (unsigned)(Epi::brow(Rb) * K + C) * 2u; }
    const size_t kstep = (size_t)(BK * 2);
    const size_t hstep = (size_t)HALF * K * 2;
    const size_t tstep = 2 * hstep;
    const unsigned ldsw = (unsigned)wid * 1024u;
    const int aoff = lds_byte(wr * 64 + fr, fq * 8), boff = lds_byte(wc * 32 + fr, fq * 8);
#define PG8_SA(b, h) (((b) * 2 + (h)) * HTB)
#define PG8_SB(b, h) ((4 + (b) * 2 + (h)) * HTB)
#define PG8_STAGE(bufoff, gbase, voff) do { _Pragma("unroll") for (int _i = 0; _i < 2; ++_i) \
        __builtin_amdgcn_global_load_lds((const unsigned*)((const char*)(gbase) + (voff)[_i]), (PG8_LAS unsigned*)(lds + (bufoff) + ldsw + _i * 8192), 16, 0, 0); } while (0)
#define PG8_LDA(dst, b, h) do { _Pragma("unroll") for (int m = 0; m < 4; ++m) _Pragma("unroll") for (int k = 0; k < 2; ++k) dst[m][k] = *(const PG8_LAS bf16x8*)(lds + PG8_SA(b, h) + aoff + m * 2048 + k * 1024); } while (0)
#define PG8_LDB(dst, b, h) do { _Pragma("unroll") for (int n = 0; n < 2; ++n) _Pragma("unroll") for (int k = 0; k < 2; ++k) dst[n][k] = *(const PG8_LAS bf16x8*)(lds + PG8_SB(b, h) + boff + n * 2048 + k * 1024); } while (0)
#define PG8_MMA(ai, bj, At, Bt) do { __builtin_amdgcn_s_setprio(1); _Pragma("unroll") for (int m = 0; m < 4; ++m) _Pragma("unroll") for (int n = 0; n < 2; ++n) _Pragma("unroll") for (int k = 0; k < 2; ++k) \
        acc[ai][bj][m][n] = __builtin_amdgcn_mfma_f32_16x16x32_bf16(Bt[n][k], At[m][k], acc[ai][bj][m][n], 0, 0, 0); __builtin_amdgcn_s_setprio(0); } while (0)
#define PG8_WAIT_V(n) asm volatile("s_waitcnt vmcnt(" #n ")" ::: "memory")
#define PG8_WAIT_L(n) asm volatile("s_waitcnt lgkmcnt(" #n ")" ::: "memory")
#define PG8_BAR __builtin_amdgcn_s_barrier()
#define PG8_SCHED __builtin_amdgcn_sched_barrier(0)
    Unit cur, nxt; int ui = 0;
    if (!S.next(0, cur)) return;
    f32x4 acc[2][2][4][2];
#pragma unroll
    for (int a = 0; a < 2; ++a)
#pragma unroll
        for (int b = 0; b < 2; ++b)
#pragma unroll
            for (int m = 0; m < 4; ++m)
#pragma unroll
                for (int n = 0; n < 2; ++n) acc[a][b][m][n] = (f32x4){0.f, 0.f, 0.f, 0.f};
    bf16x8 At[4][2], B0[2][2], B1[2][2];
    const char* cA = (const char*)g.A + (size_t)cur.pm * tstep; const char* cB = (const char*)g.Bt + (size_t)cur.pn * tstep;
    S.a_ready(cur);
    if constexpr (SP2) {
        PG8_STAGE(PG8_SB(0, 0), cB, voffB); PG8_STAGE(PG8_SB(0, 1), cB + hstep, voffB); PG8_STAGE(PG8_SA(0, 0), cA, voffA); PG8_STAGE(PG8_SA(0, 1), cA + hstep, voffA);
        if (wr == 1) PG8_BAR;
        PG8_WAIT_V(2); PG8_BAR;
        PG8_STAGE(PG8_SB(1, 0), cB + kstep, voffB); PG8_STAGE(PG8_SA(1, 0), cA + kstep, voffA); PG8_STAGE(PG8_SB(1, 1), cB + hstep + kstep, voffB);
        PG8_WAIT_V(6); PG8_BAR;
    } else {
        PG8_STAGE(PG8_SB(0, 0), cB, voffB); PG8_STAGE(PG8_SA(0, 0), cA, voffA); PG8_STAGE(PG8_SB(0, 1), cB + hstep, voffB); PG8_STAGE(PG8_SA(0, 1), cA + hstep, voffA);
        if (wr == 1) PG8_BAR;
        PG8_WAIT_V(4); PG8_BAR;
        PG8_STAGE(PG8_SB(1, 0), cB + kstep, voffB); PG8_STAGE(PG8_SA(1, 0), cA + kstep, voffA); PG8_STAGE(PG8_SB(1, 1), cB + hstep + kstep, voffB);
        PG8_WAIT_V(6); PG8_BAR;
    }
    for (;;) {
        const bool has_next = S.next(ui + 1, nxt);
        const char* nA = has_next ? (const char*)g.A + (size_t)nxt.pm * tstep : cA; const char* nB = has_next ? (const char*)g.Bt + (size_t)nxt.pn * tstep : cB;
        for (int t = 0; t < nt; t += 2) {
            const bool last = (t == nt - 2);
            const char* a1 = cA + (size_t)(t + 1) * kstep;
            const char* a2 = last ? nA : cA + (size_t)(t + 2) * kstep; const char* b2 = last ? nB : cB + (size_t)(t + 2) * kstep;
            const char* a3 = a2 + kstep; const char* b3 = b2 + kstep;
            if (last && has_next) S.a_ready(nxt);
            if constexpr (SP2) {
            PG8_LDB(B0, 0, 0); PG8_LDB(B1, 0, 1); PG8_SCHED; PG8_LDA(At, 0, 0); PG8_STAGE(PG8_SA(1, 1), a1 + hstep, voffA);
            PG8_WAIT_V(8); PG8_WAIT_L(0); PG8_BAR; PG8_MMA(0, 0, At, B0); PG8_MMA(0, 1, At, B1); PG8_BAR; PG8_SCHED;
            PG8_LDA(At, 0, 1); PG8_STAGE(PG8_SB(0, 0), b2, voffB); PG8_STAGE(PG8_SB(0, 1), b2 + hstep, voffB); PG8_STAGE(PG8_SA(0, 0), a2, voffA);
            PG8_WAIT_V(8); PG8_WAIT_L(0); PG8_BAR; PG8_MMA(1, 0, At, B0); PG8_MMA(1, 1, At, B1); PG8_BAR; PG8_SCHED;
            PG8_LDB(B0, 1, 0); PG8_LDB(B1, 1, 1); PG8_SCHED; PG8_LDA(At, 1, 0); PG8_STAGE(PG8_SA(0, 1), a2 + hstep, voffA);
            PG8_WAIT_V(8); PG8_WAIT_L(0); PG8_BAR; PG8_MMA(0, 0, At, B0); PG8_MMA(0, 1, At, B1); PG8_BAR; PG8_SCHED;
            PG8_LDA(At, 1, 1); PG8_STAGE(PG8_SB(1, 0), b3, voffB); PG8_STAGE(PG8_SB(1, 1), b3 + hstep, voffB); PG8_STAGE(PG8_SA(1, 0), a3, voffA);
            PG8_WAIT_V(8); PG8_WAIT_L(0); PG8_BAR; PG8_MMA(1, 0, At, B0); PG8_MMA(1, 1, At, B1); PG8_BAR; PG8_SCHED;
            } else {
            PG8_LDB(B0, 0, 0); PG8_SCHED; PG8_LDA(At, 0, 0); PG8_STAGE(PG8_SA(1, 1), a1 + hstep, voffA);
            PG8_WAIT_L(8); PG8_BAR; PG8_WAIT_L(0); PG8_MMA(0, 0, At, B0); PG8_BAR; PG8_SCHED;
            PG8_LDB(B1, 0, 1); PG8_STAGE(PG8_SB(0, 0), b2, voffB);
            PG8_BAR; PG8_WAIT_L(0); PG8_MMA(0, 1, At, B1); PG8_BAR;
            PG8_LDA(At, 0, 1); PG8_STAGE(PG8_SA(0, 0), a2, voffA);
            PG8_BAR; PG8_WAIT_L(0); PG8_MMA(1, 0, At, B0); PG8_BAR; PG8_SCHED;
            PG8_STAGE(PG8_SB(0, 1), b2 + hstep, voffB);
            PG8_WAIT_V(6); PG8_BAR; PG8_MMA(1, 1, At, B1); PG8_BAR;
            PG8_LDB(B0, 1, 0); PG8_SCHED; PG8_LDA(At, 1, 0); PG8_STAGE(PG8_SA(0, 1), a2 + hstep, voffA);
            PG8_WAIT_L(8); PG8_BAR; PG8_WAIT_L(0); PG8_MMA(0, 0, At, B0); PG8_BAR; PG8_SCHED;
            PG8_LDB(B1, 1, 1); PG8_STAGE(PG8_SB(1, 0), b3, voffB);
            PG8_BAR; PG8_WAIT_L(0); PG8_MMA(0, 1, At, B1); PG8_BAR;
            PG8_LDA(At, 1, 1); PG8_STAGE(PG8_SA(1, 0), a3, voffA);
            PG8_BAR; PG8_WAIT_L(0); PG8_MMA(1, 0, At, B0); PG8_BAR; PG8_SCHED;
            PG8_STAGE(PG8_SB(1, 1), b3 + hstep, voffB);
            PG8_WAIT_V(6); PG8_BAR; PG8_MMA(1, 1, At, B1); PG8_BAR;
            }
        }
        if constexpr (ALIGN_EPI) { if (wr == 0) PG8_BAR; }
        if constexpr (!Epi::AFTER_DRAIN) { E(acc, cur, wr, wc, fr, fq); S.done(cur); }
        if (!has_next) break;
#pragma unroll
        for (int a = 0; a < 2; ++a)
#pragma unroll
            for (int b = 0; b < 2; ++b)
#pragma unroll
                for (int m = 0; m < 4; ++m)
#pragma unroll
                    for (int n = 0; n < 2; ++n) acc[a][b][m][n] = (f32x4){0.f, 0.f, 0.f, 0.f};
        cur = nxt; cA = nA; cB = nB; ++ui;
        if constexpr (ALIGN_EPI) { if (wr == 1) PG8_BAR; }
    }
    PG8_WAIT_V(0);
    if constexpr (!ALIGN_EPI) { if (wr == 0) PG8_BAR; }
    PG8_BAR;
    if constexpr (Epi::AFTER_DRAIN) { E.fused(acc, cur, wr, wc, fr, fq, lds, wid, lane); S.done(cur); }
#undef PG8_SA
#undef PG8_SB
#undef PG8_STAGE
#undef PG8_LDA
#undef PG8_LDB
#undef PG8_MMA
#undef PG8_WAIT_V
#undef PG8_WAIT_L
#undef PG8_BAR
#undef PG8_SCHED
}
}
constexpr int NTOK = 98304;
constexpr int NMT = NTOK / 256;
constexpr int P_TOK = 32768;
constexpr int LP = 2064, LS = 8208;
constexpr int KPP = 2176, KPS = 8320;
constexpr int MTP = 5, MTS = 17;
constexpr int K2P = 1152, K2S = 4224;
constexpr size_t KV_S_OFF = (size_t)16 * 2 * KPP * 64;
constexpr float EPS = 1e-6f;
constexpr float QC2 = 0.125f * 1.4426950408889634f;

namespace pg8 {
__device__ __forceinline__ u32x4 pack8(f32x4 a, f32x4 b) { u32x4 w; w.x = cvt_pk_bf16(a[0], a[1]); w.y = cvt_pk_bf16(a[2], a[3]); w.z = cvt_pk_bf16(b[0], b[1]); w.w = cvt_pk_bf16(b[2], b[3]); return w; }
__device__ __forceinline__ void unpack8(u32x4 w, f32x4& a, f32x4& b) {
    a[0] = __uint_as_float(w.x << 16); a[1] = __uint_as_float(w.x & 0xffff0000u); a[2] = __uint_as_float(w.y << 16); a[3] = __uint_as_float(w.y & 0xffff0000u);
    b[0] = __uint_as_float(w.z << 16); b[1] = __uint_as_float(w.z & 0xffff0000u); b[2] = __uint_as_float(w.w << 16); b[3] = __uint_as_float(w.w & 0xffff0000u); }
__device__ __forceinline__ float sigm(float x) { return __builtin_amdgcn_rcpf(1.0f + __expf(-x)); }
__device__ __forceinline__ float dot4(f32x4 a) { return (a[0] * a[0] + a[1] * a[1]) + (a[2] * a[2] + a[3] * a[3]); }
__device__ __forceinline__ size_t kvoff(int seq, int kvh) { return seq < 16 ? (size_t)(seq * 2 + kvh) * KPP * 64 : KV_S_OFF + (size_t)((seq - 16) * 2 + kvh) * KPS * 64; }
__device__ __forceinline__ int seqlen(int seq) { return seq < 16 ? 2048 : 8192; }

struct EpiBase { static constexpr bool PERM = true, AFTER_DRAIN = false; static __host__ __device__ __forceinline__ int brow(int R) { return R; } };

struct G1Order {
    StaticOrder so; int nwg, G, c;
    __device__ void init(int G_, int c_) { so.init(NTOK, 2816, G_, c_); nwg = so.nwg; G = G_; c = c_; }
    __device__ bool next(int i, Unit& u) const { if (so.next(i, u)) return true; if ((long)i * G + c == (long)nwg + 72) { u.pm = NMT; u.pn = 2; return true; } return false; }
    __device__ __forceinline__ void a_ready(const Unit&) const {}
    __device__ __forceinline__ void done(const Unit&) const {}
};
struct DftOrder {
    int G, c, total, sample;
    __device__ bool next(int i, Unit& u) const {
        const long idx = (long)i * G + c; if (idx >= total) return false; const int id = (int)idx;
        if (sample) { if (id < 256) { const int x = id & 7, slot = id >> 3; u.pm = 2 * x + (slot >> 4); u.pn = slot & 15; } else { u.pm = 16; u.pn = id - 256; } }
        else { u.pm = id >> 5; u.pn = id & 31; }
        return true; }
    __device__ __forceinline__ void a_ready(const Unit&) const {}
    __device__ __forceinline__ void done(const Unit&) const {}
};

struct EpiG1 : EpiBase {
    bf16_t *Q, *KB, *VB, *GA; const float *rope, *gq, *gk;
    __device__ __forceinline__ void qk_row(const f32x4& a00, const f32x4& a01, const f32x4& a10, const f32x4& a11, const f32x4 (&gv)[2][2], int prow, int pcol, int fq, float osc, u32x4 (&w)[2]) const {
        float ss = (dot4(a00) + dot4(a01)) + (dot4(a10) + dot4(a11));
        ss += __shfl_xor(ss, 16); ss += __shfl_xor(ss, 32);
        const float rs = rsqrtf(ss * (1.0f / 64.0f) + EPS) ;
        { const int pp = prow + 1; const f32x4 c = *(const f32x4*)(rope + pp * 32 + 4 * fq), s = *(const f32x4*)(rope + pp * 32 + 16 + 4 * fq);
          const f32x4 x1 = a00 * rs * gv[0][0], x2 = a01 * rs * gv[0][1]; w[0] = pack8((x1 * c - x2 * s) * osc, (x2 * c + x1 * s) * osc); }
        { const int pp = pcol + 1; const f32x4 c = *(const f32x4*)(rope + pp * 32 + 4 * fq), s = *(const f32x4*)(rope + pp * 32 + 16 + 4 * fq);
          const f32x4 x1 = a10 * rs * gv[1][0], x2 = a11 * rs * gv[1][1]; w[1] = pack8((x1 * c - x2 * s) * osc, (x2 * c + x1 * s) * osc); }
    }
    __device__ __forceinline__ void operator()(const f32x4 (&acc)[2][2][4][2], const Unit& u, int wr, int wc, int fr, int fq) const {
        asm volatile("" : "+v"(fr), "+v"(fq));
        const int pm = u.pm, pn = u.pn;
        if (pm == NMT) {
            if (pn != 2 || wr != 0) return;
            u32x4 w[2]; bf16_t* base;
            if (wc < 2) { f32x4 gv[2][2];
#pragma unroll
                for (int bj = 0; bj < 2; ++bj)
#pragma unroll
                    for (int n = 0; n < 2; ++n) gv[bj][n] = *(const f32x4*)(gk + 32 * bj + 16 * n + 4 * fq);
                qk_row(acc[0][0][0][0], acc[0][0][0][1], acc[0][1][0][0], acc[0][1][0][1], gv, -1, fr, fq, 1.0f, w); base = KB; }
            else { w[0] = pack8(acc[0][0][0][0], acc[0][0][0][1]); w[1] = pack8(acc[0][1][0][0], acc[0][1][0][1]); base = VB; }
            const int kvh = wc & 1;
#pragma unroll 1
            for (int s = 0; s < 24; ++s) { bf16_t* d = base + kvoff(s, kvh) + (size_t)(seqlen(s) + fr) * 64 + 8 * fq; *(u32x4*)d = w[0]; *(u32x4*)(d + 32) = w[1]; }
            return;
        }
        if (pn >= 3) {
            const int col0 = (pn - 3) * 256 + wc * 32 + 8 * fq;
#pragma unroll
            for (int ai = 0; ai < 2; ++ai)
#pragma unroll
                for (int m = 0; m < 4; ++m) { bf16_t* rp = GA + (size_t)(pm * 256 + ai * 128 + wr * 64 + m * 16 + fr) * 2048 + col0;
#pragma unroll
                    for (int bj = 0; bj < 2; ++bj) { f32x4 v0 = acc[ai][bj][m][0], v1 = acc[ai][bj][m][1];
#pragma unroll
                        for (int j = 0; j < 4; ++j) { v0[j] = sigm(v0[j]); v1[j] = sigm(v1[j]); }
                        *(u32x4*)(rp + bj * 128) = pack8(v0, v1); } }
            return;
        }
        const int t0 = pm * 256; int seq, p0;
        if (t0 < P_TOK) { seq = t0 >> 11; p0 = t0 & 2047; } else { const int ts = t0 - P_TOK; seq = 16 + (ts >> 13); p0 = ts & 8191; }
        const bool isq = pn < 2;
        if (!isq && wc >= 2) {
            bf16_t* vb = VB + kvoff(seq, wc - 2) + (size_t)p0 * 64 + 8 * fq;
#pragma unroll
            for (int ai = 0; ai < 2; ++ai)
#pragma unroll
                for (int m = 0; m < 4; ++m) { const int rloc = ai * 128 + wr * 64 + m * 16 + fr;
#pragma unroll
                    for (int bj = 0; bj < 2; ++bj) *(u32x4*)(vb + (size_t)rloc * 64 + 32 * bj) = pack8(acc[ai][bj][m][0], acc[ai][bj][m][1]); }
            return;
        }
        const float* g = isq ? gq : gk; const float osc = isq ? QC2 : 1.0f;
        bf16_t* ob = isq ? Q + (size_t)t0 * 512 + (4 * pn + wc) * 64 + 8 * fq : KB + kvoff(seq, wc) + (size_t)p0 * 64 + 8 * fq; const int opitch = isq ? 512 : 64;
        f32x4 gv[2][2];
#pragma unroll
        for (int bj = 0; bj < 2; ++bj)
#pragma unroll
            for (int n = 0; n < 2; ++n) gv[bj][n] = *(const f32x4*)(g + 32 * bj + 16 * n + 4 * fq);
#pragma unroll
        for (int ai = 0; ai < 2; ++ai)
#pragma unroll
            for (int m = 0; m < 4; ++m) { const int rloc = ai * 128 + wr * 64 + m * 16 + fr; const int p = p0 + rloc;
                u32x4 w[2]; qk_row(acc[ai][0][m][0], acc[ai][0][m][1], acc[ai][1][m][0], acc[ai][1][m][1], gv, p >> 6, p & 63, fq, osc, w);
                bf16_t* d = ob + (size_t)rloc * opitch; *(u32x4*)d = w[0]; *(u32x4*)(d + 32) = w[1];
                asm volatile("" ::: "memory"); }
    }
};
struct EpiGT : EpiBase {
    bf16_t *GTp, *GTs;
    __device__ __forceinline__ bf16_t* dst(int seq, int ch) const { return seq < 16 ? GTp + ((size_t)seq * 512 + ch) * KPP : GTs + ((size_t)(seq - 16) * 512 + ch) * KPS; }
    __device__ __forceinline__ void operator()(const f32x4 (&acc)[2][2][4][2], const Unit& u, int wr, int wc, int fr, int fq) const {
        asm volatile("" : "+v"(fr), "+v"(fq));
        const bool meta = (u.pn == NMT);
        const int t0 = u.pn * 256; int seq, p0;
        if (t0 < P_TOK) { seq = t0 >> 11; p0 = t0 & 2047; } else { const int ts = t0 - P_TOK; seq = 16 + (ts >> 13); p0 = ts & 8191; }
#pragma unroll
        for (int ai = 0; ai < 2; ++ai)
#pragma unroll
            for (int m = 0; m < 4; ++m) { const int ch = u.pm * 256 + ai * 128 + wr * 64 + m * 16 + fr;
#pragma unroll
                for (int bj = 0; bj < 2; ++bj) { const u32x4 w = pack8(acc[ai][bj][m][0], acc[ai][bj][m][1]);
                    if (!meta) *(u32x4*)(dst(seq, ch) + 64 + p0 + bj * 128 + wc * 32 + 8 * fq) = w;
                    else if (bj == 0 && wc < 2) { for (int s = 0; s < 24; ++s) *(u32x4*)(dst(s, ch) + wc * 32 + 8 * fq) = w; } } }
    }
};
struct EpiDftP : EpiBase {
    static __host__ __device__ __forceinline__ int brow(int R) { return R <= 64 ? R : 128 - R; }
    float* dump; int nMt;
    __device__ __forceinline__ void operator()(const f32x4 (&acc)[2][2][4][2], const Unit& u, int wr, int wc, int fr, int fq) const {
        asm volatile("" : "+v"(fr), "+v"(fq));
        int tx_ = threadIdx.x; asm volatile("" : "+v"(tx_)); f32x4* d = (f32x4*)dump + (size_t)(u.pn * nMt + u.pm) * 32 * 512 + tx_;
#pragma unroll
        for (int ai = 0; ai < 2; ++ai)
#pragma unroll
            for (int bj = 0; bj < 2; ++bj)
#pragma unroll
                for (int m = 0; m < 4; ++m)
#pragma unroll
                    for (int n = 0; n < 2; ++n) d[(size_t)(((ai * 2 + bj) * 4 + m) * 2 + n) * 512] = acc[ai][bj][m][n];
    }
};
struct EpiDftQ : EpiBase {
    static __host__ __device__ __forceinline__ int brow(int R) { return (R == 0 || R == 64) ? 0 : (R < 64 ? 64 + R : 192 - R); }
    const float* dump; int nMt; bf16_t* F; int L, tokbase, nseq; float scale;
    __device__ __forceinline__ void operator()(const f32x4 (&acc)[2][2][4][2], const Unit& u, int wr, int wc, int fr, int fq) const {
        asm volatile("" : "+v"(fr), "+v"(fq));
        int tx_ = threadIdx.x; asm volatile("" : "+v"(tx_)); const f32x4* d = (const f32x4*)dump + (size_t)(u.pn * nMt + u.pm) * 32 * 512 + tx_;
        const int b = u.pn >> 1, pnl = u.pn & 1, tb = tokbase + b * nseq - 16, L2 = L >> 1;
        const float sg = (wc < 2) ? scale : -scale; const bool z0 = (fq == 0) && ((wc & 1) == 0);
#pragma unroll
        for (int ai = 0; ai < 2; ++ai)
#pragma unroll
            for (int m = 0; m < 4; ++m) { const int lp = u.pm * 256 + ai * 128 + wr * 64 + m * 16 + fr;
#pragma unroll
                for (int bj = 0; bj < 2; ++bj) {
                    const f32x4 P0 = d[(size_t)(((ai * 2 + bj) * 4 + m) * 2 + 0) * 512] * scale, P1 = d[(size_t)(((ai * 2 + bj) * 4 + m) * 2 + 1) * 512] * scale;
                    f32x4 q0 = acc[ai][bj][m][0] * sg, q1 = acc[ai][bj][m][1] * sg; if (z0) q0[0] = 0.f;
                    const int col = (pnl * 2 + bj) * 128 + wc * 32 + 8 * fq;
                    if (lp >= 16 && lp <= L2) *(u32x4*)(F + (size_t)(tb + lp) * 512 + col) = pack8(P0 - q0, P1 - q1);
                    if (lp >= 1 && lp < L2) *(u32x4*)(F + (size_t)(tb + L - lp) * 512 + col) = pack8(P0 + q0, P1 + q1); } }
    }
};
template <int SECOND> struct EpiMerge : EpiBase {
    const bf16_t* GA; bf16_t* MG;
    __device__ __forceinline__ void operator()(const f32x4 (&acc)[2][2][4][2], const Unit& u, int wr, int wc, int fr, int fq) const {
        asm volatile("" : "+v"(fr), "+v"(fq));
        const int col0 = u.pn * 256 + wc * 32 + 8 * fq;
#pragma unroll
        for (int ai = 0; ai < 2; ++ai)
#pragma unroll
            for (int m = 0; m < 4; ++m) { const size_t t = (size_t)(u.pm * 256 + ai * 128 + wr * 64 + m * 16 + fr);
#pragma unroll
                for (int bj = 0; bj < 2; ++bj) { const int c = col0 + bj * 128;
                    f32x4 g0, g1; unpack8(*(const u32x4*)(GA + t * 2048 + SECOND * 1024 + c), g0, g1);
                    f32x4 o0 = g0 * acc[ai][bj][m][0], o1 = g1 * acc[ai][bj][m][1];
                    if (SECOND) { f32x4 p0, p1; unpack8(*(const u32x4*)(MG + t * 1024 + c), p0, p1); o0 += p0; o1 += p1; }
                    *(u32x4*)(MG + t * 1024 + c) = pack8(o0, o1); } }
    }
};
struct EpiX1 : EpiBase {
    const float *xp, *xs; float* out; bf16_t* X1B; float* ss1;
    __device__ __forceinline__ void operator()(const f32x4 (&acc)[2][2][4][2], const Unit& u, int wr, int wc, int fr, int fq) const {
        asm volatile("" : "+v"(fr), "+v"(fq));
        const int col0 = u.pn * 256 + wc * 32 + 8 * fq;
#pragma unroll
        for (int ai = 0; ai < 2; ++ai)
#pragma unroll
            for (int m = 0; m < 4; ++m) { const int t = u.pm * 256 + ai * 128 + wr * 64 + m * 16 + fr;
                const float* xr = t < P_TOK ? xp + (size_t)t * 1024 : xs + (size_t)(t - P_TOK) * 1024; float part = 0.f;
#pragma unroll
                for (int bj = 0; bj < 2; ++bj) { const int c = col0 + bj * 128;
                    const f32x4 v0 = *(const f32x4*)(xr + c) + acc[ai][bj][m][0], v1 = *(const f32x4*)(xr + c + 4) + acc[ai][bj][m][1];
                    *(f32x4*)(out + (size_t)t * 1024 + c) = v0; *(f32x4*)(out + (size_t)t * 1024 + c + 4) = v1;
                    *(u32x4*)(X1B + (size_t)t * 1024 + c) = pack8(v0, v1); part += dot4(v0) + dot4(v1); }
                part += __shfl_xor(part, 16); part += __shfl_xor(part, 32);
                if (fq == 0) atomicAdd(ss1 + t, part); }
    }
};
struct EpiF1 : EpiBase {
    const float* ss1; bf16_t* U;
    __device__ __forceinline__ void operator()(const f32x4 (&acc)[2][2][4][2], const Unit& u, int wr, int wc, int fr, int fq) const {
        asm volatile("" : "+v"(fr), "+v"(fq));
        typedef unsigned u32x2 __attribute__((ext_vector_type(2)));
        const int col0 = u.pn * 128 + wc * 16 + 4 * fq;
#pragma unroll
        for (int ai = 0; ai < 2; ++ai)
#pragma unroll
            for (int m = 0; m < 4; ++m) { const int t = u.pm * 256 + ai * 128 + wr * 64 + m * 16 + fr;
                const float rs = rsqrtf(__hip_atomic_load(ss1 + t, __ATOMIC_RELAXED, __HIP_MEMORY_SCOPE_AGENT) * (1.0f / 1024.0f) + EPS);
#pragma unroll
                for (int bj = 0; bj < 2; ++bj) { const f32x4 gt = acc[ai][bj][m][0] * rs, up = acc[ai][bj][m][1] * rs; f32x4 o;
#pragma unroll
                    for (int j = 0; j < 4; ++j) o[j] = gt[j] * sigm(gt[j]) * up[j];
                    u32x2 w; w.x = cvt_pk_bf16(o[0], o[1]); w.y = cvt_pk_bf16(o[2], o[3]);
                    *(u32x2*)(U + (size_t)t * 2816 + col0 + bj * 64) = w; } }
    }
};
struct EpiF2 : EpiBase {
    float* out; float* ss2;
    __device__ __forceinline__ void operator()(const f32x4 (&acc)[2][2][4][2], const Unit& u, int wr, int wc, int fr, int fq) const {
        asm volatile("" : "+v"(fr), "+v"(fq));
        const int col0 = u.pn * 256 + wc * 32 + 8 * fq;
#pragma unroll
        for (int ai = 0; ai < 2; ++ai)
#pragma unroll
            for (int m = 0; m < 4; ++m) { const int t = u.pm * 256 + ai * 128 + wr * 64 + m * 16 + fr; float part = 0.f;
#pragma unroll
                for (int bj = 0; bj < 2; ++bj) { float* o = out + (size_t)t * 1024 + col0 + bj * 128;
                    const f32x4 v0 = *(const f32x4*)o + acc[ai][bj][m][0], v1 = *(const f32x4*)(o + 4) + acc[ai][bj][m][1];
                    *(f32x4*)o = v0; *(f32x4*)(o + 4) = v1; part += dot4(v0) + dot4(v1); }
                part += __shfl_xor(part, 16); part += __shfl_xor(part, 32);
                if (fq == 0) atomicAdd(ss2 + t, part); }
    }
};
}
#include <hip/hip_bf16.h>
#include <cmath>
namespace attn_body {
using bf16=__hip_bfloat16;
using bf16x8=__attribute__((ext_vector_type(8)))short;
using s16x4=__attribute__((ext_vector_type(4)))short;
using f32x16=__attribute__((ext_vector_type(16)))float;
using u32x4=__attribute__((ext_vector_type(4)))unsigned;
constexpr int D=64,QP=512,KP=64;
constexpr int NW=8,QBLK=32,QB=QBLK*NW,KVBLK=64;

__device__ __forceinline__ int crow(int r,int hi){return (r&3)+8*(r>>2)+4*hi;}
#define SBAR() __builtin_amdgcn_sched_barrier(0)
__device__ __forceinline__ void kmask(f32x16&p0,f32x16&p1,bool full){
  const float NEG=-INFINITY;
  #pragma unroll
  for(int r=0;r<16;++r){ if(full||r>=8)p0[r]=NEG; p1[r]=NEG; }
}

constexpr int NSLOT=3, SLOTB=8192;
constexpr int LDS_K=0, LDS_V=NSLOT*SLOTB, LDS_WS=2*NSLOT*SLOTB, LDS_OST=LDS_WS+NW*64*4, LDS_BYTES=LDS_OST+NW*4096;
constexpr float C2=0.125f*1.4426950408889634f;
__device__ __forceinline__ void glds16(const void*gsrc,unsigned lds_dst){unsigned keep;
  asm volatile("s_mov_b32 %0, m0\n\ts_mov_b32 m0, %2\n\ts_nop 0\n\tglobal_load_lds_dwordx4 %1, off\n\ts_mov_b32 m0, %0":"=&s"(keep):"v"(gsrc),"s"(lds_dst):"memory");}
__device__ __forceinline__ float max3f(float a,float b,float c){float r;asm("v_max3_f32 %0, %1, %2, %3":"=v"(r):"v"(a),"v"(b),"v"(c));return r;}
__device__ __forceinline__ float max2f(float a,float b){float r;asm("v_max_f32_e32 %0, %1, %2":"=v"(r):"v"(a),"v"(b));return r;}
__device__ __forceinline__ float fadd_s(float a,float b){float r;asm("v_add_f32_e32 %0, %1, %2":"=v"(r):"v"(a),"v"(b));return r;}
__device__ __forceinline__ float fsub_s(float a,float b){float r;asm("v_sub_f32_e32 %0, %1, %2":"=v"(r):"v"(a),"v"(b));return r;}
typedef float f32x2_t __attribute__((ext_vector_type(2))); typedef __bf16 bf16x2_t __attribute__((ext_vector_type(2)));
__device__ __forceinline__ unsigned cvtpk_s(float lo,float hi){f32x2_t v={lo,hi};bf16x2_t b=__builtin_convertvector(v,bf16x2_t);return __builtin_bit_cast(unsigned,b);}
#define WAIT_BAR(N) asm volatile("s_waitcnt vmcnt(" #N ") lgkmcnt(0)\n\ts_barrier":::"memory")

__device__ __forceinline__ void qkt(f32x16&p0,f32x16&p1,const char*Kslot,const bf16x8*qr,const f32x16&negm,int r32,int hi){
  const char*kb=Kslot+hi*1024+r32*16;
  #pragma unroll
  for(int d0=0;d0<4;++d0){
    const bf16x8 b0=*reinterpret_cast<const bf16x8*>(kb+d0*2048);
    const bf16x8 b1=*reinterpret_cast<const bf16x8*>(kb+d0*2048+512);
    if(d0==0){p0=__builtin_amdgcn_mfma_f32_32x32x16_bf16(b0,qr[0],negm,0,0,0);p1=__builtin_amdgcn_mfma_f32_32x32x16_bf16(b1,qr[0],negm,0,0,0);}
    else{p0=__builtin_amdgcn_mfma_f32_32x32x16_bf16(b0,qr[d0],p0,0,0,0);p1=__builtin_amdgcn_mfma_f32_32x32x16_bf16(b1,qr[d0],p1,0,0,0);}}
}
typedef __attribute__((address_space(3))) const char* lds_cptr;
typedef short v4i16_t __attribute__((ext_vector_type(4)));
__device__ __forceinline__ void kload8(bf16x8*kf,lds_cptr kp){
  kf[0]=*(const __attribute__((address_space(3))) bf16x8*)(kp);      kf[1]=*(const __attribute__((address_space(3))) bf16x8*)(kp+512);
  kf[2]=*(const __attribute__((address_space(3))) bf16x8*)(kp+2048); kf[3]=*(const __attribute__((address_space(3))) bf16x8*)(kp+2560);
  kf[4]=*(const __attribute__((address_space(3))) bf16x8*)(kp+4096); kf[5]=*(const __attribute__((address_space(3))) bf16x8*)(kp+4608);
  kf[6]=*(const __attribute__((address_space(3))) bf16x8*)(kp+6144); kf[7]=*(const __attribute__((address_space(3))) bf16x8*)(kp+6656);
}
__device__ __forceinline__ void kload2(bf16x8*kf,lds_cptr kp,int j){ kf[2*j]=*(const __attribute__((address_space(3))) bf16x8*)(kp+j*2048); kf[2*j+1]=*(const __attribute__((address_space(3))) bf16x8*)(kp+j*2048+512); }
__device__ __forceinline__ s16x4 vtr(lds_cptr p){ return __builtin_bit_cast(s16x4,__builtin_amdgcn_ds_read_tr16_b64_v4i16((__attribute__((address_space(3))) v4i16_t*)p)); }
__device__ __forceinline__ float rowmax(const f32x16&p0,const f32x16&p1){
  float a=max3f(p0[0],p0[1],p1[0]),b=max3f(p0[2],p0[3],p1[1]);a=max3f(a,p1[2],p1[3]);
  #pragma unroll
  for(int r=4;r<16;r+=4){a=max3f(a,p0[r],p0[r+1]);b=max3f(b,p0[r+2],p0[r+3]);a=max3f(a,p1[r],p1[r+1]);b=max3f(b,p1[r+2],p1[r+3]);}
  const float m=max2f(a,b);
  auto rr=__builtin_amdgcn_permlane32_swap(__float_as_uint(m),__float_as_uint(m),false,false);
  return max2f(__uint_as_float(rr[0]),__uint_as_float(rr[1]));
}
__device__ __forceinline__ void pv(f32x16*o,int vb,bf16x8 pa0,bf16x8 pa1,bf16x8 pa2,bf16x8 pa3){
  #pragma unroll
  for(int d0=0;d0<2;++d0){s16x4 lo[4],hi[4];
    #pragma unroll
    for(int ks=0;ks<4;++ks){
      asm volatile("ds_read_b64_tr_b16 %0,%1 offset:%c2":"=&v"(lo[ks]):"v"(vb),"i"(d0*4096+ks*1024):"memory");
      asm volatile("ds_read_b64_tr_b16 %0,%1 offset:%c2":"=&v"(hi[ks]):"v"(vb),"i"(d0*4096+ks*1024+512):"memory");}
    asm volatile("s_waitcnt lgkmcnt(0)":::"memory");SBAR();
    #define PK(k) (bf16x8){lo[k][0],lo[k][1],lo[k][2],lo[k][3],hi[k][0],hi[k][1],hi[k][2],hi[k][3]}
    o[d0]=__builtin_amdgcn_mfma_f32_32x32x16_bf16(pa0,PK(0),o[d0],0,0,0);
    o[d0]=__builtin_amdgcn_mfma_f32_32x32x16_bf16(pa1,PK(1),o[d0],0,0,0);
    o[d0]=__builtin_amdgcn_mfma_f32_32x32x16_bf16(pa2,PK(2),o[d0],0,0,0);
    o[d0]=__builtin_amdgcn_mfma_f32_32x32x16_bf16(pa3,PK(3),o[d0],0,0,0);
    #undef PK
  }
}

#ifndef ATTN_STORE16
#define ATTN_STORE16(p,v) (*(u32x4*)(p)=(v))
#endif
template<int THRL> __device__ __forceinline__ void attn_unit(const bf16*Qblk,const bf16*__restrict__ Kh,const bf16*__restrict__ Vh,bf16*Oblk,const int NT,const float shiftM,char*shm){
  int tid_=threadIdx.x; asm volatile("":"+v"(tid_));
  const int tid=tid_,lane=tid&63,r32=lane&31,hi=lane>>5; const int wid=__builtin_amdgcn_readfirstlane(tid>>6);

  const bf16*Qw=Qblk+(long)(wid*QBLK)*QP;

  const unsigned lds0=(unsigned)(uintptr_t)shm;
  float*wsf=(float*)(shm+LDS_WS)+wid*64;
  const bf16*ksrc=Kh+(long)lane*KP+wid*8;
  const bf16*vsrc=Vh+(long)(16*(wid&3)+(lane>>2))*KP+(wid>>2)*32+(lane&3)*8;
  const unsigned kdst=lds0+LDS_K+wid*1024, vdst=lds0+LDS_V+wid*1024;
  #define DMA_K(t,slot) glds16(ksrc+(long)(t)*KVBLK*KP,(unsigned)__builtin_amdgcn_readfirstlane(kdst+(slot)))
  #define DMA_V(t,slot) glds16(vsrc+(long)(t)*KVBLK*KP,(unsigned)__builtin_amdgcn_readfirstlane(vdst+(slot)))
  const int vb0=(int)(lds0+LDS_V)+((lane>>4)&1)*32+(lane&3)*8+(4*hi+((lane&15)>>2))*64;
  const char*Kbase=shm+LDS_K; bf16x8 kf[8];
  const lds_cptr shm3=(lds_cptr)shm; const lds_cptr kp0=shm3+LDS_K+hi*1024+r32*16; const lds_cptr vp0=shm3+LDS_V+((lane>>4)&1)*32+(lane&3)*8+(4*hi+((lane&15)>>2))*64;
  DMA_K(0,0);DMA_V(0,0);DMA_K(1,SLOTB);
  bf16x8 qr[4];
  #pragma unroll
  for(int d0=0;d0<4;++d0)qr[d0]=*reinterpret_cast<const bf16x8*>(&Qw[(long)r32*QP+d0*16+hi*8]);
  float mhat=0.f,l_reg=0.f;f32x16 o[2];o[0]=f32x16{};o[1]=f32x16{};f32x16 negm; _Pragma("unroll") for(int r=0;r<16;++r)negm[r]=-shiftM; asm volatile("":"+v"(negm));
  const int qrel=wid*QBLK+r32;
  #define CMASK(P0,P1,t) do{}while(0)
  bool resc=false;
  #define START(P0,P1) do{ resc=false; \
    _Pragma("unroll") for(int r=0;r<16;++r)P0[r]=__builtin_amdgcn_exp2f(P0[r]); }while(0)
  #define RESC() do{ if(resc){ asm volatile("s_waitcnt lgkmcnt(0)":::"memory"); \
      _Pragma("unroll") for(int d_=0;d_<2;++d_) _Pragma("unroll") for(int r=0;r<16;++r)o[d_][r]*=wsf[crow(r,hi)]; } }while(0)
  f32x16 pA0,pA1,pB0,pB1;
  int sl_prev=0,sl_cur=0,sl_next=SLOTB;
  #define ROT() do{sl_prev=sl_cur;sl_cur=sl_next;sl_next=(sl_next==(NSLOT-1)*SLOTB)?0:sl_next+SLOTB;}while(0)
  DMA_K(2,2*SLOTB);
  WAIT_BAR(3);
  qkt(pA0,pA1,Kbase,qr,negm,r32,hi);asm volatile("s_nop 15\n\ts_nop 7":"+v"(pA0),"+v"(pA1));CMASK(pA0,pA1,0);
  START(pA0,pA1);
  _Pragma("unroll") for(int r=0;r<16;++r)pA1[r]=__builtin_amdgcn_exp2f(pA1[r]);
  WAIT_BAR(0);
  DMA_K(3,0);DMA_V(1,SLOTB);
  ROT();
  kload8(kf,kp0+sl_cur);
  WAIT_BAR(2);
  s16x4 vlo[8],vhi[8]; u32x4 pw0,pw1,pw2,pw3;
  #define PKW(P,B) cvtpk_s(P[B],P[B+1])
  #define PAF(k) __builtin_bit_cast(bf16x8,pw##k)
  #define VFR(i) (bf16x8){vlo[i][0],vlo[i][1],vlo[i][2],vlo[i][3],vhi[i][0],vhi[i][1],vhi[i][2],vhi[i][3]}
  #define PIN(x) asm volatile("":"+v"(x))
  #define MX3(a,b,c) __builtin_fmaxf(__builtin_fmaxf((a),(b)),(c))
  #define GAPA(MF,A0,A1,A2,A3,W0,W1,PW) do{ MF; sacc+=A0; sacc+=A1; sacc+=A2; sacc+=A3; PIN(sacc); W0; W1; PIN(PW); SBAR(); }while(0)
  #define EX(v) __builtin_amdgcn_exp2f(v)
  #define GAPB(MF,X,B) do{ MF; X[B]=EX(X[B]); X[B+1]=EX(X[B+1]); X[B+2]=EX(X[B+2]); X[B+3]=EX(X[B+3]); PIN(X); SBAR(); }while(0)
  #define VRD(i) do{ vlo[i]=vtr(vp_+(((i)>>2)*4096+((i)&3)*1024)); vhi[i]=vtr(vp_+(((i)>>2)*4096+((i)&3)*1024+512)); }while(0)
  #define KRD(G,j) do{ if(G){ kload2(kf,kp0+sl_next,j); SBAR(); } }while(0)
  #define STEP(C0,C1,P0,P1,t,GK,GV,GL) do{ SBAR(); \
    const lds_cptr vp_=vp0+sl_prev; \
    VRD(0); SBAR(); float sacc=(P0[0]+P0[1]); \
    GAPA(C0=__builtin_amdgcn_mfma_f32_32x32x16_bf16(kf[0],qr[0],negm,0,0,0), P0[2],P0[3],P0[4],P0[5],     pw0[0]=PKW(P0,0), pw0[1]=PKW(P0,2), pw0); \
    VRD(4); SBAR(); GAPA(C1=__builtin_amdgcn_mfma_f32_32x32x16_bf16(kf[1],qr[0],negm,0,0,0), P0[6],P0[7],P0[8],P0[9],     pw0[2]=PKW(P0,4), pw0[3]=PKW(P0,6), pw0); \
    VRD(1); SBAR(); GAPA(C0=__builtin_amdgcn_mfma_f32_32x32x16_bf16(kf[2],qr[1],C0,0,0,0),   P0[10],P0[11],P0[12],P0[13], pw1[0]=PKW(P0,8), pw1[1]=PKW(P0,10), pw1); \
    VRD(5); SBAR(); GAPA(C1=__builtin_amdgcn_mfma_f32_32x32x16_bf16(kf[3],qr[1],C1,0,0,0),   P0[14],P0[15],P1[0],P1[1],   pw1[2]=PKW(P0,12),pw1[3]=PKW(P0,14), pw1); \
    VRD(2); SBAR(); GAPA(C0=__builtin_amdgcn_mfma_f32_32x32x16_bf16(kf[4],qr[2],C0,0,0,0),   P1[2],P1[3],P1[4],P1[5],     pw2[0]=PKW(P1,0), pw2[1]=PKW(P1,2), pw2); \
    VRD(6); SBAR(); GAPA(C1=__builtin_amdgcn_mfma_f32_32x32x16_bf16(kf[5],qr[2],C1,0,0,0),   P1[6],P1[7],P1[8],P1[9],     pw2[2]=PKW(P1,4), pw2[3]=PKW(P1,6), pw2); \
    VRD(3); SBAR(); GAPA(C0=__builtin_amdgcn_mfma_f32_32x32x16_bf16(kf[6],qr[3],C0,0,0,0),   P1[10],P1[11],P1[12],P1[13], pw3[0]=PKW(P1,8), pw3[1]=PKW(P1,10), pw3); \
    VRD(7); SBAR(); GAPA(C1=__builtin_amdgcn_mfma_f32_32x32x16_bf16(kf[7],qr[3],C1,0,0,0),   P1[14],P1[15],0.f,0.f,       pw3[2]=PKW(P1,12),pw3[3]=PKW(P1,14), pw3); \
    l_reg+=sacc; \
    if(GK){DMA_K((t)+3,sl_cur);} if(GV){DMA_V((t)+1,sl_next);} \
    CMASK(C0,C1,t); \
    resc=false; \
    SBAR(); \
    GAPB(o[0]=__builtin_amdgcn_mfma_f32_32x32x16_bf16(PAF(0),VFR(0),o[0],0,0,0), C0,0); \
    GAPB(o[1]=__builtin_amdgcn_mfma_f32_32x32x16_bf16(PAF(0),VFR(4),o[1],0,0,0), C0,4); \
    KRD(GL,0); GAPB(o[0]=__builtin_amdgcn_mfma_f32_32x32x16_bf16(PAF(1),VFR(1),o[0],0,0,0), C0,8); \
    KRD(GL,1); GAPB(o[1]=__builtin_amdgcn_mfma_f32_32x32x16_bf16(PAF(1),VFR(5),o[1],0,0,0), C0,12); \
    KRD(GL,2); GAPB(o[0]=__builtin_amdgcn_mfma_f32_32x32x16_bf16(PAF(2),VFR(2),o[0],0,0,0), C1,0); \
    KRD(GL,3); GAPB(o[1]=__builtin_amdgcn_mfma_f32_32x32x16_bf16(PAF(2),VFR(6),o[1],0,0,0), C1,4); \
    GAPB(o[0]=__builtin_amdgcn_mfma_f32_32x32x16_bf16(PAF(3),VFR(3),o[0],0,0,0), C1,8); \
    GAPB(o[1]=__builtin_amdgcn_mfma_f32_32x32x16_bf16(PAF(3),VFR(7),o[1],0,0,0), C1,12); \
    }while(0)
  int t=1;
  #undef CMASK
  #define CMASK(P0,P1,t) do{}while(0)
  for(;t+5<NT;t+=2){
    STEP(pB0,pB1,pA0,pA1,t,true,true,true);     WAIT_BAR(2); RESC(); ROT();
    STEP(pA0,pA1,pB0,pB1,t+1,true,true,true);   WAIT_BAR(2); RESC(); ROT();
  }
  #undef CMASK
  #define CMASK(P0,P1,t) do{ if((t)>=NT-2) kmask(P0,P1,(t)==NT-1); }while(0)
  #define ENDW(tt) do{ if((tt)+3<NT){WAIT_BAR(2);} else if((tt)+2<NT){WAIT_BAR(1);} else {WAIT_BAR(0);} }while(0)
  for(;t+1<NT;t+=2){
    STEP(pB0,pB1,pA0,pA1,t,(t+3<NT),(t+1<NT),(t+1<NT));       ENDW(t);   RESC(); ROT();
    STEP(pA0,pA1,pB0,pB1,t+1,(t+4<NT),(t+2<NT),(t+2<NT));     ENDW(t+1); RESC(); ROT();
  }
  STEP(pB0,pB1,pA0,pA1,NT-1,false,false,false); RESC();
  { float sacc=pB0[0]+pB0[1]; _Pragma("unroll") for(int r=2;r<16;++r)sacc+=pB0[r]; _Pragma("unroll") for(int r=0;r<16;++r)sacc+=pB1[r]; l_reg+=sacc;
    pw0=(u32x4){PKW(pB0,0),PKW(pB0,2),PKW(pB0,4),PKW(pB0,6)};pw1=(u32x4){PKW(pB0,8),PKW(pB0,10),PKW(pB0,12),PKW(pB0,14)};pw2=(u32x4){PKW(pB1,0),PKW(pB1,2),PKW(pB1,4),PKW(pB1,6)};pw3=(u32x4){PKW(pB1,8),PKW(pB1,10),PKW(pB1,12),PKW(pB1,14)};
    SBAR(); pv(o,vb0+sl_cur,PAF(0),PAF(1),PAF(2),PAF(3)); }
  #undef PKW
  #undef PAF
  #undef VFR
  #undef PIN
  #undef MX3
  #undef GAPA
  #undef GAPB
  #undef EX
  #undef VRD
  #undef KRD
  #undef STEP
  #undef ENDW
  {auto rr=__builtin_amdgcn_permlane32_swap(__float_as_uint(l_reg),__float_as_uint(l_reg),false,false);l_reg=__uint_as_float(rr[0])+__uint_as_float(rr[1]);}
  if(hi==0)wsf[32+r32]=l_reg;asm volatile("s_waitcnt lgkmcnt(0)":::"memory");
  float rli[16];
  #pragma unroll
  for(int r=0;r<16;++r)rli[r]=__builtin_amdgcn_rcpf(wsf[32+crow(r,hi)]);
  bf16*Ow=Oblk+(long)(wid*QBLK)*QP;
  { bf16*stg=(bf16*)(shm+LDS_OST)+wid*2048;
    #pragma unroll
    for(int r=0;r<16;++r){const int orow=crow(r,hi);
      #pragma unroll
      for(int d0=0;d0<2;++d0)stg[orow*64+d0*32+r32]=__float2bfloat16(o[d0][r]*rli[r]);}
    asm volatile("s_waitcnt lgkmcnt(0)":::"memory");
    #pragma unroll
    for(int i=0;i<4;++i){const int row=i*8+(lane>>3),ch=lane&7; const u32x4 v=*(const u32x4*)(stg+row*64+ch*8); ATTN_STORE16(Ow+(long)row*QP+ch*8,v);} }
  asm volatile("s_waitcnt lgkmcnt(0)\n\ts_barrier":::"memory");
  #undef DMA_K
  #undef DMA_V
  #undef CMASK
  #undef START
  #undef RESC
  #undef ROT
}
#undef SBAR
#undef WAIT_BAR
}
#define GAS __attribute__((address_space(1)))
#define LAS __attribute__((address_space(3)))
typedef unsigned short bf16;
typedef unsigned v4u __attribute__((ext_vector_type(4)));
typedef float f32x4 __attribute__((ext_vector_type(4)));
constexpr size_t MiB = 1u << 20;
constexpr size_t WS_CTL = 0, CTL_BYTES = 4096;
constexpr size_t WS_ROPE = 1 * MiB, WS_SS1 = 2 * MiB, WS_SS2 = 3 * MiB;
constexpr size_t WS_WIN = 4 * MiB, WS_WG = 10 * MiB, WS_WA = 11 * MiB, WS_WF = 12 * MiB, WS_WO = 13 * MiB, WS_WFFN = 15 * MiB, WS_WDN = 26 * MiB;
constexpr size_t WS_GA = 32 * MiB, WS_X1B = 32 * MiB, WS_Q = 416 * MiB, WS_KB = 512 * MiB, WS_VB = 537 * MiB, WS_GTP = 562 * MiB, WS_GTS = 596 * MiB;
constexpr size_t WS_CS = 661 * MiB, WS_SS = 697 * MiB, WS_CP = 733 * MiB, WS_SP = 736 * MiB, WS_GFS = 739 * MiB, WS_GFP = 772 * MiB, WS_H = 813 * MiB, WS_F = 813 * MiB, WS_DS = 909 * MiB, WS_DP = 977 * MiB, WS_END = 1017 * MiB;
constexpr size_t WS_U = 224 * MiB, WS_MG = 512 * MiB;
static_assert(WS_GA + (size_t)NTOK * 2048 * 2 <= WS_Q && WS_Q + (size_t)NTOK * 512 * 2 <= WS_KB && WS_KB + (KV_S_OFF + (size_t)16 * KPS * 64) * 2 <= WS_VB && WS_VB + (KV_S_OFF + (size_t)16 * KPS * 64) * 2 <= WS_GTP, "ws map 1");
static_assert(WS_GTP + (size_t)16 * 512 * KPP * 2 <= WS_GTS && WS_GTS + (size_t)8 * 512 * KPS * 2 <= WS_CS && WS_CS + (size_t)MTS * 256 * K2S * 2 <= WS_SS && WS_SS + (size_t)MTS * 256 * K2S * 2 <= WS_CP, "ws map 2");
static_assert(WS_CP + (size_t)MTP * 256 * K2P * 2 <= WS_SP && WS_SP + (size_t)MTP * 256 * K2P * 2 <= WS_GFS && WS_GFS + (size_t)8 * 512 * K2S * 2 <= WS_GFP && WS_GFP + (size_t)16 * 512 * K2P * 2 <= WS_H && WS_H + (size_t)(NTOK + 256) * 1024 * 2 <= WS_END && WS_F + (size_t)NTOK * 512 * 2 <= WS_DS && WS_DS + (size_t)272 * 262144 <= WS_DP && WS_DP + (size_t)160 * 262144 <= WS_END, "ws map 3");
static_assert(WS_U + (size_t)NTOK * 2816 * 2 <= WS_END && WS_X1B + (size_t)NTOK * 1024 * 2 <= WS_U && WS_MG + (size_t)NTOK * 1024 * 2 <= WS_F && WS_WDN + (size_t)1024 * 2816 * 2 <= WS_GA && WS_WFFN + (size_t)5632 * 1024 * 2 <= WS_WDN && WS_WIN + (size_t)2816 * 1024 * 2 <= WS_WG, "ws map 4");
constexpr int LDS_BYTES = 147456, MISC_OFF = 131072 + 320;
constexpr int NATT = 3072;

__device__ __forceinline__ unsigned f2bf(float f) { unsigned u = __builtin_bit_cast(unsigned, f); return (u + 0x7fffu + ((u >> 16) & 1u)) >> 16; }
__device__ __forceinline__ unsigned pk2(float lo, float hi) { return f2bf(lo) | (f2bf(hi) << 16); }
__device__ __forceinline__ float wave_sum(float v) {
#pragma unroll
    for (int o = 1; o < 64; o <<= 1) v += __shfl_xor(v, o);
    return v; }

__device__ __forceinline__ int src_col(int mat, int n) {
    if (mat == 0) {
        if (n >= 768) return 1280 + (n - 768);
        const int ct = n & 255, bj = ct >> 7, wc = (ct >> 5) & 3, fq = (ct >> 3) & 3, nn = (ct >> 2) & 1, j = ct & 3;
        if (n < 512) return ((n >> 8) * 4 + wc) * 64 + 32 * bj + 16 * nn + 4 * fq + j;
        if (wc < 2) return 512 + wc * 64 + 32 * bj + 16 * nn + 4 * fq + j;
        return 640 + (wc - 2) * 64 + 32 * bj + 8 * fq + 4 * nn + j;
    }
    if (mat == 4) { const int pn = n >> 8, ct = n & 255, nn = (ct >> 2) & 1, j = ct & 3, q8 = ct >> 3; return (nn ? 2816 : 0) + 128 * pn + 4 * q8 + j; }
    return n;
}
__device__ __forceinline__ void tr_item(const float* W, int ldw, int K, int ND, bf16* WT, int mat, const float* ksc, LAS float* scr, int item, int lane) {
    const int nblk = ND / 32, kb = item / nblk, nb = item % nblk, k0 = 64 * kb, n0 = 32 * nb;
    const int sc = src_col(mat, n0 + (lane & 31));
#pragma unroll 8
    for (int i = 0; i < 32; ++i) { const int kk = 2 * i + (lane >> 5); float v = W[(size_t)(k0 + kk) * ldw + sc]; if (ksc) v *= ksc[k0 + kk]; scr[kk * 33 + (lane & 31)] = v; }
    asm volatile("s_waitcnt lgkmcnt(0)" ::: "memory");
    const int c = lane & 7;
#pragma unroll
    for (int j = 0; j < 4; ++j) { const int n = (lane >> 3) + 8 * j; const LAS float* s = scr + (8 * c) * 33 + n;
        v4u o; o.x = pk2(s[0 * 33], s[1 * 33]); o.y = pk2(s[2 * 33], s[3 * 33]); o.z = pk2(s[4 * 33], s[5 * 33]); o.w = pk2(s[6 * 33], s[7 * 33]);
        *(v4u*)(WT + (size_t)(n0 + n) * K + k0 + 8 * c) = o; }
    asm volatile("s_waitcnt lgkmcnt(0)" ::: "memory");
}
__device__ __forceinline__ void rms_row_bf16(const float* xrow, const float* g, bf16* orow, int lane) {
    const f32x4* xr = (const f32x4*)xrow + lane; const f32x4* gr = (const f32x4*)g + lane;
    f32x4 v[4]; float s = 0.f;
#pragma unroll
    for (int j = 0; j < 4; ++j) { v[j] = xr[64 * j]; s += (v[j].x * v[j].x + v[j].y * v[j].y) + (v[j].z * v[j].z + v[j].w * v[j].w); }
    const float rstd = rsqrtf(wave_sum(s) * (1.f / 1024.f) + EPS);
    unsigned long long* o8 = (unsigned long long*)orow + lane;
#pragma unroll
    for (int j = 0; j < 4; ++j) { const f32x4 gg = gr[64 * j]; o8[64 * j] = (unsigned long long)pk2(v[j].x * rstd * gg.x, v[j].y * rstd * gg.y) | ((unsigned long long)pk2(v[j].z * rstd * gg.z, v[j].w * rstd * gg.w) << 32); }
}
__device__ __forceinline__ void dft_fill(bf16* C, bf16* S, int rows, int KP_, int L, long gtid, long nthr) {
    const int per_row = KP_ / 8; const long items = (long)rows * per_row; const float inv = 2.0f / (float)L;
    for (long it = gtid; it < items; it += nthr) { const int r = (int)(it / per_row), l0 = (int)(it % per_row) * 8;
        const bool rv = (r >= 1 && r <= L / 2);
        unsigned cw[4], sw[4]; int m = rv ? (int)(((long)r * l0) % L) : 0;
#pragma unroll
        for (int e = 0; e < 4; ++e) { float c0 = 0.f, s0 = 0.f, c1 = 0.f, s1 = 0.f;
            if (rv && l0 + 2 * e <= L / 2) sincospif((float)m * inv, &s0, &c0);
            m += r; if (m >= L) m -= L;
            if (rv && l0 + 2 * e + 1 <= L / 2) sincospif((float)m * inv, &s1, &c1);
            m += r; if (m >= L) m -= L;
            cw[e] = pk2(c0, c1); sw[e] = pk2(s0, s1); }
        *(v4u*)(C + (size_t)r * KP_ + l0) = (v4u){cw[0], cw[1], cw[2], cw[3]}; *(v4u*)(S + (size_t)r * KP_ + l0) = (v4u){sw[0], sw[1], sw[2], sw[3]}; }
}
__device__ __forceinline__ void gt_fold(const bf16* GT, bf16* GF, int nseq, int KPin, int K2, int L, long gtid, long nthr) {
    const int per_row = K2 / 8; const long items = (long)nseq * 512 * per_row; const int L2 = L / 2;
    for (long it = gtid; it < items; it += nthr) { const int row = (int)(it / per_row), l0 = (int)(it % per_row) * 8; const bf16* g = GT + (size_t)row * KPin;
        const bool odd = ((row & 127) > 64); float o[8];
#pragma unroll
        for (int j = 0; j < 8; ++j) { const int l = l0 + j; float v = 0.f;
            if (l <= L2) { const float a = __uint_as_float((unsigned)g[l < 16 ? l : l + 48] << 16);
                if (l == 0 || l == L2) v = odd ? 0.f : a;
                else { const float b = __uint_as_float((unsigned)g[L - l + 48] << 16); v = odd ? a - b : a + b; } }
            o[j] = v; }
        *(v4u*)(GF + (size_t)row * K2 + l0) = (v4u){pk2(o[0], o[1]), pk2(o[2], o[3]), pk2(o[4], o[5]), pk2(o[6], o[7])}; }
}

__device__ __forceinline__ void my_bar(unsigned* cnt, unsigned target) {
    __syncthreads();
    if (threadIdx.x == 0) {
        __builtin_amdgcn_fence(__ATOMIC_RELEASE, "agent");
        __hip_atomic_fetch_add(cnt, 1u, __ATOMIC_RELAXED, __HIP_MEMORY_SCOPE_AGENT);
        while (__hip_atomic_load(cnt, __ATOMIC_RELAXED, __HIP_MEMORY_SCOPE_AGENT) < target) __builtin_amdgcn_s_sleep(2);
        __builtin_amdgcn_fence(__ATOMIC_ACQUIRE, "agent");
    }
    __syncthreads();
}
struct Args { const float* in[14]; float* out; unsigned char* ws; };

#if CHECKS
#define BF(v) (__uint_as_float(((unsigned)(v)) << 16))
__device__ __forceinline__ void chk(unsigned* ctl, int stage, float got, float ref, float rt) {
    const bool bad = !(fabsf(got - ref) <= rt * (1.0f + fabsf(ref)));
    const unsigned long long m = __ballot(bad);
    if ((threadIdx.x & 63) == 0 && m) atomicAdd(ctl + 200 + stage, (unsigned)__popcll(m));
}
__device__ __forceinline__ void tok_geom(int t, int& seq, int& p) { if (t < P_TOK) { seq = t >> 11; p = t & 2047; } else { seq = 16 + ((t - P_TOK) >> 13); p = (t - P_TOK) & 8191; } }
#define RUN_CHECKS(stage) do { run_checks((stage), bx * 8 + wave, lane); GRID_SYNC(); } while (0)
__device__ __forceinline__ void run_checks(int stage, int gw, int lane) {
    typedef __attribute__((address_space(4))) const Args CArgs;
    CArgs* ap_ = (CArgs*)__builtin_amdgcn_kernarg_segment_ptr(); unsigned char* ws = ap_->ws; unsigned* ctl = (unsigned*)(ws + WS_CTL);
    const int t = (int)(((long)gw * 48 + (gw >> 3)) % NTOK); int seq, p; tok_geom(t, seq, p);
    if (stage == 1) {
        const bf16* hrow = (const bf16*)(ws + WS_H) + (size_t)t * 1024; const float* w_in = ap_->in[4]; const int c = lane * 32 + (gw & 31);
        float z = 0.f; for (int k = 0; k < 1024; ++k) z += BF(hrow[k]) * w_in[(size_t)k * 3328 + 1280 + c];
        chk(ctl, 1, BF(((const bf16*)(ws + WS_GA))[(size_t)t * 2048 + c]), 1.f / (1.f + expf(-z)), 0.02f);
        { const float* xr = t < P_TOK ? ap_->in[0] + (size_t)t * 1024 : ap_->in[1] + (size_t)(t - P_TOK) * 1024; float s = 0.f; for (int k = lane; k < 1024; k += 64) s += xr[k] * xr[k];
          s = wave_sum(s); const float rs = rsqrtf(s * (1.f / 1024.f) + EPS); const int k = lane * 16 + (gw & 15); chk(ctl, 0, BF(hrow[k]), xr[k] * rs * ap_->in[3][k], 0.01f); }
    } else if (stage == 2) {
        const int L = seq < 16 ? LP : LS, lp = 16 + p, KP_ = seq < 16 ? KPP : KPS; const float scale = rsqrtf((float)L * 128.0f);
        const int c = lane * 8 + (gw & 7), g = c >> 7, cp = c & 127;
        const int rc = cp <= 64 ? cp : 128 - cp, rs_ = (cp == 0 || cp == 64) ? -1 : (cp < 64 ? 64 + cp : 192 - cp); const float sg = cp < 64 ? 1.f : -1.f;
        const bf16* gb = seq < 16 ? (const bf16*)(ws + WS_GTP) + ((size_t)seq * 512 + g * 128) * KPP : (const bf16*)(ws + WS_GTS) + ((size_t)(seq - 16) * 512 + g * 128) * KPS;
        float a = 0.f; int m = 0;
        for (int l = 0; l < L; ++l) { const int ph = l < 16 ? l : l + 48; float sn, cs; sincospif(2.0f * (float)m / (float)L, &sn, &cs);
            a += cs * BF(gb[(size_t)rc * KP_ + ph]); if (rs_ >= 0) a -= sg * sn * BF(gb[(size_t)rs_ * KP_ + ph]);
            m += lp; if (m >= L) m -= L; }
        chk(ctl, 2, BF(((const bf16*)(ws + WS_F))[(size_t)t * 512 + c]), a * scale, 0.04f);
    } else if (stage == 3) {
        const int c = lane * 16 + (gw & 15); float a = 0.f, f = 0.f;
        for (int k = 0; k < 512; ++k) { a += BF(((const bf16*)(ws + WS_Q))[(size_t)t * 512 + k]) * ap_->in[7][(size_t)k * 1024 + c]; f += BF(((const bf16*)(ws + WS_F))[(size_t)t * 512 + k]) * ap_->in[8][(size_t)k * 1024 + c]; }
        const bf16* ga = (const bf16*)(ws + WS_GA) + (size_t)t * 2048;
        chk(ctl, 3, BF(((const bf16*)(ws + WS_MG))[(size_t)t * 1024 + c]), BF(ga[c]) * a + BF(ga[1024 + c]) * f, 0.03f);
    } else if (stage == 4) {
        const float* xr = t < P_TOK ? ap_->in[0] + (size_t)t * 1024 : ap_->in[1] + (size_t)(t - P_TOK) * 1024; const float* o = ap_->out + (size_t)t * 1024;
        const int c = lane * 16 + (gw & 15); float a = 0.f; for (int k = 0; k < 1024; ++k) a += BF(((const bf16*)(ws + WS_MG))[(size_t)t * 1024 + k]) * ap_->in[9][(size_t)k * 1024 + c];
        chk(ctl, 4, o[c], xr[c] + a, 0.02f);
        chk(ctl, 4, BF(((const bf16*)(ws + WS_X1B))[(size_t)t * 1024 + c]), o[c], 0.01f);
        { float s = 0.f; for (int cc = lane; cc < 1024; cc += 64) s += o[cc] * o[cc]; s = wave_sum(s); chk(ctl, 4, ((const float*)(ws + WS_SS1))[t], s, 0.002f); }
    } else if (stage == 5) {
        const bf16* xb = (const bf16*)(ws + WS_X1B) + (size_t)t * 1024; const float rs = rsqrtf(((const float*)(ws + WS_SS1))[t] * (1.f / 1024.f) + EPS);
        const int j = lane * 44 + (gw % 44); float g = 0.f, u = 0.f;
        for (int k = 0; k < 1024; ++k) { const float xv = BF(xb[k]) * ap_->in[10][k]; g += xv * ap_->in[11][(size_t)k * 5632 + j]; u += xv * ap_->in[11][(size_t)k * 5632 + 2816 + j]; }
        g *= rs; u *= rs;
        chk(ctl, 5, BF(((const bf16*)(ws + WS_U))[(size_t)t * 2816 + j]), g / (1.f + expf(-g)) * u, 0.03f);
    } else if (stage == 6) {
        const int c = lane * 16 + (gw & 15); float a = 0.f; for (int k = 0; k < 2816; ++k) a += BF(((const bf16*)(ws + WS_U))[(size_t)t * 2816 + k]) * ap_->in[12][(size_t)k * 1024 + c];
        const float* o = ap_->out + (size_t)t * 1024;
        chk(ctl, 6, o[c], BF(((const bf16*)(ws + WS_X1B))[(size_t)t * 1024 + c]) + a, 0.03f);
        { float s = 0.f; for (int cc = lane; cc < 1024; cc += 64) s += o[cc] * o[cc]; s = wave_sum(s); chk(ctl, 6, ((const float*)(ws + WS_SS2))[t], s, 0.002f); }
    }
}
#else
#define RUN_CHECKS(stage) do {} while (0)
#endif

__global__ void __launch_bounds__(512, 2) enc_fwd(Args args) {
    extern __shared__ __attribute__((aligned(16))) unsigned char lds[];
    cg::grid_group grid = cg::this_grid();
    LAS unsigned char* L3 = (LAS unsigned char*)lds;
    volatile LAS unsigned* MISC = (volatile LAS unsigned*)(L3 + MISC_OFF);
    const int tid = threadIdx.x, lane = tid & 63, wave = __builtin_amdgcn_readfirstlane(tid >> 6);
    const int G = gridDim.x, bx = blockIdx.x; int nsync_ = 0;
#if TSTAMP
    unsigned long long ts_[9]; for (int i_ = 0; i_ < 9; ++i_) ts_[i_] = 0; ts_[0] = __builtin_amdgcn_s_memrealtime();
#endif
    typedef __attribute__((address_space(4))) const Args CArgs;
#define LOAD_ARGS() CArgs* ap_ = (CArgs*)__builtin_amdgcn_kernarg_segment_ptr(); asm volatile("" : "+s"(ap_)); unsigned char* ws = ap_->ws; (void)ws
#define WSP(T, off) ((T*)(ws + (off)))
#define AIN(i) (ap_->in[i])
#define AOUT() (ap_->out)
#if TSTAMP
#define TS_MARK() do { if (nsync_ < 9) ts_[nsync_] = __builtin_amdgcn_s_memrealtime(); } while (0)
#else
#define TS_MARK() do {} while (0)
#endif
#define GRID_SYNC() do { asm volatile("s_waitcnt vmcnt(0) lgkmcnt(0)" ::: "memory"); grid.sync(); ++nsync_; __builtin_amdgcn_fence(__ATOMIC_ACQUIRE, "agent"); asm volatile("s_waitcnt vmcnt(0)" ::: "memory"); TS_MARK(); } while (0)
#define WSPC(T, off) ((T*)(((CArgs*)__builtin_amdgcn_kernarg_segment_ptr())->ws + (off)))

#if (PHM>>0)&1
    { LOAD_ARGS();
        const int gw = bx * 8 + wave, NGW = G * 8; const long gtid = (long)bx * 512 + tid, nthr = (long)G * 512;
        LAS float* tab = (LAS float*)L3;
        if (tid < 128) { tab[tid] = cospif((float)tid * (1.0f / 64.0f)); }
        __syncthreads();
        LAS float* scr = (LAS float*)(L3 + 1024 + wave * 8704);
        constexpr int I0 = 16 * 88, I1 = 8 * 32, I2 = 8 * 32, I3 = 16 * 32, I4 = 16 * 176, I5 = 44 * 32;
        for (int it = gw; it < I0 + I1 + I2 + I3 + I4 + I5; it += NGW) { int r = it;
            if (r < I0) { tr_item(AIN(4), 3328, 1024, 2816, WSP(bf16, WS_WIN), 0, nullptr, scr, r, lane); continue; } r -= I0;
            if (r < I1) { tr_item(AIN(7), 1024, 512, 1024, WSP(bf16, WS_WA), 1, nullptr, scr, r, lane); continue; } r -= I1;
            if (r < I2) { tr_item(AIN(8), 1024, 512, 1024, WSP(bf16, WS_WF), 2, nullptr, scr, r, lane); continue; } r -= I2;
            if (r < I3) { tr_item(AIN(9), 1024, 1024, 1024, WSP(bf16, WS_WO), 3, nullptr, scr, r, lane); continue; } r -= I3;
            if (r < I4) { tr_item(AIN(11), 5632, 1024, 5632, WSP(bf16, WS_WFFN), 4, AIN(10), scr, r, lane); continue; } r -= I4;
            tr_item(AIN(12), 1024, 2816, 1024, WSP(bf16, WS_WDN), 5, nullptr, scr, r, lane); }
        for (long id = gtid; id < 512 * 128; id += nthr) { const int wv = (int)id >> 6, ln = (int)id & 63, chunk = (wv & 15) * 8 + (ln & 7), row = (wv >> 4) * 8 + (ln >> 3), s = row & 127, g = row >> 7, k = chunk * 8;
            const float* wr_ = AIN(4) + (size_t)k * 3328 + 768 + g * 128; float a[8];
#pragma unroll
            for (int j = 0; j < 8; ++j) a[j] = 0.f;
            const int sm = s <= 64 ? s : s - 64, sh = s <= 64 ? 0 : 96;
            for (int c = 0; c < 128; ++c) { const float tv = tab[(c * sm + sh) & 127];
#pragma unroll
                for (int j = 0; j < 8; ++j) a[j] += wr_[(size_t)j * 3328 + c] * tv; }
            *(v4u*)(WSP(bf16, WS_WG) + (size_t)row * 1024 + k) = (v4u){pk2(a[0], a[1]), pk2(a[2], a[3]), pk2(a[4], a[5]), pk2(a[6], a[7])}; }
        for (int m = gw; m < NTOK + 256; m += NGW) {
            bf16* orow = WSP(bf16, WS_H) + (size_t)m * 1024;
            if (m < P_TOK) rms_row_bf16(AIN(0) + (size_t)m * 1024, AIN(3), orow, lane);
            else if (m < NTOK) rms_row_bf16(AIN(1) + (size_t)(m - P_TOK) * 1024, AIN(3), orow, lane);
            else if (m < NTOK + 16) rms_row_bf16(AIN(2) + (size_t)(m - NTOK) * 1024, AIN(3), orow, lane);
            else { unsigned long long* o8 = (unsigned long long*)orow + lane;
#pragma unroll
                for (int j = 0; j < 4; ++j) o8[64 * j] = 0ull; } }
        dft_fill(WSP(bf16, WS_CS), WSP(bf16, WS_SS), MTS * 256, K2S, LS, gtid, nthr);
        dft_fill(WSP(bf16, WS_CP), WSP(bf16, WS_SP), MTP * 256, K2P, LP, gtid, nthr);
        for (long id = gtid; id < 130 * 16; id += nthr) { const int pp = (int)id >> 4, i = (int)id & 15;
            const double ang = (double)(pp - 1) * pow(10000.0, -(double)i / 16.0);
            WSP(float, WS_ROPE)[pp * 32 + i] = (float)cos(ang); WSP(float, WS_ROPE)[pp * 32 + 16 + i] = (float)sin(ang); }
        for (long id = gtid; id < NTOK; id += nthr) { WSP(float, WS_SS1)[id] = 0.f; WSP(float, WS_SS2)[id] = 0.f; }
        for (long id = gtid; id < 48L * 112 * 8; id += nthr) { const int g = (int)(id / 896), rem = (int)(id % 896), r = rem >> 3, ch = rem & 7;
            const int seq = g >> 1, kvh = g & 1; const size_t off = pg8::kvoff(seq, kvh) + (size_t)(pg8::seqlen(seq) + 16 + r) * 64 + ch * 8;
            *(v4u*)(WSP(bf16, WS_KB) + off) = (v4u){0u, 0u, 0u, 0u}; *(v4u*)(WSP(bf16, WS_VB) + off) = (v4u){0u, 0u, 0u, 0u}; }
        for (long id = gtid; id < 24L * 512 * 8; id += nthr) { const int row = (int)(id >> 3), ch = (int)(id & 7), seq = row >> 9, c = row & 511;
            bf16* d = seq < 16 ? WSP(bf16, WS_GTP) + ((size_t)seq * 512 + c) * KPP + 64 + 2048 : WSP(bf16, WS_GTS) + ((size_t)(seq - 16) * 512 + c) * KPS + 64 + 8192;
            *(v4u*)(d + ch * 8) = (v4u){0u, 0u, 0u, 0u}; }
        asm volatile("s_waitcnt vmcnt(0) lgkmcnt(0)" ::: "memory");
    }
#endif
    GRID_SYNC();
    RUN_CHECKS(0);

#if (PHM>>1)&1
    { LOAD_ARGS();
        pg8::Gemm g{WSP(bf16, WS_H), WSP(bf16, WS_WIN), NTOK + 256, 2816, 1024}; pg8::G1Order S; S.init(G, bx);
        pg8::EpiG1 E; E.Q = WSP(bf16, WS_Q); E.KB = WSP(bf16, WS_KB); E.VB = WSP(bf16, WS_VB); E.GA = WSP(bf16, WS_GA); E.rope = WSP(float, WS_ROPE); E.gq = AIN(5); E.gk = AIN(6);
        pg8::gemm_phase<pg8::EpiG1, pg8::G1Order, PG_ALIGN, PG_SP2>(L3, g, S, E);
    }
#endif
#if (PHM>>2)&1
    { LOAD_ARGS();
        pg8::Gemm g{WSP(bf16, WS_WG), WSP(bf16, WS_H), 512, NTOK + 256, 1024}; pg8::StaticOrder S; S.init(512, NTOK + 256, G, G - 1 - bx);
        pg8::EpiGT E; E.GTp = WSP(bf16, WS_GTP); E.GTs = WSP(bf16, WS_GTS);
        pg8::gemm_phase<pg8::EpiGT, pg8::StaticOrder, PG_ALIGN, PG_SP2>(L3, g, S, E);
    }
#endif
    GRID_SYNC();
    RUN_CHECKS(1);

#if (PHM>>3)&1
    { LOAD_ARGS(); const long gtid = (long)bx * 512 + tid, nthr = (long)G * 512;
      gt_fold(WSP(bf16, WS_GTS), WSP(bf16, WS_GFS), 8, KPS, K2S, LS, gtid, nthr);
      gt_fold(WSP(bf16, WS_GTP), WSP(bf16, WS_GFP), 16, KPP, K2P, LP, gtid, nthr); }
    GRID_SYNC();
#endif
#if (PHM>>3)&1
    for (int ps = 0; ps < 2; ++ps) { LOAD_ARGS();
        const int K = ps ? K2P : K2S, nMt = ps ? MTP : MTS, Lq = ps ? LP : LS;
        pg8::DftOrder S; S.G = G; S.c = ps ? (bx + G - 16) % G : bx; S.total = ps ? 160 : 272; S.sample = !ps;
        { pg8::Gemm g{ps ? WSP(bf16, WS_CP) : WSP(bf16, WS_CS), ps ? WSP(bf16, WS_GFP) : WSP(bf16, WS_GFS), nMt * 256, ps ? 16 * 512 : 8 * 512, K};
          pg8::EpiDftP E; E.dump = ps ? WSP(float, WS_DP) : WSP(float, WS_DS); E.nMt = nMt;
          pg8::gemm_phase<pg8::EpiDftP, pg8::DftOrder, PG_ALIGN, PG_SP2>(L3, g, S, E); }
        { pg8::Gemm g{ps ? WSP(bf16, WS_SP) : WSP(bf16, WS_SS), ps ? WSP(bf16, WS_GFP) : WSP(bf16, WS_GFS), nMt * 256, ps ? 16 * 512 : 8 * 512, K};
          pg8::EpiDftQ E; E.dump = ps ? WSP(float, WS_DP) : WSP(float, WS_DS); E.nMt = nMt; E.F = WSP(bf16, WS_F); E.L = Lq; E.tokbase = ps ? 0 : P_TOK; E.nseq = ps ? 2048 : 8192; E.scale = rsqrtf((float)Lq * 128.0f);
          pg8::gemm_phase<pg8::EpiDftQ, pg8::DftOrder, PG_ALIGN, PG_SP2>(L3, g, S, E); }
    }
#endif
#if (PHM>>4)&1
    float shiftM; { LOAD_ARGS(); float mq = 0.f, mk = 0.f; for (int i = 0; i < 64; ++i) { mq = fmaxf(mq, fabsf(AIN(5)[i])); mk = fmaxf(mk, fabsf(AIN(6)[i])); } shiftM = QC2 * 64.0f * mq * mk * 1.01f + 0.05f; }
    for (;;) { LOAD_ARGS();
        if (tid == 0) MISC[0] = atomicAdd(WSP(unsigned, WS_CTL) + 64, 1u);
        __syncthreads();
        const int idx = (int)MISC[0];
        __syncthreads();
        if (idx >= NATT) break;
        int tok0, NT, hq; size_t kvo;
        if (idx < 2048) { const int gk = idx >> 7, r = idx & 127, b = gk >> 1, kvh = gk & 1; hq = kvh * 4 + (r >> 5); tok0 = P_TOK + b * 8192 + (r & 31) * 256; NT = 130; kvo = KV_S_OFF + (size_t)gk * KPS * 64; }
        else { const int j = idx - 2048, gk = j >> 5, r = j & 31, b = gk >> 1, kvh = gk & 1; hq = kvh * 4 + (r >> 3); tok0 = b * 2048 + (r & 7) * 256; NT = 34; kvo = (size_t)gk * KPP * 64; }
        attn_body::attn_unit<8>((const attn_body::bf16*)(WSP(bf16, WS_Q) + (size_t)tok0 * 512 + hq * 64), (const attn_body::bf16*)(WSP(bf16, WS_KB) + kvo), (const attn_body::bf16*)(WSP(bf16, WS_VB) + kvo), (attn_body::bf16*)(WSP(bf16, WS_Q) + (size_t)tok0 * 512 + hq * 64), NT, shiftM, (char*)lds);
    }
#endif
    GRID_SYNC();
    RUN_CHECKS(2);

#if PROBE == 1
    {
        LOAD_ARGS();
        const long gtid = (long)bx * 512 + tid, nthr = (long)G * 512;
        for (long id = gtid; id < (long)NTOK * 128; id += nthr) { const long t = id >> 7; const int c = (int)(id & 127) * 8;
            const bf16* src = c < 512 ? WSP(bf16, WS_F) + t * 512 + c : WSP(bf16, WS_Q) + t * 512 + (c - 512);
            const v4u w = *(const v4u*)src; float* o = AOUT() + t * 1024 + c;
            o[0] = __uint_as_float(w.x << 16); o[1] = __uint_as_float(w.x & 0xffff0000u); o[2] = __uint_as_float(w.y << 16); o[3] = __uint_as_float(w.y & 0xffff0000u);
            o[4] = __uint_as_float(w.z << 16); o[5] = __uint_as_float(w.z & 0xffff0000u); o[6] = __uint_as_float(w.w << 16); o[7] = __uint_as_float(w.w & 0xffff0000u); }
        return;
    }
#endif
#if (PHM>>5)&1
    { LOAD_ARGS();
        pg8::StaticOrder S; S.init(NTOK, 1024, G, bx);
        { pg8::Gemm g{WSP(bf16, WS_Q), WSP(bf16, WS_WA), NTOK, 1024, 512}; pg8::EpiMerge<0> E; E.GA = WSP(bf16, WS_GA); E.MG = WSP(bf16, WS_MG);
          pg8::gemm_phase<pg8::EpiMerge<0>, pg8::StaticOrder, PG_ALIGN, PG_SP2>(L3, g, S, E); }
        { pg8::Gemm g{WSP(bf16, WS_F), WSP(bf16, WS_WF), NTOK, 1024, 512}; pg8::EpiMerge<1> E; E.GA = WSP(bf16, WS_GA); E.MG = WSP(bf16, WS_MG);
          pg8::gemm_phase<pg8::EpiMerge<1>, pg8::StaticOrder, PG_ALIGN, PG_SP2>(L3, g, S, E); }
    }
    GRID_SYNC();
    RUN_CHECKS(3);
#endif
#if PROBE == 4
    {
        LOAD_ARGS();
        const int gw = bx * 8 + wave, NGW = G * 8;
        for (int m = gw; m < NTOK; m += NGW) { const bf16* gr = WSP(bf16, WS_GA) + (size_t)m * 2048;
            const v4u a = *(const v4u*)(gr + lane * 8), b = *(const v4u*)(gr + 1024 + lane * 8);
            asm volatile("s_waitcnt vmcnt(0)" ::: "memory");
            float* o = AOUT() + (size_t)m * 1024 + lane * 8;
            o[0] = __uint_as_float(a.x << 16); o[1] = __uint_as_float(a.x & 0xffff0000u); o[2] = __uint_as_float(a.y << 16); o[3] = __uint_as_float(a.y & 0xffff0000u);
            o[4] = __uint_as_float(a.z << 16); o[5] = __uint_as_float(a.z & 0xffff0000u); o[6] = __uint_as_float(a.w << 16); o[7] = __uint_as_float(a.w & 0xffff0000u);
            o += 512;
            o[0] = __uint_as_float(b.x << 16); o[1] = __uint_as_float(b.x & 0xffff0000u); o[2] = __uint_as_float(b.y << 16); o[3] = __uint_as_float(b.y & 0xffff0000u);
            o[4] = __uint_as_float(b.z << 16); o[5] = __uint_as_float(b.z & 0xffff0000u); o[6] = __uint_as_float(b.w << 16); o[7] = __uint_as_float(b.w & 0xffff0000u); }
        return;
    }
#endif
#if PROBE == 3
    {
        LOAD_ARGS();
        const long gtid = (long)bx * 512 + tid, nthr = (long)G * 512;
        for (long id = gtid; id < (long)NTOK * 128; id += nthr) { const long t = id >> 7; const int c = (int)(id & 127) * 8;
            const v4u w = *(const v4u*)(WSP(bf16, WS_MG) + t * 1024 + c); float* o = AOUT() + t * 1024 + c;
            o[0] = __uint_as_float(w.x << 16); o[1] = __uint_as_float(w.x & 0xffff0000u); o[2] = __uint_as_float(w.y << 16); o[3] = __uint_as_float(w.y & 0xffff0000u);
            o[4] = __uint_as_float(w.z << 16); o[5] = __uint_as_float(w.z & 0xffff0000u); o[6] = __uint_as_float(w.w << 16); o[7] = __uint_as_float(w.w & 0xffff0000u); }
        return;
    }
#endif
#if (PHM>>6)&1
    { LOAD_ARGS();
        pg8::Gemm g{WSP(bf16, WS_MG), WSP(bf16, WS_WO), NTOK, 1024, 1024}; pg8::StaticOrder S; S.init(NTOK, 1024, G, bx);
        pg8::EpiX1 E; E.xp = AIN(0); E.xs = AIN(1); E.out = AOUT(); E.X1B = WSP(bf16, WS_X1B); E.ss1 = WSP(float, WS_SS1);
        pg8::gemm_phase<pg8::EpiX1, pg8::StaticOrder, PG_ALIGN, PG_SP2>(L3, g, S, E);
    }
#endif
    GRID_SYNC();
    RUN_CHECKS(4);
#if PROBE == 2
    return;
#endif
#if (PHM>>7)&1
    { LOAD_ARGS();
        pg8::Gemm g{WSP(bf16, WS_X1B), WSP(bf16, WS_WFFN), NTOK, 5632, 1024}; pg8::StaticOrder S; S.init(NTOK, 5632, G, bx);
        pg8::EpiF1 E; E.ss1 = WSP(float, WS_SS1); E.U = WSP(bf16, WS_U);
        pg8::gemm_phase<pg8::EpiF1, pg8::StaticOrder, PG_ALIGN, PG_SP2>(L3, g, S, E);
    }
#endif
    GRID_SYNC();
    RUN_CHECKS(5);
#if (PHM>>8)&1
    { LOAD_ARGS();
        pg8::Gemm g{WSP(bf16, WS_U), WSP(bf16, WS_WDN), NTOK, 1024, 2816}; pg8::StaticOrder S; S.init(NTOK, 1024, G, bx);
        pg8::EpiF2 E; E.out = AOUT(); E.ss2 = WSP(float, WS_SS2);
        pg8::gemm_phase<pg8::EpiF2, pg8::StaticOrder, PG_ALIGN, PG_SP2>(L3, g, S, E);
    }
#endif
    GRID_SYNC();
    RUN_CHECKS(6);
    { LOAD_ARGS();
        const int gw = bx * 8 + wave, NGW = G * 8; const f32x4* gf = (const f32x4*)AIN(13) + lane;
        for (int m = gw; m < NTOK; m += NGW) { f32x4* o = (f32x4*)(AOUT() + (size_t)m * 1024) + lane; const float rs = rsqrtf(__hip_atomic_load(WSP(float, WS_SS2) + m, __ATOMIC_RELAXED, __HIP_MEMORY_SCOPE_AGENT) * (1.f / 1024.f) + EPS);
#pragma unroll
            for (int j = 0; j < 4; ++j) o[64 * j] = o[64 * j] * rs * gf[64 * j]; }
    }
#if TSTAMP
    { asm volatile("s_waitcnt vmcnt(0)" ::: "memory"); grid.sync(); LOAD_ARGS(); const unsigned long long tend = __builtin_amdgcn_s_memrealtime();
      if (bx == 0 && tid == 0) { const unsigned long long a_ = ts_[TS_A], b_ = (TS_B == 8) ? tend : ts_[TS_B]; AOUT()[0] = 1000.0f * (float)(b_ - a_) * 0.01f; } }
#endif
#if CHECKS
    { asm volatile("s_waitcnt vmcnt(0)" ::: "memory"); grid.sync(); LOAD_ARGS(); if (bx == 0 && tid == 0) { for (int st = 0; st < 7; ++st) { const unsigned v = __hip_atomic_load(WSP(unsigned, WS_CTL) + 200 + st, __ATOMIC_RELAXED, __HIP_MEMORY_SCOPE_AGENT);
        if (v) { AOUT()[0] = (float)st * 1e7f + 1e6f + 8e6f * (float)v / 131072.0f; break; } } } }
#endif
}

extern "C" void kernel_launch(void* const* d_in, const int* in_sizes, int n_in, void* d_out, int out_size, void* d_ws, size_t ws_size, hipStream_t stream) {
    static int grid = 0;
    if (grid == 0) {
        if (n_in != 14 || out_size != NTOK * 1024 || ws_size < WS_END) { fprintf(stderr, "kernel_launch: unexpected shapes: n_in %d out %d ws %zu (need %zu)\n", n_in, out_size, ws_size, (size_t)WS_END); grid = -1; return; }
        int dev = 0, cus = 0, per_cu = 0;
        hipGetDevice(&dev); hipDeviceGetAttribute(&cus, hipDeviceAttributeMultiprocessorCount, dev);
        if (hipFuncSetAttribute((const void*)enc_fwd, hipFuncAttributeMaxDynamicSharedMemorySize, LDS_BYTES) != hipSuccess) { fprintf(stderr, "kernel_launch: hipFuncSetAttribute failed\n"); grid = -1; return; }
        if (hipOccupancyMaxActiveBlocksPerMultiprocessor(&per_cu, (const void*)enc_fwd, 512, LDS_BYTES) != hipSuccess || per_cu < 1) { fprintf(stderr, "kernel_launch: occupancy query says %d\n", per_cu); per_cu = 1; }
        (void)hipGetLastError();
        grid = cus * per_cu;
    }
    if (grid < 0) return;
    hipMemsetAsync((char*)d_ws + WS_CTL, 0, CTL_BYTES, stream);
    Args a{};
    for (int i = 0; i < 14; ++i) a.in[i] = (const float*)d_in[i];
    a.out = (float*)d_out; a.ws = (unsigned char*)d_ws;
    void* kargs[] = {&a};
    hipError_t e = hipLaunchCooperativeKernel((const void*)enc_fwd, dim3(grid), dim3(512), kargs, LDS_BYTES, stream);
    if (e != hipSuccess) fprintf(stderr, "cooperative launch failed: %s (grid %d)\n", hipGetErrorString(e), grid);
}
```

```cpp
#include <hip/hip_runtime.h>
#include <hip/hip_cooperative_groups.h>
#include <cstdio>
#include <cstdint>
namespace cg = cooperative_groups;
#ifndef PHM
#define PHM 0x1ff
#endif
#ifndef PROBE
#define PROBE 0
#endif
#ifndef PG_ALIGN
#define PG_ALIGN true
#endif
#ifndef PG_SP2
#define PG_SP2 true
#endif
#ifndef CHECKS
#define CHECKS 0
#endif
#ifndef TSTAMP
#define TSTAMP 0
#endif
#ifndef TS_A
#define TS_A 0
#endif
#ifndef TS_B
#define TS_B 1
#endif
namespace pg8 {
#define PG8_LAS __attribute__((address_space(3)))
typedef unsigned short bf16_t;
typedef short bf16x8 __attribute__((ext_vector_type(8)));
typedef float f32x4 __attribute__((ext_vector_type(4)));
typedef unsigned u32x4 __attribute__((ext_vector_type(4)));
constexpr int BM = 256, BK = 64, HALF = 128, HTB = HALF * BK * 2  , STAGE_BYTES = 8 * HTB, NXCD = 8, WGM = 8;

__host__ __device__ __forceinline__ int lds_byte(int r, int c) { const int st = (r >> 4) * 2 + (c >> 5), rr = r & 15, cc = c & 31, ob = rr * 64 + cc * 2; return st * 1024 + (ob ^ (((ob >> 9) & 1) << 5)); }
__host__ __device__ __forceinline__ void stage_rc(int b, int& R, int& C) { const int st = b / 1024, sb = b % 1024, swz = sb ^ (((sb >> 9) & 1) << 5); R = (st >> 1) * 16 + swz / 64; C = (st & 1) * 32 + (swz % 64) / 2; }
__host__ __device__ __forceinline__ int perm32(int rho) { const int n = rho >> 4, i = rho & 15; return 8 * (i >> 2) + 4 * n + (i & 3); }

struct Unit { int pm, pn; };
struct Gemm { const bf16_t* A; const bf16_t* Bt; int M, N, K; };

struct StaticOrder {
    int nM, nN, nwg, G, c;
    __host__ __device__ void init(int M, int N, int G_, int c_) { nM = M / BM; nN = N / BM; nwg = nM * nN; G = G_; c = c_; }
    __host__ __device__ bool next(int i, Unit& u) const {
        const long L = (long)i * G + c; if (L >= nwg) return false;
        int wgid = (int)L; { const int q = nwg / NXCD, r = nwg % NXCD, xcd = wgid % NXCD, off = wgid / NXCD; wgid = (xcd < r ? xcd * (q + 1) : r * (q + 1) + (xcd - r) * q) + off; }
        const int nig = WGM * nN, gid = wgid / nig, fm = gid * WGM, gsz = (nM - fm) < WGM ? (nM - fm) : WGM;
        u.pm = fm + ((wgid % nig) % gsz); u.pn = (wgid % nig) / gsz; return true;
    }
    __device__ __forceinline__ void a_ready(const Unit&) const {}
    __device__ __forceinline__ void done(const Unit&) const {}
};

typedef float f32x2c_t __attribute__((ext_vector_type(2))); typedef __bf16 bf16x2c_t __attribute__((ext_vector_type(2)));
__device__ __forceinline__ unsigned cvt_pk_bf16(float lo, float hi) { f32x2c_t v = {lo, hi}; bf16x2c_t b = __builtin_convertvector(v, bf16x2c_t); return __builtin_bit_cast(unsigned, b); }
typedef float f32x2 __attribute__((ext_vector_type(2)));
template <class Epi, class Sched, bool ALIGN_EPI = false, bool SP2 = false>
__device__ __forceinline__ void gemm_phase(PG8_LAS unsigned char* lds, const Gemm g, const Sched& S, const Epi& E) {
    int tid_ = threadIdx.x; asm volatile("" : "+v"(tid_));
    const int tid = tid_, wid = __builtin_amdgcn_readfirstlane(tid >> 6), lane = tid & 63, wr = wid >> 2, wc = wid & 3, fr = lane & 15, fq = lane >> 4;
    const int K = g.K, nt = K / BK;
    unsigned voffA[2], voffB[2];
#pragma unroll
    for (int i = 0; i < 2; ++i) { int R, C; stage_rc(tid * 16 + i * 8192, R, C); const int Rb = Epi::PERM ? ((R & ~31) + perm32(R & 31)) : R;
        voffA[i] = (unsigned)(R * K + C) * 2u; voffB[i] = (unsigned)(Epi::brow(Rb) * K + C) * 2u; }
    const size_t kstep = (size_t)(BK * 2);
    const size_t hstep = (size_t)HALF * K * 2;
    const size_t tstep = 2 * hstep;
    const unsigned ldsw = (unsigned)wid * 1024u;
    const int aoff = lds_byte(wr * 64 + fr, fq * 8), boff = lds_byte(wc * 32 + fr, fq * 8);
#define PG8_SA(b, h) (((b) * 2 + (h)) * HTB)
#define PG8_SB(b, h) ((4 + (b) * 2 + (h)) * HTB)
#define PG8_STAGE(bufoff, gbase, voff) do { _Pragma("unroll") for (int _i = 0; _i < 2; ++_i) \
        __builtin_amdgcn_global_load_lds((const unsigned*)((const char*)(gbase) + (voff)[_i]), (PG8_LAS unsigned*)(lds + (bufoff) + ldsw + _i * 8192), 16, 0, 0); } while (0)
#define PG8_LDA(dst, b, h) do { _Pragma("unroll") for (int m = 0; m < 4; ++m) _Pragma("unroll") for (int k = 0; k < 2; ++k) dst[m][k] = *(const PG8_LAS bf16x8*)(lds + PG8_SA(b, h) + aoff + m * 2048 + k * 1024); } while (0)
#define PG8_LDB(dst, b, h) do { _Pragma("unroll") for (int n = 0; n < 2; ++n) _Pragma("unroll") for (int k = 0; k < 2; ++k) dst[n][k] = *(const PG8_LAS bf16x8*)(lds + PG8_SB(b, h) + boff + n * 2048 + k * 1024); } while (0)
#define PG8_MMA(ai, bj, At, Bt) do { __builtin_amdgcn_s_setprio(1); _Pragma("unroll") for (int m = 0; m < 4; ++m) _Pragma("unroll") for (int n = 0; n < 2; ++n) _Pragma("unroll") for (int k = 0; k < 2; ++k) \
        acc[ai][bj][m][n] = __builtin_amdgcn_mfma_f32_16x16x32_bf16(Bt[n][k], At[m][k], acc[ai][bj][m][n], 0, 0, 0); __builtin_amdgcn_s_setprio(0); } while (0)
#define PG8_WAIT_V(n) asm volatile("s_waitcnt vmcnt(" #n ")" ::: "memory")
#define PG8_WAIT_L(n) asm volatile("s_waitcnt lgkmcnt(" #n ")" ::: "memory")
#define PG8_BAR __builtin_amdgcn_s_barrier()
#define PG8_SCHED __builtin_amdgcn_sched_barrier(0)
    Unit cur, nxt; int ui = 0;
    if (!S.next(0, cur)) return;
    f32x4 acc[2][2][4][2];
#pragma unroll
    for (int a = 0; a < 2; ++a)
#pragma unroll
        for (int b = 0; b < 2; ++b)
#pragma unroll
            for (int m = 0; m < 4; ++m)
#pragma unroll
                for (int n = 0; n < 2; ++n) acc[a][b][m][n] = (f32x4){0.f, 0.f, 0.f, 0.f};
    bf16x8 At[4][2], B0[2][2], B1[2][2];
    const char* cA = (const char*)g.A + (size_t)cur.pm * tstep; const char* cB = (const char*)g.Bt + (size_t)cur.pn * tstep;
    S.a_ready(cur);
    if constexpr (SP2) {
        PG8_STAGE(PG8_SB(0, 0), cB, voffB); PG8_STAGE(PG8_SB(0, 1), cB + hstep, voffB); PG8_STAGE(PG8_SA(0, 0), cA, voffA); PG8_STAGE(PG8_SA(0, 1), cA + hstep, voffA);
        if (wr == 1) PG8_BAR;
        PG8_WAIT_V(2); PG8_BAR;
        PG8_STAGE(PG8_SB(1, 0), cB + kstep, voffB); PG8_STAGE(PG8_SA(1, 0), cA + kstep, voffA); PG8_STAGE(PG8_SB(1, 1), cB + hstep + kstep, voffB);
        PG8_WAIT_V(6); PG8_BAR;
    } else {
        PG8_STAGE(PG8_SB(0, 0), cB, voffB); PG8_STAGE(PG8_SA(0, 0), cA, voffA); PG8_STAGE(PG8_SB(0, 1), cB + hstep, voffB); PG8_STAGE(PG8_SA(0, 1), cA + hstep, voffA);
        if (wr == 1) PG8_BAR;
        PG8_WAIT_V(4); PG8_BAR;
        PG8_STAGE(PG8_SB(1, 0), cB + kstep, voffB); PG8_STAGE(PG8_SA(1, 0), cA + kstep, voffA); PG8_STAGE(PG8_SB(1, 1), cB + hstep + kstep, voffB);
        PG8_WAIT_V(6); PG8_BAR;
    }
    for (;;) {
        const bool has_next = S.next(ui + 1, nxt);
        const char* nA = has_next ? (const char*)g.A + (size_t)nxt.pm * tstep : cA; const char* nB = has_next ? (const char*)g.Bt + (size_t)nxt.pn * tstep : cB;
        for (int t = 0; t < nt; t += 2) {
            const bool last = (t == nt - 2);
            const char* a1 = cA + (size_t)(t + 1) * kstep;
            const char* a2 = last ? nA : cA + (size_t)(t + 2) * kstep; const char* b2 = last ? nB : cB + (size_t)(t + 2) * kstep;
            const char* a3 = a2 + kstep; const char* b3 = b2 + kstep;
            if (last && has_next) S.a_ready(nxt);
            if constexpr (SP2) {
            PG8_LDB(B0, 0, 0); PG8_LDB(B1, 0, 1); PG8_SCHED; PG8_LDA(At, 0, 0); PG8_STAGE(PG8_SA(1, 1), a1 + hstep, voffA);
            PG8_WAIT_V(8); PG8_WAIT_L(0); PG8_BAR; PG8_MMA(0, 0, At, B0); PG8_MMA(0, 1, At, B1); PG8_BAR; PG8_SCHED;
            PG8_LDA(At, 0, 1); PG8_STAGE(PG8_SB(0, 0), b2, voffB); PG8_STAGE(PG8_SB(0, 1), b2 + hstep, voffB); PG8_STAGE(PG8_SA(0, 0), a2, voffA);
            PG8_WAIT_V(8); PG8_WAIT_L(0); PG8_BAR; PG8_MMA(1, 0, At, B0); PG8_MMA(1, 1, At, B1); PG8_BAR; PG8_SCHED;
            PG8_LDB(B0, 1, 0); PG8_LDB(B1, 1, 1); PG8_SCHED; PG8_LDA(At, 1, 0); PG8_STAGE(PG8_SA(0, 1), a2 + hstep, voffA);
            PG8_WAIT_V(8); PG8_WAIT_L(0); PG8_BAR; PG8_MMA(0, 0, At, B0); PG8_MMA(0, 1, At, B1); PG8_BAR; PG8_SCHED;
            PG8_LDA(At, 1, 1); PG8_STAGE(PG8_SB(1, 0), b3, voffB); PG8_STAGE(PG8_SB(1, 1), b3 + hstep, voffB); PG8_STAGE(PG8_SA(1, 0), a3, voffA);
            PG8_WAIT_V(8); PG8_WAIT_L(0); PG8_BAR; PG8_MMA(1, 0, At, B0); PG8_MMA(1, 1, At, B1); PG8_BAR; PG8_SCHED;
            } else {
            PG8_LDB(B0, 0, 0); PG8_SCHED; PG8_LDA(At, 0, 0); PG8_STAGE(PG8_SA(1, 1), a1 + hstep, voffA);
            PG8_WAIT_L(8); PG8_BAR; PG8_WAIT_L(0); PG8_MMA(0, 0, At, B0); PG8_BAR; PG8_SCHED;
            PG8_LDB(B1, 0, 1); PG8_STAGE(PG8_SB(0, 0), b2, voffB);
            PG8_BAR; PG8_WAIT_L(0); PG8_MMA(0, 1, At, B1); PG8_BAR;
            PG8_LDA(At, 0, 1); PG8_STAGE(PG8_SA(0, 0), a2, voffA);
            PG8_BAR; PG8_WAIT_L(0); PG8_MMA(1, 0, At, B0); PG8_BAR; PG8_SCHED;
            PG8_STAGE(PG8_SB(0, 1), b2 + hstep, voffB);
            PG8_WAIT_V(6); PG8_BAR; PG8_MMA(1, 1, At, B1); PG8_BAR;
            PG8_LDB(B0, 1, 0); PG8_SCHED; PG8_LDA(At, 1, 0); PG8_STAGE(PG8_SA(0, 1), a2 + hstep, voffA);
            PG8_WAIT_L(8); PG8_BAR; PG8_WAIT_L(0); PG8_MMA(0, 0, At, B0); PG8_BAR; PG8_SCHED;
            PG8_LDB(B1, 1, 1); PG8_STAGE(PG8_SB(1, 0), b3, voffB);
            PG8_BAR; PG8_WAIT_L(0); PG8_MMA(0, 1, At, B1); PG8_BAR;
            PG8_LDA(At, 1, 1); PG8_STAGE(PG8_SA(1, 0), a3, voffA);
            PG8_BAR; PG8_WAIT_L(0); PG8_MMA(1, 0, At, B0); PG8_BAR; PG8_SCHED;
            PG8_STAGE(PG8_SB(1, 1), b3 + hstep, voffB);
            PG8_WAIT_V(6); PG8_BAR; PG8_MMA(1, 1, At, B1); PG8_BAR;
            }
        }
        if constexpr (ALIGN_EPI) { if (wr == 0) PG8_BAR; }
        if constexpr (!Epi::AFTER_DRAIN) { E(acc, cur, wr, wc, fr, fq); S.done(cur); }
        if (!has_next) break;
#pragma unroll
        for (int a = 0; a < 2; ++a)
#pragma unroll
            for (int b = 0; b < 2; ++b)
#pragma unroll
                for (int m = 0; m < 4; ++m)
#pragma unroll
                    for (int n = 0; n < 2; ++n) acc[a][b][m][n] = (f32x4){0.f, 0.f, 0.f, 0.f};
        cur = nxt; cA = nA; cB = nB; ++ui;
        if constexpr (ALIGN_EPI) { if (wr == 1) PG8_BAR; }
    }
    PG8_WAIT_V(0);
    if constexpr (!ALIGN_EPI) { if (wr == 0) PG8_BAR; }
    PG8_BAR;
    if constexpr (Epi::AFTER_DRAIN) { E.fused(acc, cur, wr, wc, fr, fq, lds, wid, lane); S.done(cur); }
#undef PG8_SA
#undef PG8_SB
#undef PG8_STAGE
#undef PG8_LDA
#undef PG8_LDB
#undef PG8_MMA
#undef PG8_WAIT_V
#undef PG8_WAIT_L
#undef PG8_BAR
#undef PG8_SCHED
}
}
constexpr int NTOK = 98304;
constexpr int NMT = NTOK / 256;
constexpr int P_TOK = 32768;
constexpr int LP = 2064, LS = 8208;
constexpr int KPP = 2176, KPS = 8320;
constexpr int MTP = 5, MTS = 17;
constexpr int K2P = 1152, K2S = 4224;
constexpr size_t KV_S_OFF = (size_t)16 * 2 * KPP * 64;
constexpr float EPS = 1e-6f;
constexpr float QC2 = 0.125f * 1.4426950408889634f;

namespace pg8 {
__device__ __forceinline__ u32x4 pack8(f32x4 a, f32x4 b) { u32x4 w; w.x = cvt_pk_bf16(a[0], a[1]); w.y = cvt_pk_bf16(a[2], a[3]); w.z = cvt_pk_bf16(b[0], b[1]); w.w = cvt_pk_bf16(b[2], b[3]); return w; }
__device__ __forceinline__ void unpack8(u32x4 w, f32x4& a, f32x4& b) {
    a[0] = __uint_as_float(w.x << 16); a[1] = __uint_as_float(w.x & 0xffff0000u); a[2] = __uint_as_float(w.y << 16); a[3] = __uint_as_float(w.y & 0xffff0000u);
    b[0] = __uint_as_float(w.z << 16); b[1] = __uint_as_float(w.z & 0xffff0000u); b[2] = __uint_as_float(w.w << 16); b[3] = __uint_as_float(w.w & 0xffff0000u); }
__device__ __forceinline__ float sigm(float x) { return __builtin_amdgcn_rcpf(1.0f + __expf(-x)); }
__device__ __forceinline__ float dot4(f32x4 a) { return (a[0] * a[0] + a[1] * a[1]) + (a[2] * a[2] + a[3] * a[3]); }
__device__ __forceinline__ size_t kvoff(int seq, int kvh) { return seq < 16 ? (size_t)(seq * 2 + kvh) * KPP * 64 : KV_S_OFF + (size_t)((seq - 16) * 2 + kvh) * KPS * 64; }
__device__ __forceinline__ int seqlen(int seq) { return seq < 16 ? 2048 : 8192; }

struct EpiBase { static constexpr bool PERM = true, AFTER_DRAIN = false; static __host__ __device__ __forceinline__ int brow(int R) { return R; } };

struct G1Order {
    StaticOrder so; int nwg, G, c;
    __device__ void init(int G_, int c_) { so.init(NTOK, 2816, G_, c_); nwg = so.nwg; G = G_; c = c_; }
    __device__ bool next(int i, Unit& u) const { if (so.next(i, u)) return true; if ((long)i * G + c == (long)nwg + 72) { u.pm = NMT; u.pn = 2; return true; } return false; }
    __device__ __forceinline__ void a_ready(const Unit&) const {}
    __device__ __forceinline__ void done(const Unit&) const {}
};
struct DftOrder {
    int G, c, total, sample;
    __device__ bool next(int i, Unit& u) const {
        const long idx = (long)i * G + c; if (idx >= total) return false; const int id = (int)idx;
        if (sample) { if (id < 256) { const int x = id & 7, slot = id >> 3; u.pm = 2 * x + (slot >> 4); u.pn = slot & 15; } else { u.pm = 16; u.pn = id - 256; } }
        else { u.pm = id >> 5; u.pn = id & 31; }
        return true; }
    __device__ __forceinline__ void a_ready(const Unit&) const {}
    __device__ __forceinline__ void done(const Unit&) const {}
};

struct EpiG1 : EpiBase {
    bf16_t *Q, *KB, *VB, *GA; const float *rope, *gq, *gk;
    __device__ __forceinline__ void qk_row(const f32x4& a00, const f32x4& a01, const f32x4& a10, const f32x4& a11, const f32x4 (&gv)[2][2], int prow, int pcol, int fq, float osc, u32x4 (&w)[2]) const {
        float ss = (dot4(a00) + dot4(a01)) + (dot4(a10) + dot4(a11));
        ss += __shfl_xor(ss, 16); ss += __shfl_xor(ss, 32);
        const float rs = rsqrtf(ss * (1.0f / 64.0f) + EPS) ;
        { const int pp = prow + 1; const f32x4 c = *(const f32x4*)(rope + pp * 32 + 4 * fq), s = *(const f32x4*)(rope + pp * 32 + 16 + 4 * fq);
          const f32x4 x1 = a00 * rs * gv[0][0], x2 = a01 * rs * gv[0][1]; w[0] = pack8((x1 * c - x2 * s) * osc, (x2 * c + x1 * s) * osc); }
        { const int pp = pcol + 1; const f32x4 c = *(const f32x4*)(rope + pp * 32 + 4 * fq), s = *(const f32x4*)(rope + pp * 32 + 16 + 4 * fq);
          const f32x4 x1 = a10 * rs * gv[1][0], x2 = a11 * rs * gv[1][1]; w[1] = pack8((x1 * c - x2 * s) * osc, (x2 * c + x1 * s) * osc); }
    }
    __device__ __forceinline__ void operator()(const f32x4 (&acc)[2][2][4][2], const Unit& u, int wr, int wc, int fr, int fq) const {
        asm volatile("" : "+v"(fr), "+v"(fq));
        const int pm = u.pm, pn = u.pn;
        if (pm == NMT) {
            if (pn != 2 || wr != 0) return;
            u32x4 w[2]; bf16_t* base;
            if (wc < 2) { f32x4 gv[2][2];
#pragma unroll
                for (int bj = 0; bj < 2; ++bj)
#pragma unroll
                    for (int n = 0; n < 2; ++n) gv[bj][n] = *(const f32x4*)(gk + 32 * bj + 16 * n + 4 * fq);
                qk_row(acc[0][0][0][0], acc[0][0][0][1], acc[0][1][0][0], acc[0][1][0][1], gv, -1, fr, fq, 1.0f, w); base = KB; }
            else { w[0] = pack8(acc[0][0][0][0], acc[0][0][0][1]); w[1] = pack8(acc[0][1][0][0], acc[0][1][0][1]); base = VB; }
            const int kvh = wc & 1;
#pragma unroll 1
            for (int s = 0; s < 24; ++s) { bf16_t* d = base + kvoff(s, kvh) + (size_t)(seqlen(s) + fr) * 64 + 8 * fq; *(u32x4*)d = w[0]; *(u32x4*)(d + 32) = w[1]; }
            return;
        }
        if (pn >= 3) {
            const int col0 = (pn - 3) * 256 + wc * 32 + 8 * fq;
#pragma unroll
            for (int ai = 0; ai < 2; ++ai)
#pragma unroll
                for (int m = 0; m < 4; ++m) { bf16_t* rp = GA + (size_t)(pm * 256 + ai * 128 + wr * 64 + m * 16 + fr) * 2048 + col0;
#pragma unroll
                    for (int bj = 0; bj < 2; ++bj) { f32x4 v0 = acc[ai][bj][m][0], v1 = acc[ai][bj][m][1];
#pragma unroll
                        for (int j = 0; j < 4; ++j) { v0[j] = sigm(v0[j]); v1[j] = sigm(v1[j]); }
                        *(u32x4*)(rp + bj * 128) = pack8(v0, v1); } }
            return;
        }
        const int t0 = pm * 256; int seq, p0;
        if (t0 < P_TOK) { seq = t0 >> 11; p0 = t0 & 2047; } else { const int ts = t0 - P_TOK; seq = 16 + (ts >> 13); p0 = ts & 8191; }
        const bool isq = pn < 2;
        if (!isq && wc >= 2) {
            bf16_t* vb = VB + kvoff(seq, wc - 2) + (size_t)p0 * 64 + 8 * fq;
#pragma unroll
            for (int ai = 0; ai < 2; ++ai)
#pragma unroll
                for (int m = 0; m < 4; ++m) { const int rloc = ai * 128 + wr * 64 + m * 16 + fr;
#pragma unroll
                    for (int bj = 0; bj < 2; ++bj) *(u32x4*)(vb + (size_t)rloc * 64 + 32 * bj) = pack8(acc[ai][bj][m][0], acc[ai][bj][m][1]); }
            return;
        }
        const float* g = isq ? gq : gk; const float osc = isq ? QC2 : 1.0f;
        bf16_t* ob = isq ? Q + (size_t)t0 * 512 + (4 * pn + wc) * 64 + 8 * fq : KB + kvoff(seq, wc) + (size_t)p0 * 64 + 8 * fq; const int opitch = isq ? 512 : 64;
        f32x4 gv[2][2];
#pragma unroll
        for (int bj = 0; bj < 2; ++bj)
#pragma unroll
            for (int n = 0; n < 2; ++n) gv[bj][n] = *(const f32x4*)(g + 32 * bj + 16 * n + 4 * fq);
#pragma unroll
        for (int ai = 0; ai < 2; ++ai)
#pragma unroll
            for (int m = 0; m < 4; ++m) { const int rloc = ai * 128 + wr * 64 + m * 16 + fr; const int p = p0 + rloc;
                u32x4 w[2]; qk_row(acc[ai][0][m][0], acc[ai][0][m][1], acc[ai][1][m][0], acc[ai][1][m][1], gv, p >> 6, p & 63, fq, osc, w);
                bf16_t* d = ob + (size_t)rloc * opitch; *(u32x4*)d = w[0]; *(u32x4*)(d + 32) = w[1];
                asm volatile("" ::: "memory"); }
    }
};
struct EpiGT : EpiBase {
    bf16_t *GTp, *GTs;
    __device__ __forceinline__ bf16_t* dst(int seq, int ch) const { return seq < 16 ? GTp + ((size_t)seq * 512 + ch) * KPP : GTs + ((size_t)(seq - 16) * 512 + ch) * KPS; }
    __device__ __forceinline__ void operator()(const f32x4 (&acc)[2][2][4][2], const Unit& u, int wr, int wc, int fr, int fq) const {
        asm volatile("" : "+v"(fr), "+v"(fq));
        const bool meta = (u.pn == NMT);
        const int t0 = u.pn * 256; int seq, p0;
        if (t0 < P_TOK) { seq = t0 >> 11; p0 = t0 & 2047; } else { const int ts = t0 - P_TOK; seq = 16 + (ts >> 13); p0 = ts & 8191; }
#pragma unroll
        for (int ai = 0; ai < 2; ++ai)
#pragma unroll
            for (int m = 0; m < 4; ++m) { const int ch = u.pm * 256 + ai * 128 + wr * 64 + m * 16 + fr;
#pragma unroll
                for (int bj = 0; bj < 2; ++bj) { const u32x4 w = pack8(acc[ai][bj][m][0], acc[ai][bj][m][1]);
                    if (!meta) *(u32x4*)(dst(seq, ch) + 64 + p0 + bj * 128 + wc * 32 + 8 * fq) = w;
                    else if (bj == 0 && wc < 2) { for (int s = 0; s < 24; ++s) *(u32x4*)(dst(s, ch) + wc * 32 + 8 * fq) = w; } } }
    }
};
struct EpiDftP : EpiBase {
    static __host__ __device__ __forceinline__ int brow(int R) { return R <= 64 ? R : 128 - R; }
    float* dump; int nMt;
    __device__ __forceinline__ void operator()(const f32x4 (&acc)[2][2][4][2], const Unit& u, int wr, int wc, int fr, int fq) const {
        asm volatile("" : "+v"(fr), "+v"(fq));
        int tx_ = threadIdx.x; asm volatile("" : "+v"(tx_)); f32x4* d = (f32x4*)dump + (size_t)(u.pn * nMt + u.pm) * 32 * 512 + tx_;
#pragma unroll
        for (int ai = 0; ai < 2; ++ai)
#pragma unroll
            for (int bj = 0; bj < 2; ++bj)
#pragma unroll
                for (int m = 0; m < 4; ++m)
#pragma unroll
                    for (int n = 0; n < 2; ++n) d[(size_t)(((ai * 2 + bj) * 4 + m) * 2 + n) * 512] = acc[ai][bj][m][n];
    }
};
struct EpiDftQ : EpiBase {
    static __host__ __device__ __forceinline__ int brow(int R) { return (R == 0 || R == 64) ? 0 : (R < 64 ? 64 + R : 192 - R); }
    const float* dump; int nMt; bf16_t* F; int L, tokbase, nseq; float scale;
    __device__ __forceinline__ void operator()(const f32x4 (&acc)[2][2][4][2], const Unit& u, int wr, int wc, int fr, int fq) const {
        asm volatile("" : "+v"(fr), "+v"(fq));
        int tx_ = threadIdx.x; asm volatile("" : "+v"(tx_)); const f32x4* d = (const f32x4*)dump + (size_t)(u.pn * nMt + u.pm) * 32 * 512 + tx_;
        const int b = u.pn >> 1, pnl = u.pn & 1, tb = tokbase + b * nseq - 16, L2 = L >> 1;
        const float sg = (wc < 2) ? scale : -scale; const bool z0 = (fq == 0) && ((wc & 1) == 0);
#pragma unroll
        for (int ai = 0; ai < 2; ++ai)
#pragma unroll
            for (int m = 0; m < 4; ++m) { const int lp = u.pm * 256 + ai * 128 + wr * 64 + m * 16 + fr;
#pragma unroll
                for (int bj = 0; bj < 2; ++bj) {
                    const f32x4 P0 = d[(size_t)(((ai * 2 + bj) * 4 + m) * 2 + 0) * 512] * scale, P1 = d[(size_t)(((ai * 2 + bj) * 4 + m) * 2 + 1) * 512] * scale;
                    f32x4 q0 = acc[ai][bj][m][0] * sg, q1 = acc[ai][bj][m][1] * sg; if (z0) q0[0] = 0.f;
                    const int col = (pnl * 2 + bj) * 128 + wc * 32 + 8 * fq;
                    if (lp >= 16 && lp <= L2) *(u32x4*)(F + (size_t)(tb + lp) * 512 + col) = pack8(P0 - q0, P1 - q1);
                    if (lp >= 1 && lp < L2) *(u32x4*)(F + (size_t)(tb + L - lp) * 512 + col) = pack8(P0 + q0, P1 + q1); } }
    }
};
template <int SECOND> struct EpiMerge : EpiBase {
    const bf16_t* GA; bf16_t* MG;
    __device__ __forceinline__ void operator()(const f32x4 (&acc)[2][2][4][2], const Unit& u, int wr, int wc, int fr, int fq) const {
        asm volatile("" : "+v"(fr), "+v"(fq));
        const int col0 = u.pn * 256 + wc * 32 + 8 * fq;
#pragma unroll
        for (int ai = 0; ai < 2; ++ai)
#pragma unroll
            for (int m = 0; m < 4; ++m) { const size_t t = (size_t)(u.pm * 256 + ai * 128 + wr * 64 + m * 16 + fr);
#pragma unroll
                for (int bj = 0; bj < 2; ++bj) { const int c = col0 + bj * 128;
                    f32x4 g0, g1; unpack8(*(const u32x4*)(GA + t * 2048 + SECOND * 1024 + c), g0, g1);
                    f32x4 o0 = g0 * acc[ai][bj][m][0], o1 = g1 * acc[ai][bj][m][1];
                    if (SECOND) { f32x4 p0, p1; unpack8(*(const u32x4*)(MG + t * 1024 + c), p0, p1); o0 += p0; o1 += p1; }
                    *(u32x4*)(MG + t * 1024 + c) = pack8(o0, o1); } }
    }
};
struct EpiX1 : EpiBase {
    const float *xp, *xs; bf16_t* X1B; float* ss1;
    __device__ __forceinline__ void operator()(const f32x4 (&acc)[2][2][4][2], const Unit& u, int wr, int wc, int fr, int fq) const {
        asm volatile("" : "+v"(fr), "+v"(fq));
        const int col0 = u.pn * 256 + wc * 32 + 8 * fq;
#pragma unroll
        for (int ai = 0; ai < 2; ++ai)
#pragma unroll
            for (int m = 0; m < 4; ++m) { const int t = u.pm * 256 + ai * 128 + wr * 64 + m * 16 + fr;
                const float* xr = t < P_TOK ? xp + (size_t)t * 1024 : xs + (size_t)(t - P_TOK) * 1024; float part = 0.f;
#pragma unroll
                for (int bj = 0; bj < 2; ++bj) { const int c = col0 + bj * 128;
                    const f32x4 v0 = *(const f32x4*)(xr + c) + acc[ai][bj][m][0], v1 = *(const f32x4*)(xr + c + 4) + acc[ai][bj][m][1];
                    *(u32x4*)(X1B + (size_t)t * 1024 + c) = pack8(v0, v1); part += dot4(v0) + dot4(v1); }
                part += __shfl_xor(part, 16); part += __shfl_xor(part, 32);
                if (fq == 0) atomicAdd(ss1 + t, part); }
    }
};
struct EpiF1 : EpiBase {
    const float* ss1; bf16_t* U;
    __device__ __forceinline__ void operator()(const f32x4 (&acc)[2][2][4][2], const Unit& u, int wr, int wc, int fr, int fq) const {
        asm volatile("" : "+v"(fr), "+v"(fq));
        typedef unsigned u32x2 __attribute__((ext_vector_type(2)));
        const int col0 = u.pn * 128 + wc * 16 + 4 * fq;
#pragma unroll
        for (int ai = 0; ai < 2; ++ai)
#pragma unroll
            for (int m = 0; m < 4; ++m) { const int t = u.pm * 256 + ai * 128 + wr * 64 + m * 16 + fr;
                const float rs = rsqrtf(__hip_atomic_load(ss1 + t, __ATOMIC_RELAXED, __HIP_MEMORY_SCOPE_AGENT) * (1.0f / 1024.0f) + EPS);
#pragma unroll
                for (int bj = 0; bj < 2; ++bj) { const f32x4 gt = acc[ai][bj][m][0] * rs, up = acc[ai][bj][m][1] * rs; f32x4 o;
#pragma unroll
                    for (int j = 0; j < 4; ++j) o[j] = gt[j] * sigm(gt[j]) * up[j];
                    u32x2 w; w.x = cvt_pk_bf16(o[0], o[1]); w.y = cvt_pk_bf16(o[2], o[3]);
                    *(u32x2*)(U + (size_t)t * 2816 + col0 + bj * 64) = w; } }
    }
};
struct EpiF2 : EpiBase {
    bf16_t* XB; float* ss2;
    __device__ __forceinline__ void operator()(const f32x4 (&acc)[2][2][4][2], const Unit& u, int wr, int wc, int fr, int fq) const {
        asm volatile("" : "+v"(fr), "+v"(fq));
        const int col0 = u.pn * 256 + wc * 32 + 8 * fq;
#pragma unroll
        for (int ai = 0; ai < 2; ++ai)
#pragma unroll
            for (int m = 0; m < 4; ++m) { const int t = u.pm * 256 + ai * 128 + wr * 64 + m * 16 + fr; float part = 0.f;
#pragma unroll
                for (int bj = 0; bj < 2; ++bj) { bf16_t* o = XB + (size_t)t * 1024 + col0 + bj * 128; f32x4 x0, x1; unpack8(*(const u32x4*)o, x0, x1);
                    const f32x4 v0 = x0 + acc[ai][bj][m][0], v1 = x1 + acc[ai][bj][m][1];
                    *(u32x4*)o = pack8(v0, v1); part += dot4(v0) + dot4(v1); }
                part += __shfl_xor(part, 16); part += __shfl_xor(part, 32);
                if (fq == 0) atomicAdd(ss2 + t, part); }
    }
};
}
#include <hip/hip_bf16.h>
#include <cmath>
namespace attn_body {
using bf16=__hip_bfloat16;
using bf16x8=__attribute__((ext_vector_type(8)))short;
using s16x4=__attribute__((ext_vector_type(4)))short;
using f32x16=__attribute__((ext_vector_type(16)))float;
using u32x4=__attribute__((ext_vector_type(4)))unsigned;
constexpr int D=64,QP=512,KP=64;
constexpr int NW=8,QBLK=32,QB=QBLK*NW,KVBLK=64;

__device__ __forceinline__ int crow(int r,int hi){return (r&3)+8*(r>>2)+4*hi;}
#define SBAR() __builtin_amdgcn_sched_barrier(0)
__device__ __forceinline__ void kmask(f32x16&p0,f32x16&p1,bool full){
  const float NEG=-INFINITY;
  #pragma unroll
  for(int r=0;r<16;++r){ if(full||r>=8)p0[r]=NEG; p1[r]=NEG; }
}

constexpr int NSLOT=3, SLOTB=8192;
constexpr int LDS_K=0, LDS_V=NSLOT*SLOTB, LDS_WS=2*NSLOT*SLOTB, LDS_OST=LDS_WS+NW*64*4, LDS_BYTES=LDS_OST+NW*4096;
constexpr float C2=0.125f*1.4426950408889634f;
__device__ __forceinline__ void glds16(const void*gsrc,unsigned lds_dst){unsigned keep;
  asm volatile("s_mov_b32 %0, m0\n\ts_mov_b32 m0, %2\n\ts_nop 0\n\tglobal_load_lds_dwordx4 %1, off\n\ts_mov_b32 m0, %0":"=&s"(keep):"v"(gsrc),"s"(lds_dst):"memory");}
__device__ __forceinline__ float max3f(float a,float b,float c){float r;asm("v_max3_f32 %0, %1, %2, %3":"=v"(r):"v"(a),"v"(b),"v"(c));return r;}
__device__ __forceinline__ float max2f(float a,float b){float r;asm("v_max_f32_e32 %0, %1, %2":"=v"(r):"v"(a),"v"(b));return r;}
__device__ __forceinline__ float fadd_s(float a,float b){float r;asm("v_add_f32_e32 %0, %1, %2":"=v"(r):"v"(a),"v"(b));return r;}
__device__ __forceinline__ float fsub_s(float a,float b){float r;asm("v_sub_f32_e32 %0, %1, %2":"=v"(r):"v"(a),"v"(b));return r;}
typedef float f32x2_t __attribute__((ext_vector_type(2))); typedef __bf16 bf16x2_t __attribute__((ext_vector_type(2)));
__device__ __forceinline__ unsigned cvtpk_s(float lo,float hi){f32x2_t v={lo,hi};bf16x2_t b=__builtin_convertvector(v,bf16x2_t);return __builtin_bit_cast(unsigned,b);}
#define WAIT_BAR(N) asm volatile("s_waitcnt vmcnt(" #N ") lgkmcnt(0)\n\ts_barrier":::"memory")

__device__ __forceinline__ void qkt(f32x16&p0,f32x16&p1,const char*Kslot,const bf16x8*qr,const f32x16&negm,int r32,int hi){
  const char*kb=Kslot+hi*1024+r32*16;
  #pragma unroll
  for(int d0=0;d0<4;++d0){
    const bf16x8 b0=*reinterpret_cast<const bf16x8*>(kb+d0*2048);
    const bf16x8 b1=*reinterpret_cast<const bf16x8*>(kb+d0*2048+512);
    if(d0==0){p0=__builtin_amdgcn_mfma_f32_32x32x16_bf16(b0,qr[0],negm,0,0,0);p1=__builtin_amdgcn_mfma_f32_32x32x16_bf16(b1,qr[0],negm,0,0,0);}
    else{p0=__builtin_amdgcn_mfma_f32_32x32x16_bf16(b0,qr[d0],p0,0,0,0);p1=__builtin_amdgcn_mfma_f32_32x32x16_bf16(b1,qr[d0],p1,0,0,0);}}
}
typedef __attribute__((address_space(3))) const char* lds_cptr;
typedef short v4i16_t __attribute__((ext_vector_type(4)));
__device__ __forceinline__ void kload8(bf16x8*kf,lds_cptr kp){
  kf[0]=*(const __attribute__((address_space(3))) bf16x8*)(kp);      kf[1]=*(const __attribute__((address_space(3))) bf16x8*)(kp+512);
  kf[2]=*(const __attribute__((address_space(3))) bf16x8*)(kp+2048); kf[3]=*(const __attribute__((address_space(3))) bf16x8*)(kp+2560);
  kf[4]=*(const __attribute__((address_space(3))) bf16x8*)(kp+4096); kf[5]=*(const __attribute__((address_space(3))) bf16x8*)(kp+4608);
  kf[6]=*(const __attribute__((address_space(3))) bf16x8*)(kp+6144); kf[7]=*(const __attribute__((address_space(3))) bf16x8*)(kp+6656);
}
__device__ __forceinline__ void kload2(bf16x8*kf,lds_cptr kp,int j){ kf[2*j]=*(const __attribute__((address_space(3))) bf16x8*)(kp+j*2048); kf[2*j+1]=*(const __attribute__((address_space(3))) bf16x8*)(kp+j*2048+512); }
__device__ __forceinline__ s16x4 vtr(lds_cptr p){ return __builtin_bit_cast(s16x4,__builtin_amdgcn_ds_read_tr16_b64_v4i16((__attribute__((address_space(3))) v4i16_t*)p)); }
__device__ __forceinline__ float rowmax(const f32x16&p0,const f32x16&p1){
  float a=max3f(p0[0],p0[1],p1[0]),b=max3f(p0[2],p0[3],p1[1]);a=max3f(a,p1[2],p1[3]);
  #pragma unroll
  for(int r=4;r<16;r+=4){a=max3f(a,p0[r],p0[r+1]);b=max3f(b,p0[r+2],p0[r+3]);a=max3f(a,p1[r],p1[r+1]);b=max3f(b,p1[r+2],p1[r+3]);}
  const float m=max2f(a,b);
  auto rr=__builtin_amdgcn_permlane32_swap(__float_as_uint(m),__float_as_uint(m),false,false);
  return max2f(__uint_as_float(rr[0]),__uint_as_float(rr[1]));
}
__device__ __forceinline__ void pv(f32x16*o,int vb,bf16x8 pa0,bf16x8 pa1,bf16x8 pa2,bf16x8 pa3){
  #pragma unroll
  for(int d0=0;d0<2;++d0){s16x4 lo[4],hi[4];
    #pragma unroll
    for(int ks=0;ks<4;++ks){
      asm volatile("ds_read_b64_tr_b16 %0,%1 offset:%c2":"=&v"(lo[ks]):"v"(vb),"i"(d0*4096+ks*1024):"memory");
      asm volatile("ds_read_b64_tr_b16 %0,%1 offset:%c2":"=&v"(hi[ks]):"v"(vb),"i"(d0*4096+ks*1024+512):"memory");}
    asm volatile("s_waitcnt lgkmcnt(0)":::"memory");SBAR();
    #define PK(k) (bf16x8){lo[k][0],lo[k][1],lo[k][2],lo[k][3],hi[k][0],hi[k][1],hi[k][2],hi[k][3]}
    o[d0]=__builtin_amdgcn_mfma_f32_32x32x16_bf16(pa0,PK(0),o[d0],0,0,0);
    o[d0]=__builtin_amdgcn_mfma_f32_32x32x16_bf16(pa1,PK(1),o[d0],0,0,0);
    o[d0]=__builtin_amdgcn_mfma_f32_32x32x16_bf16(pa2,PK(2),o[d0],0,0,0);
    o[d0]=__builtin_amdgcn_mfma_f32_32x32x16_bf16(pa3,PK(3),o[d0],0,0,0);
    #undef PK
  }
}

#ifndef ATTN_STORE16
#define ATTN_STORE16(p,v) (*(u32x4*)(p)=(v))
#endif
template<int THRL> __device__ __forceinline__ void attn_unit(const bf16*Qblk,const bf16*__restrict__ Kh,const bf16*__restrict__ Vh,bf16*Oblk,const int NT,const float shiftM,char*shm){
  int tid_=threadIdx.x; asm volatile("":"+v"(tid_));
  const int tid=tid_,lane=tid&63,r32=lane&31,hi=lane>>5; const int wid=__builtin_amdgcn_readfirstlane(tid>>6);

  const bf16*Qw=Qblk+(long)(wid*QBLK)*QP;

  const unsigned lds0=(unsigned)(uintptr_t)shm;
  float*wsf=(float*)(shm+LDS_WS)+wid*64;
  const bf16*ksrc=Kh+(long)lane*KP+wid*8;
  const bf16*vsrc=Vh+(long)(16*(wid&3)+(lane>>2))*KP+(wid>>2)*32+(lane&3)*8;
  const unsigned kdst=lds0+LDS_K+wid*1024, vdst=lds0+LDS_V+wid*1024;
  #define DMA_K(t,slot) glds16(ksrc+(long)(t)*KVBLK*KP,(unsigned)__builtin_amdgcn_readfirstlane(kdst+(slot)))
  #define DMA_V(t,slot) glds16(vsrc+(long)(t)*KVBLK*KP,(unsigned)__builtin_amdgcn_readfirstlane(vdst+(slot)))
  const int vb0=(int)(lds0+LDS_V)+((lane>>4)&1)*32+(lane&3)*8+(4*hi+((lane&15)>>2))*64;
  const char*Kbase=shm+LDS_K; bf16x8 kf[8];
  const lds_cptr shm3=(lds_cptr)shm; const lds_cptr kp0=shm3+LDS_K+hi*1024+r32*16; const lds_cptr vp0=shm3+LDS_V+((lane>>4)&1)*32+(lane&3)*8+(4*hi+((lane&15)>>2))*64;
  DMA_K(0,0);DMA_V(0,0);DMA_K(1,SLOTB);
  bf16x8 qr[4];
  #pragma unroll
  for(int d0=0;d0<4;++d0)qr[d0]=*reinterpret_cast<const bf16x8*>(&Qw[(long)r32*QP+d0*16+hi*8]);
  float mhat=0.f,l_reg=0.f;f32x16 o[2];o[0]=f32x16{};o[1]=f32x16{};f32x16 negm; _Pragma("unroll") for(int r=0;r<16;++r)negm[r]=-shiftM; asm volatile("":"+v"(negm));
  const int qrel=wid*QBLK+r32;
  #define CMASK(P0,P1,t) do{}while(0)
  bool resc=false;
  #define START(P0,P1) do{ resc=false; \
    _Pragma("unroll") for(int r=0;r<16;++r)P0[r]=__builtin_amdgcn_exp2f(P0[r]); }while(0)
  #define RESC() do{ if(resc){ asm volatile("s_waitcnt lgkmcnt(0)":::"memory"); \
      _Pragma("unroll") for(int d_=0;d_<2;++d_) _Pragma("unroll") for(int r=0;r<16;++r)o[d_][r]*=wsf[crow(r,hi)]; } }while(0)
  f32x16 pA0,pA1,pB0,pB1;
  int sl_prev=0,sl_cur=0,sl_next=SLOTB;
  #define ROT() do{sl_prev=sl_cur;sl_cur=sl_next;sl_next=(sl_next==(NSLOT-1)*SLOTB)?0:sl_next+SLOTB;}while(0)
  DMA_K(2,2*SLOTB);
  WAIT_BAR(3);
  qkt(pA0,pA1,Kbase,qr,negm,r32,hi);asm volatile("s_nop 15\n\ts_nop 7":"+v"(pA0),"+v"(pA1));CMASK(pA0,pA1,0);
  START(pA0,pA1);
  _Pragma("unroll") for(int r=0;r<16;++r)pA1[r]=__builtin_amdgcn_exp2f(pA1[r]);
  WAIT_BAR(0);
  DMA_K(3,0);DMA_V(1,SLOTB);
  ROT();
  kload8(kf,kp0+sl_cur);
  WAIT_BAR(2);
  s16x4 vlo[8],vhi[8]; u32x4 pw0,pw1,pw2,pw3;
  #define PKW(P,B) cvtpk_s(P[B],P[B+1])
  #define PAF(k) __builtin_bit_cast(bf16x8,pw##k)
  #define VFR(i) (bf16x8){vlo[i][0],vlo[i][1],vlo[i][2],vlo[i][3],vhi[i][0],vhi[i][1],vhi[i][2],vhi[i][3]}
  #define PIN(x) asm volatile("":"+v"(x))
  #define MX3(a,b,c) __builtin_fmaxf(__builtin_fmaxf((a),(b)),(c))
  #define GAPA(MF,A0,A1,A2,A3,W0,W1,PW) do{ MF; sacc+=A0; sacc+=A1; sacc+=A2; sacc+=A3; PIN(sacc); W0; W1; PIN(PW); SBAR(); }while(0)
  #define EX(v) __builtin_amdgcn_exp2f(v)
  #define GAPB(MF,X,B) do{ MF; X[B]=EX(X[B]); X[B+1]=EX(X[B+1]); X[B+2]=EX(X[B+2]); X[B+3]=EX(X[B+3]); PIN(X); SBAR(); }while(0)
  #define VRD(i) do{ vlo[i]=vtr(vp_+(((i)>>2)*4096+((i)&3)*1024)); vhi[i]=vtr(vp_+(((i)>>2)*4096+((i)&3)*1024+512)); }while(0)
  #define KRD(G,j) do{ if(G){ kload2(kf,kp0+sl_next,j); SBAR(); } }while(0)
  #define STEP(C0,C1,P0,P1,t,GK,GV,GL) do{ SBAR(); \
    const lds_cptr vp_=vp0+sl_prev; \
    VRD(0); SBAR(); float sacc=(P0[0]+P0[1]); \
    GAPA(C0=__builtin_amdgcn_mfma_f32_32x32x16_bf16(kf[0],qr[0],negm,0,0,0), P0[2],P0[3],P0[4],P0[5],     pw0[0]=PKW(P0,0), pw0[1]=PKW(P0,2), pw0); \
    VRD(4); SBAR(); GAPA(C1=__builtin_amdgcn_mfma_f32_32x32x16_bf16(kf[1],qr[0],negm,0,0,0), P0[6],P0[7],P0[8],P0[9],     pw0[2]=PKW(P0,4), pw0[3]=PKW(P0,6), pw0); \
    VRD(1); SBAR(); GAPA(C0=__builtin_amdgcn_mfma_f32_32x32x16_bf16(kf[2],qr[1],C0,0,0,0),   P0[10],P0[11],P0[12],P0[13], pw1[0]=PKW(P0,8), pw1[1]=PKW(P0,10), pw1); \
    VRD(5); SBAR(); GAPA(C1=__builtin_amdgcn_mfma_f32_32x32x16_bf16(kf[3],qr[1],C1,0,0,0),   P0[14],P0[15],P1[0],P1[1],   pw1[2]=PKW(P0,12),pw1[3]=PKW(P0,14), pw1); \
    VRD(2); SBAR(); GAPA(C0=__builtin_amdgcn_mfma_f32_32x32x16_bf16(kf[4],qr[2],C0,0,0,0),   P1[2],P1[3],P1[4],P1[5],     pw2[0]=PKW(P1,0), pw2[1]=PKW(P1,2), pw2); \
    VRD(6); SBAR(); GAPA(C1=__builtin_amdgcn_mfma_f32_32x32x16_bf16(kf[5],qr[2],C1,0,0,0),   P1[6],P1[7],P1[8],P1[9],     pw2[2]=PKW(P1,4), pw2[3]=PKW(P1,6), pw2); \
    VRD(3); SBAR(); GAPA(C0=__builtin_amdgcn_mfma_f32_32x32x16_bf16(kf[6],qr[3],C0,0,0,0),   P1[10],P1[11],P1[12],P1[13], pw3[0]=PKW(P1,8), pw3[1]=PKW(P1,10), pw3); \
    VRD(7); SBAR(); GAPA(C1=__builtin_amdgcn_mfma_f32_32x32x16_bf16(kf[7],qr[3],C1,0,0,0),   P1[14],P1[15],0.f,0.f,       pw3[2]=PKW(P1,12),pw3[3]=PKW(P1,14), pw3); \
    l_reg+=sacc; \
    if(GK){DMA_K((t)+3,sl_cur);} if(GV){DMA_V((t)+1,sl_next);} \
    CMASK(C0,C1,t); \
    resc=false; \
    SBAR(); \
    GAPB(o[0]=__builtin_amdgcn_mfma_f32_32x32x16_bf16(PAF(0),VFR(0),o[0],0,0,0), C0,0); \
    GAPB(o[1]=__builtin_amdgcn_mfma_f32_32x32x16_bf16(PAF(0),VFR(4),o[1],0,0,0), C0,4); \
    KRD(GL,0); GAPB(o[0]=__builtin_amdgcn_mfma_f32_32x32x16_bf16(PAF(1),VFR(1),o[0],0,0,0), C0,8); \
    KRD(GL,1); GAPB(o[1]=__builtin_amdgcn_mfma_f32_32x32x16_bf16(PAF(1),VFR(5),o[1],0,0,0), C0,12); \
    KRD(GL,2); GAPB(o[0]=__builtin_amdgcn_mfma_f32_32x32x16_bf16(PAF(2),VFR(2),o[0],0,0,0), C1,0); \
    KRD(GL,3); GAPB(o[1]=__builtin_amdgcn_mfma_f32_32x32x16_bf16(PAF(2),VFR(6),o[1],0,0,0), C1,4); \
    GAPB(o[0]=__builtin_amdgcn_mfma_f32_32x32x16_bf16(PAF(3),VFR(3),o[0],0,0,0), C1,8); \
    GAPB(o[1]=__builtin_amdgcn_mfma_f32_32x32x16_bf16(PAF(3),VFR(7),o[1],0,0,0), C1,12); \
    }while(0)
  int t=1;
  #undef CMASK
  #define CMASK(P0,P1,t) do{}while(0)
  for(;t+5<NT;t+=2){
    STEP(pB0,pB1,pA0,pA1,t,true,true,true);     WAIT_BAR(2); RESC(); ROT();
    STEP(pA0,pA1,pB0,pB1,t+1,true,true,true);   WAIT_BAR(2); RESC(); ROT();
  }
  #undef CMASK
  #define CMASK(P0,P1,t) do{ if((t)>=NT-2) kmask(P0,P1,(t)==NT-1); }while(0)
  #define ENDW(tt) do{ if((tt)+3<NT){WAIT_BAR(2);} else if((tt)+2<NT){WAIT_BAR(1);} else {WAIT_BAR(0);} }while(0)
  for(;t+1<NT;t+=2){
    STEP(pB0,pB1,pA0,pA1,t,(t+3<NT),(t+1<NT),(t+1<NT));       ENDW(t);   RESC(); ROT();
    STEP(pA0,pA1,pB0,pB1,t+1,(t+4<NT),(t+2<NT),(t+2<NT));     ENDW(t+1); RESC(); ROT();
  }
  STEP(pB0,pB1,pA0,pA1,NT-1,false,false,false); RESC();
  { float sacc=pB0[0]+pB0[1]; _Pragma("unroll") for(int r=2;r<16;++r)sacc+=pB0[r]; _Pragma("unroll") for(int r=0;r<16;++r)sacc+=pB1[r]; l_reg+=sacc;
    pw0=(u32x4){PKW(pB0,0),PKW(pB0,2),PKW(pB0,4),PKW(pB0,6)};pw1=(u32x4){PKW(pB0,8),PKW(pB0,10),PKW(pB0,12),PKW(pB0,14)};pw2=(u32x4){PKW(pB1,0),PKW(pB1,2),PKW(pB1,4),PKW(pB1,6)};pw3=(u32x4){PKW(pB1,8),PKW(pB1,10),PKW(pB1,12),PKW(pB1,14)};
    SBAR(); pv(o,vb0+sl_cur,PAF(0),PAF(1),PAF(2),PAF(3)); }
  #undef PKW
  #undef PAF
  #undef VFR
  #undef PIN
  #undef MX3
  #undef GAPA
  #undef GAPB
  #undef EX
  #undef VRD
  #undef KRD
  #undef STEP
  #undef ENDW
  {auto rr=__builtin_amdgcn_permlane32_swap(__float_as_uint(l_reg),__float_as_uint(l_reg),false,false);l_reg=__uint_as_float(rr[0])+__uint_as_float(rr[1]);}
  if(hi==0)wsf[32+r32]=l_reg;asm volatile("s_waitcnt lgkmcnt(0)":::"memory");
  float rli[16];
  #pragma unroll
  for(int r=0;r<16;++r)rli[r]=__builtin_amdgcn_rcpf(wsf[32+crow(r,hi)]);
  bf16*Ow=Oblk+(long)(wid*QBLK)*QP;
  { bf16*stg=(bf16*)(shm+LDS_OST)+wid*2048;
    #pragma unroll
    for(int r=0;r<16;++r){const int orow=crow(r,hi);
      #pragma unroll
      for(int d0=0;d0<2;++d0)stg[orow*64+d0*32+r32]=__float2bfloat16(o[d0][r]*rli[r]);}
    asm volatile("s_waitcnt lgkmcnt(0)":::"memory");
    #pragma unroll
    for(int i=0;i<4;++i){const int row=i*8+(lane>>3),ch=lane&7; const u32x4 v=*(const u32x4*)(stg+row*64+ch*8); ATTN_STORE16(Ow+(long)row*QP+ch*8,v);} }
  asm volatile("s_waitcnt lgkmcnt(0)\n\ts_barrier":::"memory");
  #undef DMA_K
  #undef DMA_V
  #undef CMASK
  #undef START
  #undef RESC
  #undef ROT
}
#undef SBAR
#undef WAIT_BAR
}
#define GAS __attribute__((address_space(1)))
#define LAS __attribute__((address_space(3)))
typedef unsigned short bf16;
typedef unsigned v4u __attribute__((ext_vector_type(4)));
typedef float f32x4 __attribute__((ext_vector_type(4)));
constexpr size_t MiB = 1u << 20;
constexpr size_t WS_CTL = 0, CTL_BYTES = 4096;
constexpr size_t WS_ROPE = 1 * MiB, WS_SS1 = 2 * MiB, WS_SS2 = 3 * MiB;
constexpr size_t WS_WIN = 4 * MiB, WS_WG = 10 * MiB, WS_WA = 11 * MiB, WS_WF = 12 * MiB, WS_WO = 13 * MiB, WS_WFFN = 15 * MiB, WS_WDN = 26 * MiB;
constexpr size_t WS_GA = 32 * MiB, WS_X1B = 32 * MiB, WS_Q = 416 * MiB, WS_KB = 512 * MiB, WS_VB = 537 * MiB, WS_GTP = 562 * MiB, WS_GTS = 596 * MiB;
constexpr size_t WS_CS = 661 * MiB, WS_SS = 697 * MiB, WS_CP = 733 * MiB, WS_SP = 736 * MiB, WS_GFS = 739 * MiB, WS_GFP = 772 * MiB, WS_H = 813 * MiB, WS_F = 813 * MiB, WS_DS = 909 * MiB, WS_DP = 977 * MiB, WS_END = 1017 * MiB;
constexpr size_t WS_U = 224 * MiB, WS_MG = 512 * MiB;
static_assert(WS_GA + (size_t)NTOK * 2048 * 2 <= WS_Q && WS_Q + (size_t)NTOK * 512 * 2 <= WS_KB && WS_KB + (KV_S_OFF + (size_t)16 * KPS * 64) * 2 <= WS_VB && WS_VB + (KV_S_OFF + (size_t)16 * KPS * 64) * 2 <= WS_GTP, "ws map 1");
static_assert(WS_GTP + (size_t)16 * 512 * KPP * 2 <= WS_GTS && WS_GTS + (size_t)8 * 512 * KPS * 2 <= WS_CS && WS_CS + (size_t)MTS * 256 * K2S * 2 <= WS_SS && WS_SS + (size_t)MTS * 256 * K2S * 2 <= WS_CP, "ws map 2");
static_assert(WS_CP + (size_t)MTP * 256 * K2P * 2 <= WS_SP && WS_SP + (size_t)MTP * 256 * K2P * 2 <= WS_GFS && WS_GFS + (size_t)8 * 512 * K2S * 2 <= WS_GFP && WS_GFP + (size_t)16 * 512 * K2P * 2 <= WS_H && WS_H + (size_t)(NTOK + 256) * 1024 * 2 <= WS_END && WS_F + (size_t)NTOK * 512 * 2 <= WS_DS && WS_DS + (size_t)272 * 262144 <= WS_DP && WS_DP + (size_t)160 * 262144 <= WS_END, "ws map 3");
static_assert(WS_U + (size_t)NTOK * 2816 * 2 <= WS_END && WS_X1B + (size_t)NTOK * 1024 * 2 <= WS_U && WS_MG + (size_t)NTOK * 1024 * 2 <= WS_F && WS_WDN + (size_t)1024 * 2816 * 2 <= WS_GA && WS_WFFN + (size_t)5632 * 1024 * 2 <= WS_WDN && WS_WIN + (size_t)2816 * 1024 * 2 <= WS_WG, "ws map 4");
constexpr int LDS_BYTES = 147456, MISC_OFF = 131072 + 320;
constexpr int NATT = 3072;

__device__ __forceinline__ unsigned f2bf(float f) { unsigned u = __builtin_bit_cast(unsigned, f); return (u + 0x7fffu + ((u >> 16) & 1u)) >> 16; }
__device__ __forceinline__ unsigned pk2(float lo, float hi) { return f2bf(lo) | (f2bf(hi) << 16); }
__device__ __forceinline__ float wave_sum(float v) {
#pragma unroll
    for (int o = 1; o < 64; o <<= 1) v += __shfl_xor(v, o);
    return v; }

__device__ __forceinline__ int src_col(int mat, int n) {
    if (mat == 0) {
        if (n >= 768) return 1280 + (n - 768);
        const int ct = n & 255, bj = ct >> 7, wc = (ct >> 5) & 3, fq = (ct >> 3) & 3, nn = (ct >> 2) & 1, j = ct & 3;
        if (n < 512) return ((n >> 8) * 4 + wc) * 64 + 32 * bj + 16 * nn + 4 * fq + j;
        if (wc < 2) return 512 + wc * 64 + 32 * bj + 16 * nn + 4 * fq + j;
        return 640 + (wc - 2) * 64 + 32 * bj + 8 * fq + 4 * nn + j;
    }
    if (mat == 4) { const int pn = n >> 8, ct = n & 255, nn = (ct >> 2) & 1, j = ct & 3, q8 = ct >> 3; return (nn ? 2816 : 0) + 128 * pn + 4 * q8 + j; }
    return n;
}
__device__ __forceinline__ void tr_item(const float* W, int ldw, int K, int ND, bf16* WT, int mat, const float* ksc, LAS float* scr, int item, int lane) {
    const int nblk = ND / 32, kb = item / nblk, nb = item % nblk, k0 = 64 * kb, n0 = 32 * nb;
    const int sc = src_col(mat, n0 + (lane & 31));
#pragma unroll 8
    for (int i = 0; i < 32; ++i) { const int kk = 2 * i + (lane >> 5); float v = W[(size_t)(k0 + kk) * ldw + sc]; if (ksc) v *= ksc[k0 + kk]; scr[kk * 33 + (lane & 31)] = v; }
    asm volatile("s_waitcnt lgkmcnt(0)" ::: "memory");
    const int c = lane & 7;
#pragma unroll
    for (int j = 0; j < 4; ++j) { const int n = (lane >> 3) + 8 * j; const LAS float* s = scr + (8 * c) * 33 + n;
        v4u o; o.x = pk2(s[0 * 33], s[1 * 33]); o.y = pk2(s[2 * 33], s[3 * 33]); o.z = pk2(s[4 * 33], s[5 * 33]); o.w = pk2(s[6 * 33], s[7 * 33]);
        *(v4u*)(WT + (size_t)(n0 + n) * K + k0 + 8 * c) = o; }
    asm volatile("s_waitcnt lgkmcnt(0)" ::: "memory");
}
__device__ __forceinline__ void rms_row_bf16(const float* xrow, const float* g, bf16* orow, int lane) {
    const f32x4* xr = (const f32x4*)xrow + lane; const f32x4* gr = (const f32x4*)g + lane;
    f32x4 v[4]; float s = 0.f;
#pragma unroll
    for (int j = 0; j < 4; ++j) { v[j] = xr[64 * j]; s += (v[j].x * v[j].x + v[j].y * v[j].y) + (v[j].z * v[j].z + v[j].w * v[j].w); }
    const float rstd = rsqrtf(wave_sum(s) * (1.f / 1024.f) + EPS);
    unsigned long long* o8 = (unsigned long long*)orow + lane;
#pragma unroll
    for (int j = 0; j < 4; ++j) { const f32x4 gg = gr[64 * j]; o8[64 * j] = (unsigned long long)pk2(v[j].x * rstd * gg.x, v[j].y * rstd * gg.y) | ((unsigned long long)pk2(v[j].z * rstd * gg.z, v[j].w * rstd * gg.w) << 32); }
}
__device__ __forceinline__ void dft_fill(bf16* C, bf16* S, int rows, int KP_, int L, long gtid, long nthr) {
    const int per_row = KP_ / 8; const long items = (long)rows * per_row; const float inv = 2.0f / (float)L;
    for (long it = gtid; it < items; it += nthr) { const int r = (int)(it / per_row), l0 = (int)(it % per_row) * 8;
        const bool rv = (r >= 1 && r <= L / 2);
        unsigned cw[4], sw[4]; int m = rv ? (int)(((long)r * l0) % L) : 0;
#pragma unroll
        for (int e = 0; e < 4; ++e) { float c0 = 0.f, s0 = 0.f, c1 = 0.f, s1 = 0.f;
            if (rv && l0 + 2 * e <= L / 2) sincospif((float)m * inv, &s0, &c0);
            m += r; if (m >= L) m -= L;
            if (rv && l0 + 2 * e + 1 <= L / 2) sincospif((float)m * inv, &s1, &c1);
            m += r; if (m >= L) m -= L;
            cw[e] = pk2(c0, c1); sw[e] = pk2(s0, s1); }
        *(v4u*)(C + (size_t)r * KP_ + l0) = (v4u){cw[0], cw[1], cw[2], cw[3]}; *(v4u*)(S + (size_t)r * KP_ + l0) = (v4u){sw[0], sw[1], sw[2], sw[3]}; }
}
__device__ __forceinline__ void gt_fold(const bf16* GT, bf16* GF, int nseq, int KPin, int K2, int L, long gtid, long nthr) {
    const int per_row = K2 / 8; const long items = (long)nseq * 512 * per_row; const int L2 = L / 2;
    for (long it = gtid; it < items; it += nthr) { const int row = (int)(it / per_row), l0 = (int)(it % per_row) * 8; const bf16* g = GT + (size_t)row * KPin;
        const bool odd = ((row & 127) > 64); float o[8];
#pragma unroll
        for (int j = 0; j < 8; ++j) { const int l = l0 + j; float v = 0.f;
            if (l <= L2) { const float a = __uint_as_float((unsigned)g[l < 16 ? l : l + 48] << 16);
                if (l == 0 || l == L2) v = odd ? 0.f : a;
                else { const float b = __uint_as_float((unsigned)g[L - l + 48] << 16); v = odd ? a - b : a + b; } }
            o[j] = v; }
        *(v4u*)(GF + (size_t)row * K2 + l0) = (v4u){pk2(o[0], o[1]), pk2(o[2], o[3]), pk2(o[4], o[5]), pk2(o[6], o[7])}; }
}

__device__ __forceinline__ void my_bar(unsigned* cnt, unsigned target) {
    __syncthreads();
    if (threadIdx.x == 0) {
        __builtin_amdgcn_fence(__ATOMIC_RELEASE, "agent");
        __hip_atomic_fetch_add(cnt, 1u, __ATOMIC_RELAXED, __HIP_MEMORY_SCOPE_AGENT);
        while (__hip_atomic_load(cnt, __ATOMIC_RELAXED, __HIP_MEMORY_SCOPE_AGENT) < target) __builtin_amdgcn_s_sleep(2);
        __builtin_amdgcn_fence(__ATOMIC_ACQUIRE, "agent");
    }
    __syncthreads();
}
struct Args { const float* in[14]; float* out; unsigned char* ws; };

#if CHECKS
#define BF(v) (__uint_as_float(((unsigned)(v)) << 16))
__device__ __forceinline__ void chk(unsigned* ctl, int stage, float got, float ref, float rt) {
    const bool bad = !(fabsf(got - ref) <= rt * (1.0f + fabsf(ref)));
    const unsigned long long m = __ballot(bad);
    if ((threadIdx.x & 63) == 0 && m) atomicAdd(ctl + 200 + stage, (unsigned)__popcll(m));
}
__device__ __forceinline__ void tok_geom(int t, int& seq, int& p) { if (t < P_TOK) { seq = t >> 11; p = t & 2047; } else { seq = 16 + ((t - P_TOK) >> 13); p = (t - P_TOK) & 8191; } }
#define RUN_CHECKS(stage) do { run_checks((stage), bx * 8 + wave, lane); GRID_SYNC(); } while (0)
__device__ __forceinline__ void run_checks(int stage, int gw, int lane) {
    typedef __attribute__((address_space(4))) const Args CArgs;
    CArgs* ap_ = (CArgs*)__builtin_amdgcn_kernarg_segment_ptr(); unsigned char* ws = ap_->ws; unsigned* ctl = (unsigned*)(ws + WS_CTL);
    const int t = (int)(((long)gw * 48 + (gw >> 3)) % NTOK); int seq, p; tok_geom(t, seq, p);
    if (stage == 1) {
        ((float*)(ws + 65536))[(size_t)gw * 64 + lane] = BF(((const bf16*)(ws + WS_Q))[(size_t)t * 512 + (gw & 7) * 64 + lane]);
        const bf16* hrow = (const bf16*)(ws + WS_H) + (size_t)t * 1024; const float* w_in = ap_->in[4]; const int c = lane * 32 + (gw & 31);
        float z = 0.f; for (int k = 0; k < 1024; ++k) z += BF(hrow[k]) * w_in[(size_t)k * 3328 + 1280 + c];
        chk(ctl, 1, BF(((const bf16*)(ws + WS_GA))[(size_t)t * 2048 + c]), 1.f / (1.f + expf(-z)), 0.02f);
        { const float* xr = t < P_TOK ? ap_->in[0] + (size_t)t * 1024 : ap_->in[1] + (size_t)(t - P_TOK) * 1024; float s = 0.f; for (int k = lane; k < 1024; k += 64) s += xr[k] * xr[k];
          s = wave_sum(s); const float rs = rsqrtf(s * (1.f / 1024.f) + EPS); const int k = lane * 16 + (gw & 15); chk(ctl, 0, BF(hrow[k]), xr[k] * rs * ap_->in[3][k], 0.01f); }
    } else if (stage == 2) {
        const int L = seq < 16 ? LP : LS, lp = 16 + p, KP_ = seq < 16 ? KPP : KPS; const float scale = rsqrtf((float)L * 128.0f);
        const int c = lane * 8 + (gw & 7), g = c >> 7, cp = c & 127;
        const int rc = cp <= 64 ? cp : 128 - cp, rs_ = (cp == 0 || cp == 64) ? -1 : (cp < 64 ? 64 + cp : 192 - cp); const float sg = cp < 64 ? 1.f : -1.f;
        const bf16* gb = seq < 16 ? (const bf16*)(ws + WS_GTP) + ((size_t)seq * 512 + g * 128) * KPP : (const bf16*)(ws + WS_GTS) + ((size_t)(seq - 16) * 512 + g * 128) * KPS;
        float a = 0.f; int m = 0;
        for (int l = 0; l < L; ++l) { const int ph = l < 16 ? l : l + 48; float sn, cs; sincospif(2.0f * (float)m / (float)L, &sn, &cs);
            a += cs * BF(gb[(size_t)rc * KP_ + ph]); if (rs_ >= 0) a -= sg * sn * BF(gb[(size_t)rs_ * KP_ + ph]);
            m += lp; if (m >= L) m -= L; }
        chk(ctl, 2, BF(((const bf16*)(ws + WS_F))[(size_t)t * 512 + c]), a * scale, 0.04f);
        if ((gw & 15) == 0) { const int hq = gw & 7, kvh = hq >> 2, n = seq < 16 ? 2048 : 8192; const bf16* kb = (const bf16*)(ws + WS_KB) + pg8::kvoff(seq, kvh); const bf16* vb = (const bf16*)(ws + WS_VB) + pg8::kvoff(seq, kvh);
          const float* qs = (const float*)(ws + 65536) + (size_t)gw * 64; float mx = -1e30f;
          for (int j = lane; j < n + 16; j += 64) { float s = 0.f; for (int d = 0; d < 64; ++d) s += qs[d] * BF(kb[(size_t)j * 64 + d]); mx = fmaxf(mx, s); }
          for (int o = 1; o < 64; o <<= 1) mx = fmaxf(mx, __shfl_xor(mx, o));
          float den = 0.f, num = 0.f; const int dd = (gw >> 4) & 63;
          for (int j = lane; j < n + 16; j += 64) { float s = 0.f; for (int d = 0; d < 64; ++d) s += qs[d] * BF(kb[(size_t)j * 64 + d]); const float pj = exp2f(s - mx); den += pj; num += pj * BF(vb[(size_t)j * 64 + dd]); }
          den = wave_sum(den); num = wave_sum(num);
          const float got = BF(((const bf16*)(ws + WS_Q))[(size_t)t * 512 + hq * 64 + dd]), ref = num / den;
          if (lane == 0 && !(fabsf(got - ref) <= 0.004f + 0.02f * fabsf(ref))) atomicAdd(ctl + 202, 1u); }
    } else if (stage == 3) {
        const int c = lane * 16 + (gw & 15); float a = 0.f, f = 0.f;
        for (int k = 0; k < 512; ++k) { a += BF(((const bf16*)(ws + WS_Q))[(size_t)t * 512 + k]) * ap_->in[7][(size_t)k * 1024 + c]; f += BF(((const bf16*)(ws + WS_F))[(size_t)t * 512 + k]) * ap_->in[8][(size_t)k * 1024 + c]; }
        const bf16* ga = (const bf16*)(ws + WS_GA) + (size_t)t * 2048;
        chk(ctl, 3, BF(((const bf16*)(ws + WS_MG))[(size_t)t * 1024 + c]), BF(ga[c]) * a + BF(ga[1024 + c]) * f, 0.03f);
    } else if (stage == 4) {
        const float* xr = t < P_TOK ? ap_->in[0] + (size_t)t * 1024 : ap_->in[1] + (size_t)(t - P_TOK) * 1024; const float* o = ap_->out + (size_t)t * 1024;
        const int c = lane * 16 + (gw & 15); float a = 0.f; for (int k = 0; k < 1024; ++k) a += BF(((const bf16*)(ws + WS_MG))[(size_t)t * 1024 + k]) * ap_->in[9][(size_t)k * 1024 + c];
        chk(ctl, 4, o[c], xr[c] + a, 0.02f);
        chk(ctl, 4, BF(((const bf16*)(ws + WS_X1B))[(size_t)t * 1024 + c]), o[c], 0.01f);
        { float s = 0.f; for (int cc = lane; cc < 1024; cc += 64) s += o[cc] * o[cc]; s = wave_sum(s); chk(ctl, 4, ((const float*)(ws + WS_SS1))[t], s, 0.002f); }
    } else if (stage == 5) {
        const bf16* xb = (const bf16*)(ws + WS_X1B) + (size_t)t * 1024; const float rs = rsqrtf(((const float*)(ws + WS_SS1))[t] * (1.f / 1024.f) + EPS);
        const int j = lane * 44 + (gw % 44); float g = 0.f, u = 0.f;
        for (int k = 0; k < 1024; ++k) { const float xv = BF(xb[k]) * ap_->in[10][k]; g += xv * ap_->in[11][(size_t)k * 5632 + j]; u += xv * ap_->in[11][(size_t)k * 5632 + 2816 + j]; }
        g *= rs; u *= rs;
        chk(ctl, 5, BF(((const bf16*)(ws + WS_U))[(size_t)t * 2816 + j]), g / (1.f + expf(-g)) * u, 0.03f);
    } else if (stage == 6) {
        const int c = lane * 16 + (gw & 15); float a = 0.f; for (int k = 0; k < 2816; ++k) a += BF(((const bf16*)(ws + WS_U))[(size_t)t * 2816 + k]) * ap_->in[12][(size_t)k * 1024 + c];
        const float* o = ap_->out + (size_t)t * 1024;
        chk(ctl, 6, o[c], BF(((const bf16*)(ws + WS_X1B))[(size_t)t * 1024 + c]) + a, 0.03f);
        { float s = 0.f; for (int cc = lane; cc < 1024; cc += 64) s += o[cc] * o[cc]; s = wave_sum(s); chk(ctl, 6, ((const float*)(ws + WS_SS2))[t], s, 0.002f); }
    }
}
#else
#define RUN_CHECKS(stage) do {} while (0)
#endif

__global__ void __launch_bounds__(512, 2) enc_fwd(Args args) {
    extern __shared__ __attribute__((aligned(16))) unsigned char lds[];
    cg::grid_group grid = cg::this_grid();
    LAS unsigned char* L3 = (LAS unsigned char*)lds;
    volatile LAS unsigned* MISC = (volatile LAS unsigned*)(L3 + MISC_OFF);
    const int tid = threadIdx.x, lane = tid & 63, wave = __builtin_amdgcn_readfirstlane(tid >> 6);
    const int G = gridDim.x, bx = blockIdx.x; int nsync_ = 0;
#if TSTAMP
    unsigned long long ts_[9]; for (int i_ = 0; i_ < 9; ++i_) ts_[i_] = 0; ts_[0] = __builtin_amdgcn_s_memrealtime();
#endif
    typedef __attribute__((address_space(4))) const Args CArgs;
#define LOAD_ARGS() CArgs* ap_ = (CArgs*)__builtin_amdgcn_kernarg_segment_ptr(); asm volatile("" : "+s"(ap_)); unsigned char* ws = ap_->ws; (void)ws
#define WSP(T, off) ((T*)(ws + (off)))
#define AIN(i) (ap_->in[i])
#define AOUT() (ap_->out)
#if TSTAMP
#define TS_MARK() do { if (nsync_ < 9) ts_[nsync_] = __builtin_amdgcn_s_memrealtime(); } while (0)
#else
#define TS_MARK() do {} while (0)
#endif
#define GRID_SYNC() do { asm volatile("s_waitcnt vmcnt(0) lgkmcnt(0)" ::: "memory"); grid.sync(); ++nsync_; __builtin_amdgcn_fence(__ATOMIC_ACQUIRE, "agent"); asm volatile("s_waitcnt vmcnt(0)" ::: "memory"); TS_MARK(); } while (0)
#define WSPC(T, off) ((T*)(((CArgs*)__builtin_amdgcn_kernarg_segment_ptr())->ws + (off)))

#if (PHM>>0)&1
    { LOAD_ARGS();
        const int gw = bx * 8 + wave, NGW = G * 8; const long gtid = (long)bx * 512 + tid, nthr = (long)G * 512;
        LAS float* tab = (LAS float*)L3;
        if (tid < 128) { tab[tid] = cospif((float)tid * (1.0f / 64.0f)); }
        __syncthreads();
        LAS float* scr = (LAS float*)(L3 + 1024 + wave * 8704);
        constexpr int I0 = 16 * 88, I1 = 8 * 32, I2 = 8 * 32, I3 = 16 * 32, I4 = 16 * 176, I5 = 44 * 32;
        for (int it = gw; it < I0 + I1 + I2 + I3 + I4 + I5; it += NGW) { int r = it;
            if (r < I0) { tr_item(AIN(4), 3328, 1024, 2816, WSP(bf16, WS_WIN), 0, nullptr, scr, r, lane); continue; } r -= I0;
            if (r < I1) { tr_item(AIN(7), 1024, 512, 1024, WSP(bf16, WS_WA), 1, nullptr, scr, r, lane); continue; } r -= I1;
            if (r < I2) { tr_item(AIN(8), 1024, 512, 1024, WSP(bf16, WS_WF), 2, nullptr, scr, r, lane); continue; } r -= I2;
            if (r < I3) { tr_item(AIN(9), 1024, 1024, 1024, WSP(bf16, WS_WO), 3, nullptr, scr, r, lane); continue; } r -= I3;
            if (r < I4) { tr_item(AIN(11), 5632, 1024, 5632, WSP(bf16, WS_WFFN), 4, AIN(10), scr, r, lane); continue; } r -= I4;
            tr_item(AIN(12), 1024, 2816, 1024, WSP(bf16, WS_WDN), 5, nullptr, scr, r, lane); }
        for (long id = gtid; id < 512 * 128; id += nthr) { const int wv = (int)id >> 6, ln = (int)id & 63, chunk = (wv & 15) * 8 + (ln & 7), row = (wv >> 4) * 8 + (ln >> 3), s = row & 127, g = row >> 7, k = chunk * 8;
            const float* wr_ = AIN(4) + (size_t)k * 3328 + 768 + g * 128; float a[8];
#pragma unroll
            for (int j = 0; j < 8; ++j) a[j] = 0.f;
            const int sm = s <= 64 ? s : s - 64, sh = s <= 64 ? 0 : 96;
            for (int c = 0; c < 128; ++c) { const float tv = tab[(c * sm + sh) & 127];
#pragma unroll
                for (int j = 0; j < 8; ++j) a[j] += wr_[(size_t)j * 3328 + c] * tv; }
            *(v4u*)(WSP(bf16, WS_WG) + (size_t)row * 1024 + k) = (v4u){pk2(a[0], a[1]), pk2(a[2], a[3]), pk2(a[4], a[5]), pk2(a[6], a[7])}; }
        for (int m = gw; m < NTOK + 256; m += NGW) {
            bf16* orow = WSP(bf16, WS_H) + (size_t)m * 1024;
            if (m < P_TOK) rms_row_bf16(AIN(0) + (size_t)m * 1024, AIN(3), orow, lane);
            else if (m < NTOK) rms_row_bf16(AIN(1) + (size_t)(m - P_TOK) * 1024, AIN(3), orow, lane);
            else if (m < NTOK + 16) rms_row_bf16(AIN(2) + (size_t)(m - NTOK) * 1024, AIN(3), orow, lane);
            else { unsigned long long* o8 = (unsigned long long*)orow + lane;
#pragma unroll
                for (int j = 0; j < 4; ++j) o8[64 * j] = 0ull; } }
        dft_fill(WSP(bf16, WS_CS), WSP(bf16, WS_SS), MTS * 256, K2S, LS, gtid, nthr);
        dft_fill(WSP(bf16, WS_CP), WSP(bf16, WS_SP), MTP * 256, K2P, LP, gtid, nthr);
        for (long id = gtid; id < 130 * 16; id += nthr) { const int pp = (int)id >> 4, i = (int)id & 15;
            const double ang = (double)(pp - 1) * pow(10000.0, -(double)i / 16.0);
            WSP(float, WS_ROPE)[pp * 32 + i] = (float)cos(ang); WSP(float, WS_ROPE)[pp * 32 + 16 + i] = (float)sin(ang); }
        for (long id = gtid; id < NTOK; id += nthr) { WSP(float, WS_SS1)[id] = 0.f; WSP(float, WS_SS2)[id] = 0.f; }
        for (long id = gtid; id < 48L * 112 * 8; id += nthr) { const int g = (int)(id / 896), rem = (int)(id % 896), r = rem >> 3, ch = rem & 7;
            const int seq = g >> 1, kvh = g & 1; const size_t off = pg8::kvoff(seq, kvh) + (size_t)(pg8::seqlen(seq) + 16 + r) * 64 + ch * 8;
            *(v4u*)(WSP(bf16, WS_KB) + off) = (v4u){0u, 0u, 0u, 0u}; *(v4u*)(WSP(bf16, WS_VB) + off) = (v4u){0u, 0u, 0u, 0u}; }
        for (long id = gtid; id < 24L * 512 * 8; id += nthr) { const int row = (int)(id >> 3), ch = (int)(id & 7), seq = row >> 9, c = row & 511;
            bf16* d = seq < 16 ? WSP(bf16, WS_GTP) + ((size_t)seq * 512 + c) * KPP + 64 + 2048 : WSP(bf16, WS_GTS) + ((size_t)(seq - 16) * 512 + c) * KPS + 64 + 8192;
            *(v4u*)(d + ch * 8) = (v4u){0u, 0u, 0u, 0u}; }
        asm volatile("s_waitcnt vmcnt(0) lgkmcnt(0)" ::: "memory");
    }
#endif
    GRID_SYNC();
    RUN_CHECKS(0);

#if (PHM>>1)&1
    { LOAD_ARGS();
        pg8::Gemm g{WSP(bf16, WS_H), WSP(bf16, WS_WIN), NTOK + 256, 2816, 1024}; pg8::G1Order S; S.init(G, bx);
        pg8::EpiG1 E; E.Q = WSP(bf16, WS_Q); E.KB = WSP(bf16, WS_KB); E.VB = WSP(bf16, WS_VB); E.GA = WSP(bf16, WS_GA); E.rope = WSP(float, WS_ROPE); E.gq = AIN(5); E.gk = AIN(6);
        pg8::gemm_phase<pg8::EpiG1, pg8::G1Order, PG_ALIGN, PG_SP2>(L3, g, S, E);
    }
#endif
#if (PHM>>2)&1
    { LOAD_ARGS();
        pg8::Gemm g{WSP(bf16, WS_WG), WSP(bf16, WS_H), 512, NTOK + 256, 1024}; pg8::StaticOrder S; S.init(512, NTOK + 256, G, G - 1 - bx);
        pg8::EpiGT E; E.GTp = WSP(bf16, WS_GTP); E.GTs = WSP(bf16, WS_GTS);
        pg8::gemm_phase<pg8::EpiGT, pg8::StaticOrder, PG_ALIGN, PG_SP2>(L3, g, S, E);
    }
#endif
    GRID_SYNC();
    RUN_CHECKS(1);

#if (PHM>>3)&1
    { LOAD_ARGS(); const long gtid = (long)bx * 512 + tid, nthr = (long)G * 512;
      gt_fold(WSP(bf16, WS_GTS), WSP(bf16, WS_GFS), 8, KPS, K2S, LS, gtid, nthr);
      gt_fold(WSP(bf16, WS_GTP), WSP(bf16, WS_GFP), 16, KPP, K2P, LP, gtid, nthr); }
    GRID_SYNC();
#endif
#if (PHM>>3)&1
    for (int ps = 0; ps < 2; ++ps) { LOAD_ARGS();
        const int K = ps ? K2P : K2S, nMt = ps ? MTP : MTS, Lq = ps ? LP : LS;
        pg8::DftOrder S; S.G = G; S.c = ps ? (bx + G - 16) % G : bx; S.total = ps ? 160 : 272; S.sample = !ps;
        { pg8::Gemm g{ps ? WSP(bf16, WS_CP) : WSP(bf16, WS_CS), ps ? WSP(bf16, WS_GFP) : WSP(bf16, WS_GFS), nMt * 256, ps ? 16 * 512 : 8 * 512, K};
          pg8::EpiDftP E; E.dump = ps ? WSP(float, WS_DP) : WSP(float, WS_DS); E.nMt = nMt;
          pg8::gemm_phase<pg8::EpiDftP, pg8::DftOrder, PG_ALIGN, PG_SP2>(L3, g, S, E); }
        { pg8::Gemm g{ps ? WSP(bf16, WS_SP) : WSP(bf16, WS_SS), ps ? WSP(bf16, WS_GFP) : WSP(bf16, WS_GFS), nMt * 256, ps ? 16 * 512 : 8 * 512, K};
          pg8::EpiDftQ E; E.dump = ps ? WSP(float, WS_DP) : WSP(float, WS_DS); E.nMt = nMt; E.F = WSP(bf16, WS_F); E.L = Lq; E.tokbase = ps ? 0 : P_TOK; E.nseq = ps ? 2048 : 8192; E.scale = rsqrtf((float)Lq * 128.0f);
          pg8::gemm_phase<pg8::EpiDftQ, pg8::DftOrder, PG_ALIGN, PG_SP2>(L3, g, S, E); }
    }
#endif
#if (PHM>>4)&1
    float shiftM; { LOAD_ARGS(); float mq = 0.f, mk = 0.f; for (int i = 0; i < 64; ++i) { mq = fmaxf(mq, fabsf(AIN(5)[i])); mk = fmaxf(mk, fabsf(AIN(6)[i])); } shiftM = QC2 * 64.0f * mq * mk * 1.01f + 0.05f; }
    for (;;) { LOAD_ARGS();
        if (tid == 0) MISC[0] = atomicAdd(WSP(unsigned, WS_CTL) + 64, 1u);
        __syncthreads();
        const int idx = (int)MISC[0];
        __syncthreads();
        if (idx >= NATT) break;
        int tok0, NT, hq; size_t kvo;
        if (idx < 2048) { const int gk = idx >> 7, r = idx & 127, b = gk >> 1, kvh = gk & 1; hq = kvh * 4 + (r >> 5); tok0 = P_TOK + b * 8192 + (r & 31) * 256; NT = 130; kvo = KV_S_OFF + (size_t)gk * KPS * 64; }
        else { const int j = idx - 2048, gk = j >> 5, r = j & 31, b = gk >> 1, kvh = gk & 1; hq = kvh * 4 + (r >> 3); tok0 = b * 2048 + (r & 7) * 256; NT = 34; kvo = (size_t)gk * KPP * 64; }
        attn_body::attn_unit<8>((const attn_body::bf16*)(WSP(bf16, WS_Q) + (size_t)tok0 * 512 + hq * 64), (const attn_body::bf16*)(WSP(bf16, WS_KB) + kvo), (const attn_body::bf16*)(WSP(bf16, WS_VB) + kvo), (attn_body::bf16*)(WSP(bf16, WS_Q) + (size_t)tok0 * 512 + hq * 64), NT, shiftM, (char*)lds);
    }
#endif
    GRID_SYNC();
    RUN_CHECKS(2);

#if PROBE == 1
    {
        LOAD_ARGS();
        const long gtid = (long)bx * 512 + tid, nthr = (long)G * 512;
        for (long id = gtid; id < (long)NTOK * 128; id += nthr) { const long t = id >> 7; const int c = (int)(id & 127) * 8;
            const bf16* src = c < 512 ? WSP(bf16, WS_F) + t * 512 + c : WSP(bf16, WS_Q) + t * 512 + (c - 512);
            const v4u w = *(const v4u*)src; float* o = AOUT() + t * 1024 + c;
            o[0] = __uint_as_float(w.x << 16); o[1] = __uint_as_float(w.x & 0xffff0000u); o[2] = __uint_as_float(w.y << 16); o[3] = __uint_as_float(w.y & 0xffff0000u);
            o[4] = __uint_as_float(w.z << 16); o[5] = __uint_as_float(w.z & 0xffff0000u); o[6] = __uint_as_float(w.w << 16); o[7] = __uint_as_float(w.w & 0xffff0000u); }
        return;
    }
#endif
#if (PHM>>5)&1
    { LOAD_ARGS();
        pg8::StaticOrder S; S.init(NTOK, 1024, G, bx);
        { pg8::Gemm g{WSP(bf16, WS_Q), WSP(bf16, WS_WA), NTOK, 1024, 512}; pg8::EpiMerge<0> E; E.GA = WSP(bf16, WS_GA); E.MG = WSP(bf16, WS_MG);
          pg8::gemm_phase<pg8::EpiMerge<0>, pg8::StaticOrder, PG_ALIGN, PG_SP2>(L3, g, S, E); }
        { pg8::Gemm g{WSP(bf16, WS_F), WSP(bf16, WS_WF), NTOK, 1024, 512}; pg8::EpiMerge<1> E; E.GA = WSP(bf16, WS_GA); E.MG = WSP(bf16, WS_MG);
          pg8::gemm_phase<pg8::EpiMerge<1>, pg8::StaticOrder, PG_ALIGN, PG_SP2>(L3, g, S, E); }
    }
    GRID_SYNC();
    RUN_CHECKS(3);
#endif
#if PROBE == 4
    {
        LOAD_ARGS();
        const int gw = bx * 8 + wave, NGW = G * 8;
        for (int m = gw; m < NTOK; m += NGW) { const bf16* gr = WSP(bf16, WS_GA) + (size_t)m * 2048;
            const v4u a = *(const v4u*)(gr + lane * 8), b = *(const v4u*)(gr + 1024 + lane * 8);
            asm volatile("s_waitcnt vmcnt(0)" ::: "memory");
            float* o = AOUT() + (size_t)m * 1024 + lane * 8;
            o[0] = __uint_as_float(a.x << 16); o[1] = __uint_as_float(a.x & 0xffff0000u); o[2] = __uint_as_float(a.y << 16); o[3] = __uint_as_float(a.y & 0xffff0000u);
            o[4] = __uint_as_float(a.z << 16); o[5] = __uint_as_float(a.z & 0xffff0000u); o[6] = __uint_as_float(a.w << 16); o[7] = __uint_as_float(a.w & 0xffff0000u);
            o += 512;
            o[0] = __uint_as_float(b.x << 16); o[1] = __uint_as_float(b.x & 0xffff0000u); o[2] = __uint_as_float(b.y << 16); o[3] = __uint_as_float(b.y & 0xffff0000u);
            o[4] = __uint_as_float(b.z << 16); o[5] = __uint_as_float(b.z & 0xffff0000u); o[6] = __uint_as_float(b.w << 16); o[7] = __uint_as_float(b.w & 0xffff0000u); }
        return;
    }
#endif
#if PROBE == 3
    {
        LOAD_ARGS();
        const long gtid = (long)bx * 512 + tid, nthr = (long)G * 512;
        for (long id = gtid; id < (long)NTOK * 128; id += nthr) { const long t = id >> 7; const int c = (int)(id & 127) * 8;
            const v4u w = *(const v4u*)(WSP(bf16, WS_MG) + t * 1024 + c); float* o = AOUT() + t * 1024 + c;
            o[0] = __uint_as_float(w.x << 16); o[1] = __uint_as_float(w.x & 0xffff0000u); o[2] = __uint_as_float(w.y << 16); o[3] = __uint_as_float(w.y & 0xffff0000u);
            o[4] = __uint_as_float(w.z << 16); o[5] = __uint_as_float(w.z & 0xffff0000u); o[6] = __uint_as_float(w.w << 16); o[7] = __uint_as_float(w.w & 0xffff0000u); }
        return;
    }
#endif
#if (PHM>>6)&1
    { LOAD_ARGS();
        pg8::Gemm g{WSP(bf16, WS_MG), WSP(bf16, WS_WO), NTOK, 1024, 1024}; pg8::StaticOrder S; S.init(NTOK, 1024, G, bx);
        pg8::EpiX1 E; E.xp = AIN(0); E.xs = AIN(1); E.X1B = WSP(bf16, WS_X1B); E.ss1 = WSP(float, WS_SS1);
        pg8::gemm_phase<pg8::EpiX1, pg8::StaticOrder, PG_ALIGN, PG_SP2>(L3, g, S, E);
    }
#endif
    GRID_SYNC();
    RUN_CHECKS(4);
#if PROBE == 2
    return;
#endif
#if (PHM>>7)&1
    { LOAD_ARGS();
        pg8::Gemm g{WSP(bf16, WS_X1B), WSP(bf16, WS_WFFN), NTOK, 5632, 1024}; pg8::StaticOrder S; S.init(NTOK, 5632, G, bx);
        pg8::EpiF1 E; E.ss1 = WSP(float, WS_SS1); E.U = WSP(bf16, WS_U);
        pg8::gemm_phase<pg8::EpiF1, pg8::StaticOrder, PG_ALIGN, PG_SP2>(L3, g, S, E);
    }
#endif
    GRID_SYNC();
    RUN_CHECKS(5);
#if (PHM>>8)&1
    { LOAD_ARGS();
        pg8::Gemm g{WSP(bf16, WS_U), WSP(bf16, WS_WDN), NTOK, 1024, 2816}; pg8::StaticOrder S; S.init(NTOK, 1024, G, bx);
        pg8::EpiF2 E; E.XB = WSP(bf16, WS_X1B); E.ss2 = WSP(float, WS_SS2);
        pg8::gemm_phase<pg8::EpiF2, pg8::StaticOrder, PG_ALIGN, PG_SP2>(L3, g, S, E);
    }
#endif
    GRID_SYNC();
    RUN_CHECKS(6);
    { LOAD_ARGS();
        const int gw = bx * 8 + wave, NGW = G * 8; const f32x4* gf = (const f32x4*)AIN(13) + 2 * lane;
        for (int m = gw; m < NTOK; m += NGW) { const v4u* xi = (const v4u*)(WSP(bf16, WS_X1B) + (size_t)m * 1024) + lane; f32x4* o = (f32x4*)(AOUT() + (size_t)m * 1024) + 2 * lane;
            const float rs = rsqrtf(__hip_atomic_load(WSP(float, WS_SS2) + m, __ATOMIC_RELAXED, __HIP_MEMORY_SCOPE_AGENT) * (1.f / 1024.f) + EPS);
#pragma unroll
            for (int j = 0; j < 2; ++j) { const v4u w = xi[64 * j]; f32x4 a, b;
                a[0] = __uint_as_float(w.x << 16); a[1] = __uint_as_float(w.x & 0xffff0000u); a[2] = __uint_as_float(w.y << 16); a[3] = __uint_as_float(w.y & 0xffff0000u);
                b[0] = __uint_as_float(w.z << 16); b[1] = __uint_as_float(w.z & 0xffff0000u); b[2] = __uint_as_float(w.w << 16); b[3] = __uint_as_float(w.w & 0xffff0000u);
                o[128 * j] = a * rs * gf[128 * j]; o[128 * j + 1] = b * rs * gf[128 * j + 1]; } }
    }
#if TSTAMP
    { asm volatile("s_waitcnt vmcnt(0)" ::: "memory"); grid.sync(); LOAD_ARGS(); const unsigned long long tend = __builtin_amdgcn_s_memrealtime();
      if (bx == 0 && tid == 0) { const unsigned long long a_ = ts_[TS_A], b_ = (TS_B == 8) ? tend : ts_[TS_B]; AOUT()[0] = 1000.0f * (float)(b_ - a_) * 0.01f; } }
#endif
#if CHECKS
    { asm volatile("s_waitcnt vmcnt(0)" ::: "memory"); grid.sync(); LOAD_ARGS(); if (bx == 0 && tid == 0) { for (int st = 0; st < 7; ++st) { const unsigned v = __hip_atomic_load(WSP(unsigned, WS_CTL) + 200 + st, __ATOMIC_RELAXED, __HIP_MEMORY_SCOPE_AGENT);
        if (v) { AOUT()[0] = (float)st * 1e7f + 1e6f + 8e6f * (float)v / 131072.0f; break; } } } }
#endif
}

extern "C" void kernel_launch(void* const* d_in, const int* in_sizes, int n_in, void* d_out, int out_size, void* d_ws, size_t ws_size, hipStream_t stream) {
    static int grid = 0;
    if (grid == 0) {
        if (n_in != 14 || out_size != NTOK * 1024 || ws_size < WS_END) { fprintf(stderr, "kernel_launch: unexpected shapes: n_in %d out %d ws %zu (need %zu)\n", n_in, out_size, ws_size, (size_t)WS_END); grid = -1; return; }
        int dev = 0, cus = 0, per_cu = 0;
        hipGetDevice(&dev); hipDeviceGetAttribute(&cus, hipDeviceAttributeMultiprocessorCount, dev);
        if (hipFuncSetAttribute((const void*)enc_fwd, hipFuncAttributeMaxDynamicSharedMemorySize, LDS_BYTES) != hipSuccess) { fprintf(stderr, "kernel_launch: hipFuncSetAttribute failed\n"); grid = -1; return; }
        if (hipOccupancyMaxActiveBlocksPerMultiprocessor(&per_cu, (const void*)enc_fwd, 512, LDS_BYTES) != hipSuccess || per_cu < 1) { fprintf(stderr, "kernel_launch: occupancy query says %d\n", per_cu); per_cu = 1; }
        (void)hipGetLastError();
        grid = cus * per_cu;
    }
    if (grid < 0) return;
    hipMemsetAsync((char*)d_ws + WS_CTL, 0, CTL_BYTES, stream);
    Args a{};
    for (int i = 0; i < 14; ++i) a.in[i] = (const float*)d_in[i];
    a.out = (float*)d_out; a.ws = (unsigned char*)d_ws;
    void* kargs[] = {&a};
    hipError_t e = hipLaunchCooperativeKernel((const void*)enc_fwd, dim3(grid), dim3(512), kargs, LDS_BYTES, stream);
    if (e != hipSuccess) fprintf(stderr, "cooperative launch failed: %s (grid %d)\n", hipGetErrorString(e), grid);
}
```
